# Optimizing an MI355X kernel written in HIP

```python
import math
import jax, jax.numpy as jnp
from jax import lax
import numpy as np

D_MODEL = 2048
BATCH = 4
SEQ = 2048
DEPTH = 4

GRID_W = 64
CTX_LEN = 256
D_POOL = D_MODEL // 4
POOL_WINDOWS = (2, 4, 8, 16)
N_POOL_GROUPS = len(POOL_WINDOWS)
POOL_GROUP = D_POOL // N_POOL_GROUPS
D_HYENA = D_MODEL // 4
FILTER_EMB = 33
FILTER_BANDS = (FILTER_EMB - 1) // 2
FILTER_ORDER = 64
FILTER_DECAY_TARGET = 1e-2
FILTER_FAST_PCT = 0.3
FILTER_SLOW_PCT = 1.5
RET_HEAD_DIM = 256
D_RET = D_MODEL // 2
RET_HEADS = D_RET // RET_HEAD_DIM
RET_CHUNK = 128
ROPE_BASE = 10000.0
ROPE_PAIRS = RET_HEAD_DIM // 4
N_BRANCH = 3
D_FF = 4 * D_MODEL
LN_EPS = 1e-5
GN_EPS = 1e-6
DEEPNORM_ALPHA = (2 * DEPTH) ** 0.25
DEEPNORM_BETA = (8 * DEPTH) ** -0.25
O_POOL = 0
O_HY = O_POOL + D_POOL
O_Q = O_HY + 3 * D_HYENA
O_K = O_Q + D_RET
O_V = O_K + D_RET
O_G = O_V + D_RET
O_GATE = O_G + D_RET
D_IN = O_GATE + N_BRANCH * D_MODEL

kernel_name = 'hybrid_pool_hyena_retention_dit_block'


def layer_norm(x, g, b):
    xf = x.astype(jnp.float32)
    mu = xf.mean(-1, keepdims=True)
    var = jnp.square(xf - mu).mean(-1, keepdims=True)
    return ((xf - mu) * lax.rsqrt(var + LN_EPS) * g + b).astype(x.dtype)


def modulate(h, shift, scale):
    return h * (1.0 + scale) + shift


def pool_mixer(u, w, scale):
    B, L, _ = u.shape
    ug = u.astype(jnp.float32).reshape(B, L, N_POOL_GROUPS, POOL_GROUP)
    csum = jnp.concatenate([jnp.zeros_like(ug[:, :1]), jnp.cumsum(ug, axis=1)], axis=1)
    t = jnp.arange(L)[:, None]
    win = jnp.array(POOL_WINDOWS)[None, :]
    lo = jnp.clip(t - win // 2, 0, L)
    hi = jnp.clip(t + win - win // 2, 0, L)
    grp = jnp.arange(N_POOL_GROUPS)[None, :]
    wsum = csum[:, hi, grp] - csum[:, lo, grp]
    pooled = wsum / (hi - lo).astype(jnp.float32)[None, :, :, None] - ug
    y = jnp.einsum('blgc,gcd->blgd', pooled, w)
    return y.reshape(B, L, D_POOL) * scale


def short_conv(u, w, b):
    up = jnp.pad(u, ((0, 0), (1, 1), (0, 0)))
    return up[:, :-2] * w[0] + up[:, 1:-1] * w[1] + up[:, 2:] * w[2] + b


def hyena_filters(L, p):
    t = jnp.linspace(0.0, 1.0, L, dtype=jnp.float32)[:, None]
    w = 2.0 * math.pi * jnp.arange(L, dtype=jnp.float32)[:, None] / L
    f = jnp.linspace(1e-4, FILTER_BANDS - 1, FILTER_BANDS, dtype=jnp.float32)[None, :]
    z = jnp.concatenate([t, jnp.cos(f * w), -jnp.sin(f * w)], axis=-1)
    hdn = jnp.sin(p['filt_f1'] * (z @ p['filt_w1'] + p['filt_b1']))
    hdn = jnp.sin(p['filt_f2'] * (hdn @ p['filt_w2'] + p['filt_b2']))
    hdn = jnp.sin(p['filt_f3'] * (hdn @ p['filt_w3'] + p['filt_b3']))
    h = (hdn @ p['filt_w4']).astype(jnp.float32)
    max_decay = math.log(FILTER_DECAY_TARGET) / FILTER_FAST_PCT
    min_decay = math.log(FILTER_DECAY_TARGET) / FILTER_SLOW_PCT
    deltas = jnp.linspace(min_decay, max_decay, D_HYENA, dtype=jnp.float32)
    decay = jnp.exp(-t * jnp.abs(deltas)[None, :])
    h = h * jnp.concatenate([decay, decay], axis=-1)
    return h[:, :D_HYENA], h[:, D_HYENA:]


def bidir_long_conv(u, h_f, h_b):
    L = u.shape[1]
    k2 = jnp.concatenate([h_f, jnp.zeros_like(h_f[:1]), h_b[:0:-1]], axis=0)
    U = jnp.fft.rfft(u, n=2 * L, axis=1)
    K = jnp.fft.rfft(k2, n=2 * L, axis=0)
    return jnp.fft.irfft(U * K[None], n=2 * L, axis=1)[:, :L]


def hyena_mixer(u, p):
    L = u.shape[1]
    z = short_conv(u, p['conv_w'], p['conv_b']).astype(jnp.float32)
    v, x0, x1 = jnp.split(z, 3, axis=-1)
    h_f, h_b = hyena_filters(L, p)
    uu = v * x1
    return (bidir_long_conv(uu, h_f, h_b) + uu * p['hyena_d']) * x0


def grid_rope_tables(L):
    rows = L // GRID_W
    row = jnp.repeat(jnp.arange(rows, dtype=jnp.float32), GRID_W)
    col = jnp.tile(jnp.arange(GRID_W, dtype=jnp.float32), rows)
    inv = ROPE_BASE ** (-jnp.arange(ROPE_PAIRS, dtype=jnp.float32) / ROPE_PAIRS)
    ang_r = row[:, None] * inv[None, :]
    ang_c = col[:, None] * inv[None, :]
    return (jnp.cos(ang_r), jnp.sin(ang_r), jnp.cos(ang_c), jnp.sin(ang_c))


def rotate(x, cos, sin):
    x1, x2 = jnp.split(x, 2, axis=-1)
    return jnp.concatenate([x1 * cos - x2 * sin, x2 * cos + x1 * sin], axis=-1)


def apply_grid_rope(x, rope):
    cr, sr, cc, sc = rope
    half = RET_HEAD_DIM // 2
    return jnp.concatenate([rotate(x[..., :half], cr, sr), rotate(x[..., half:], cc, sc)], axis=-1)


def to_heads(t):
    B, L, _ = t.shape
    return t.reshape(B, L, RET_HEADS, RET_HEAD_DIM).transpose(0, 2, 1, 3).astype(jnp.float32)


def log_decays(param):
    lg = jnp.log1p(-jnp.exp(param.astype(jnp.float32)))
    return lg[0], lg[1]


def chunk_retention(q, k, v, lg, state0):
    B, H, L, _ = q.shape
    dv = v.shape[-1]
    n = L // RET_CHUNK

    def chunks(t):
        return t.reshape(B, H, n, RET_CHUNK, t.shape[-1]).transpose(2, 0, 1, 3, 4)

    idx = jnp.arange(RET_CHUNK, dtype=jnp.float32)
    rel = idx[:, None] - idx[None, :]
    lower = rel >= 0
    dmask = jnp.where(lower[None], jnp.exp(jnp.where(lower, rel, 0.0)[None] * lg[:, None, None]), 0.0)
    q_dec = jnp.exp((idx + 1.0)[None, :] * lg[:, None])[None, :, :, None]
    k_dec = jnp.exp((RET_CHUNK - 1.0 - idx)[None, :] * lg[:, None])[None, :, :, None]
    c_dec = jnp.exp(RET_CHUNK * lg)[None, :, None, None]

    def step(state, xs):
        qc, kc, vc = xs
        scores = jnp.einsum('bhid,bhjd->bhij', qc, kc) * dmask
        out = (jnp.einsum('bhij,bhjv->bhiv', scores, vc)
               + jnp.einsum('bhid,bhdv->bhiv', qc * q_dec, state))
        state = state * c_dec + jnp.einsum('bhjd,bhjv->bhdv', kc * k_dec, vc)
        return state, out

    _, out = lax.scan(step, state0, (chunks(q), chunks(k), chunks(v)))
    return out.transpose(1, 2, 0, 3, 4).reshape(B, H, L, dv)


def bidir_retention(q, k, v, lg_f, lg_b, s_f, s_b):
    def flip(t):
        return jnp.flip(t, axis=2)
    o_f = chunk_retention(q, k, v, lg_f, s_f)
    o_b = flip(chunk_retention(flip(q), flip(k), flip(v), lg_b, s_b))
    return o_f + o_b


def context_states(k, v, lg_f, lg_b):
    L = k.shape[2]
    pos = jnp.arange(L, dtype=jnp.float32)
    w_f = jnp.exp((L - 1.0 - pos)[None, :] * lg_f[:, None])
    w_b = jnp.exp(pos[None, :] * lg_b[:, None])
    s_f = jnp.einsum('bhlk,hl,bhlv->bhkv', k, w_f, v)
    s_b = jnp.einsum('bhlk,hl,bhlv->bhkv', k, w_b, v)
    return s_f, s_b


def hybrid_mixer(h, p, rope, s_f, s_b):
    B, L, _ = h.shape
    z = h @ p['w_in'] + p['b_in']
    y_a = pool_mixer(z[..., O_POOL:O_HY], p['pool_w'], p['pool_scale'])
    y_b = hyena_mixer(z[..., O_HY:O_Q], p)
    q = to_heads(z[..., O_Q:O_K])
    k = to_heads(z[..., O_K:O_V]) * RET_HEAD_DIM ** -0.5
    v = to_heads(z[..., O_V:O_G])
    if rope is not None:
        q = apply_grid_rope(q, rope)
        k = apply_grid_rope(k, rope)
    lg_f, lg_b = log_decays(p['ret_decay'])
    o = bidir_retention(q, k, v, lg_f, lg_b, s_f, s_b)
    mu = o.mean(-1, keepdims=True)
    var = jnp.square(o - mu).mean(-1, keepdims=True)
    o = ((o - mu) * lax.rsqrt(var + GN_EPS)).transpose(0, 2, 1, 3).reshape(B, L, D_RET)
    y_c = jax.nn.silu(z[..., O_G:O_GATE].astype(jnp.float32)) * o
    gates = jax.nn.sigmoid(z[..., O_GATE:].astype(jnp.float32)).reshape(B, L, N_BRANCH, D_MODEL)
    merged = (gates[:, :, 0] * (y_a @ p['p_a'])
              + gates[:, :, 1] * (y_b @ p['p_b'])
              + gates[:, :, 2] * (y_c @ p['p_c']))
    return merged @ p['w_o'] + p['b_o'], k, v


def context_kv(h, p):
    z = h @ p['w_in'][:, O_K:O_G] + p['b_in'][O_K:O_G]
    return to_heads(z[..., :D_RET]) * RET_HEAD_DIM ** -0.5, to_heads(z[..., D_RET:])


def sq_relu_mlp(h, p):
    a = jax.nn.relu(h @ p['w_mlp1'] + p['b_mlp1'])
    return jnp.square(a) @ p['w_mlp2'] + p['b_mlp2']


def setup_inputs(seed: int = 0) -> dict:
    key = jax.random.key(seed)
    ks = jax.random.split(key, 64)
    counter = [0]

    def nrm(shape, scale):
        k = ks[counter[0]]
        counter[0] += 1
        return jax.random.normal(k, shape, jnp.float32) * scale

    beta = DEEPNORM_BETA
    ret_base = -(5.0 + jnp.arange(RET_HEADS, dtype=jnp.float32)) * math.log(2.0)
    return {
        'x': nrm((BATCH, SEQ, D_MODEL), 1.0),
        'c': nrm((BATCH, D_MODEL), 1.0),
        'ctx': nrm((BATCH, CTX_LEN, D_MODEL), 1.0),
        'c_ctx': nrm((D_MODEL,), 1.0),
        'w_ada': nrm((DEPTH, D_MODEL, 6 * D_MODEL), 0.5 * D_MODEL ** -0.5),
        'b_ada': nrm((DEPTH, 6 * D_MODEL), 0.02),
        'w_in': nrm((DEPTH, D_MODEL, D_IN), D_MODEL ** -0.5),
        'b_in': nrm((DEPTH, D_IN), 0.02),
        'conv_w': nrm((DEPTH, 3, 3 * D_HYENA), 3.0 ** -0.5),
        'conv_b': nrm((DEPTH, 3 * D_HYENA), 0.02),
        'pool_w': nrm((DEPTH, N_POOL_GROUPS, POOL_GROUP, POOL_GROUP), POOL_GROUP ** -0.5),
        'pool_scale': 1.0 + nrm((DEPTH, D_POOL), 0.02),
        'filt_w1': nrm((DEPTH, FILTER_EMB, FILTER_ORDER), FILTER_EMB ** -0.5),
        'filt_b1': nrm((DEPTH, FILTER_ORDER), 0.02),
        'filt_f1': 1.0 + nrm((DEPTH, FILTER_ORDER), 0.1),
        'filt_w2': nrm((DEPTH, FILTER_ORDER, FILTER_ORDER), FILTER_ORDER ** -0.5),
        'filt_b2': nrm((DEPTH, FILTER_ORDER), 0.02),
        'filt_f2': 1.0 + nrm((DEPTH, FILTER_ORDER), 0.1),
        'filt_w3': nrm((DEPTH, FILTER_ORDER, FILTER_ORDER), FILTER_ORDER ** -0.5),
        'filt_b3': nrm((DEPTH, FILTER_ORDER), 0.02),
        'filt_f3': 1.0 + nrm((DEPTH, FILTER_ORDER), 0.1),
        'filt_w4': nrm((DEPTH, FILTER_ORDER, 2 * D_HYENA), 0.1 * FILTER_ORDER ** -0.5),
        'hyena_d': nrm((DEPTH, D_HYENA), 0.5),
        'ret_decay': ret_base + nrm((DEPTH, 2, RET_HEADS), 0.05),
        'p_a': nrm((DEPTH, D_POOL, D_MODEL), beta * D_POOL ** -0.5),
        'p_b': nrm((DEPTH, D_HYENA, D_MODEL), beta * D_HYENA ** -0.5),
        'p_c': nrm((DEPTH, D_RET, D_MODEL), beta * D_RET ** -0.5),
        'w_o': nrm((DEPTH, D_MODEL, D_MODEL), beta * D_MODEL ** -0.5),
        'b_o': nrm((DEPTH, D_MODEL), 0.02),
        'ln1_g': 1.0 + nrm((DEPTH, D_MODEL), 0.02),
        'ln1_b': nrm((DEPTH, D_MODEL), 0.02),
        'w_mlp1': nrm((DEPTH, D_MODEL, D_FF), D_MODEL ** -0.5),
        'b_mlp1': nrm((DEPTH, D_FF), 0.02),
        'w_mlp2': nrm((DEPTH, D_FF, D_MODEL), beta * D_FF ** -0.5),
        'b_mlp2': nrm((DEPTH, D_MODEL), 0.02),
        'ln2_g': 1.0 + nrm((DEPTH, D_MODEL), 0.02),
        'ln2_b': nrm((DEPTH, D_MODEL), 0.02),
    }


def reference(x, c, ctx, c_ctx, w_ada, b_ada, w_in, b_in, conv_w, conv_b, pool_w, pool_scale,
              filt_w1, filt_b1, filt_f1, filt_w2, filt_b2, filt_f2, filt_w3, filt_b3, filt_f3, filt_w4,
              hyena_d, ret_decay, p_a, p_b, p_c, w_o, b_o, ln1_g, ln1_b,
              w_mlp1, b_mlp1, w_mlp2, b_mlp2, ln2_g, ln2_b):
    L = x.shape[1]
    rope = grid_rope_tables(L)
    silu_c = jax.nn.silu(c)
    silu_cc = jax.nn.silu(c_ctx)
    zero_state = jnp.zeros((ctx.shape[0], RET_HEADS, RET_HEAD_DIM, RET_HEAD_DIM), jnp.float32)
    for l in range(DEPTH):
        p = {
            'w_in': w_in[l], 'b_in': b_in[l], 'conv_w': conv_w[l], 'conv_b': conv_b[l],
            'pool_w': pool_w[l], 'pool_scale': pool_scale[l],
            'filt_w1': filt_w1[l], 'filt_b1': filt_b1[l], 'filt_f1': filt_f1[l],
            'filt_w2': filt_w2[l], 'filt_b2': filt_b2[l], 'filt_f2': filt_f2[l],
            'filt_w3': filt_w3[l], 'filt_b3': filt_b3[l], 'filt_f3': filt_f3[l],
            'filt_w4': filt_w4[l], 'hyena_d': hyena_d[l], 'ret_decay': ret_decay[l],
            'p_a': p_a[l], 'p_b': p_b[l], 'p_c': p_c[l], 'w_o': w_o[l], 'b_o': b_o[l],
            'w_mlp1': w_mlp1[l], 'b_mlp1': b_mlp1[l], 'w_mlp2': w_mlp2[l], 'b_mlp2': b_mlp2[l],
        }
        mod_x = (silu_c @ w_ada[l] + b_ada[l])[:, None, :]
        mod_c = (silu_cc @ w_ada[l] + b_ada[l])[None, None, :]
        sh1, sc1, g1, sh2, sc2, g2 = jnp.split(mod_x, 6, axis=-1)
        csh1, csc1, cg1, csh2, csc2, cg2 = jnp.split(mod_c, 6, axis=-1)
        last = l == DEPTH - 1
        hc = modulate(ctx, csh1, csc1)
        if not last:
            yc, kc, vc = hybrid_mixer(hc, p, None, zero_state, zero_state)
        else:
            kc, vc = context_kv(hc, p)
        lg_f, lg_b = log_decays(p['ret_decay'])
        s_f, s_b = context_states(kc, vc, lg_f, lg_b)
        yx, _, _ = hybrid_mixer(modulate(x, sh1, sc1), p, rope, s_f, s_b)
        x = layer_norm(DEEPNORM_ALPHA * x + g1 * yx, ln1_g[l], ln1_b[l])
        x = layer_norm(DEEPNORM_ALPHA * x + g2 * sq_relu_mlp(modulate(x, sh2, sc2), p), ln2_g[l], ln2_b[l])
        if not last:
            ctx = layer_norm(DEEPNORM_ALPHA * ctx + cg1 * yc, ln1_g[l], ln1_b[l])
            ctx = layer_norm(DEEPNORM_ALPHA * ctx + cg2 * sq_relu_mlp(modulate(ctx, csh2, csc2), p),
                             ln2_g[l], ln2_b[l])
    return x
```

```cpp
#include <hip/hip_runtime.h>
#include <cstdio>
#include <cstdint>

#ifndef MK_PER_PHASE
#define MK_PER_PHASE 1
#endif

#define LAS __attribute__((address_space(3)))
#define GAS __attribute__((address_space(1)))
typedef unsigned short bf16_t;
typedef short bf16x8 __attribute__((ext_vector_type(8)));
typedef float f32x4 __attribute__((ext_vector_type(4)));
typedef float f32x2 __attribute__((ext_vector_type(2)));
typedef unsigned u32x4 __attribute__((ext_vector_type(4)));
typedef unsigned u32x2 __attribute__((ext_vector_type(2)));

constexpr int D = 2048, NB = 4, SEQ = 2048, DEPTH = 4, CTXL = 256;
constexpr int MC = NB * CTXL, ML = NB * SEQ, M = MC + ML;
constexpr int DIN = 12288, DFF = 8192;
constexpr int O_HY = 512, O_Q = 2048, O_K = 3072, O_V = 4096, O_G = 5120, O_GATE = 6144;
constexpr int NU = 144;
constexpr float LN_EPS = 1e-5f, GN_EPS = 1e-6f;
constexpr float ALPHA = 1.6817928305074290f;

constexpr size_t MiB = 1u << 20;
constexpr size_t WS_CTL = 0;
constexpr size_t WS_MOD = 1 * MiB;
constexpr size_t WS_ROPE = 2 * MiB;
constexpr size_t WS_MODP = 4 * MiB;
constexpr size_t WS_FILT = 20 * MiB;
constexpr size_t WS_FILTC = 52 * MiB;
constexpr size_t WS_WPT = 56 * MiB;
constexpr size_t WS_WIN = 58 * MiB;
constexpr size_t WS_PT = 250 * MiB;
constexpr size_t WS_WO = 282 * MiB;
constexpr size_t WS_W1 = 314 * MiB;
constexpr size_t WS_W2 = 442 * MiB;
constexpr size_t WS_X = 570 * MiB;
constexpr size_t WS_XM = 642 * MiB;
constexpr size_t WS_Z = 678 * MiB;
constexpr size_t WS_H = WS_Z;
constexpr size_t WS_Y = 894 * MiB;
constexpr size_t WS_UU = 930 * MiB;
constexpr size_t WS_X0 = 948 * MiB;
constexpr size_t WS_POOL = 966 * MiB;
constexpr size_t WS_ABUF = 976 * MiB;
constexpr size_t WS_BBUF = 1030 * MiB;
constexpr size_t WS_KT = 1084 * MiB;
constexpr size_t WS_UT = 1120 * MiB;
constexpr size_t WS_OBUF = 1192 * MiB;
constexpr size_t WS_MGF = 1228 * MiB;
constexpr size_t WS_S = WS_MGF;
constexpr size_t WS_MG = 1300 * MiB;
constexpr size_t WS_END = 1336 * MiB;

constexpr int RING_BYTES = 131072;
constexpr int MISC_OFF = RING_BYTES;
constexpr int LDS_BYTES = 147456;

#define RLX_AGENT __ATOMIC_RELAXED, __HIP_MEMORY_SCOPE_AGENT
#define LDS_WAIT() asm volatile("s_waitcnt lgkmcnt(0)" ::: "memory")
#define VM_WAIT() asm volatile("s_waitcnt vmcnt(0)" ::: "memory")

__device__ __forceinline__ unsigned f2bf(float f) { unsigned u = __builtin_bit_cast(unsigned, f); return (u + 0x7fffu + ((u >> 16) & 1u)) >> 16; }
__device__ __forceinline__ unsigned pk2(float lo, float hi) { return f2bf(lo) | (f2bf(hi) << 16); }
__device__ __forceinline__ float bflo(unsigned w) { return __builtin_bit_cast(float, w << 16); }
__device__ __forceinline__ float bfhi(unsigned w) { return __builtin_bit_cast(float, w & 0xffff0000u); }
__device__ __forceinline__ float bf1(bf16_t h) { return __builtin_bit_cast(float, ((unsigned)h) << 16); }

namespace pg8 {
constexpr int BM = 256, BK = 64, HALF = 128, HTB = HALF * BK * 2, STAGE_BYTES = 8 * HTB, NXCD = 8, WGM = 8;
__host__ __device__ __forceinline__ int lds_byte(int r, int c) { const int st = (r >> 4) * 2 + (c >> 5), rr = r & 15, cc = c & 31, ob = rr * 64 + cc * 2; return st * 1024 + (ob ^ (((ob >> 9) & 1) << 5)); }
__host__ __device__ __forceinline__ void stage_rc(int b, int& R, int& C) { const int st = b / 1024, sb = b % 1024, swz = sb ^ (((sb >> 9) & 1) << 5); R = (st >> 1) * 16 + swz / 64; C = (st & 1) * 32 + (swz % 64) / 2; }
__host__ __device__ __forceinline__ int perm32(int rho) { const int n = rho >> 4, i = rho & 15; return 8 * (i >> 2) + 4 * n + (i & 3); }

struct Unit { int pm, pn, z; };
struct Gemm { int lda, ldb, K; };

__device__ __forceinline__ unsigned cvt_pk_bf16(float lo, float hi) { unsigned r; asm volatile("v_cvt_pk_bf16_f32 %0, %1, %2" : "=v"(r) : "v"(lo), "v"(hi)); return r; }

struct BigOrder {
    const char* A; const char* B; size_t astep, bstep; int nM, nN, nwg, G, c;
    __device__ __forceinline__ void init(const void* A_, const void* B_, int lda, int ldb, int M_, int N_, int G_, int c_) {
        A = (const char*)A_; B = (const char*)B_; astep = (size_t)BM * lda * 2; bstep = (size_t)BM * ldb * 2; nM = M_ / BM; nN = N_ / BM; nwg = nM * nN; G = G_; c = c_; }
    __device__ __forceinline__ bool next(int i, Unit& u) const {
        const long L = (long)i * G + c; if (L >= nwg) return false;
        int wgid = (int)L; { const int q = nwg / NXCD, r = nwg % NXCD, xcd = wgid % NXCD, off = wgid / NXCD; wgid = (xcd < r ? xcd * (q + 1) : r * (q + 1) + (xcd - r) * q) + off; }
        const int nig = WGM * nN, gid = wgid / nig, fm = gid * WGM, gsz = (nM - fm) < WGM ? (nM - fm) : WGM;
        u.pm = fm + ((wgid % nig) % gsz); u.pn = (wgid % nig) / gsz; u.z = 0; return true;
    }
    __device__ __forceinline__ const char* aptr(const Unit& u) const { return A + (size_t)u.pm * astep; }
    __device__ __forceinline__ const char* bptr(const Unit& u) const { return B + (size_t)u.pn * bstep; }
};

template <class Epi, class Sched, bool ALIGN_EPI, bool SP2>
__device__ __forceinline__ void gemm_phase(LAS unsigned char* lds, const int tid, const Gemm g, const Sched& S, const Epi& E) {
    const int wid = __builtin_amdgcn_readfirstlane(tid >> 6), lane = tid & 63, wr = wid >> 2, wc = wid & 3, fr = lane & 15, fq = lane >> 4;
    const int K = g.K, nt = K / BK;
    unsigned voffA[2], voffB[2];
#pragma unroll
    for (int i = 0; i < 2; ++i) { int R, C; stage_rc(tid * 16 + i * 8192, R, C); const int Rb = Epi::PERM ? ((R & ~31) + perm32(R & 31)) : R;
        voffA[i] = (unsigned)(R * g.lda + C) * 2u; voffB[i] = (unsigned)(Rb * g.ldb + C) * 2u; }
    const size_t kstep = (size_t)(BK * 2);
    const size_t hstepA = (size_t)HALF * g.lda * 2, hstepB = (size_t)HALF * g.ldb * 2;
    const unsigned ldsw = (unsigned)wid * 1024u;
    const int aoff = lds_byte(wr * 64 + fr, fq * 8), boff = lds_byte(wc * 32 + fr, fq * 8);
#define PG8_SA(b, h) (((b) * 2 + (h)) * HTB)
#define PG8_SB(b, h) ((4 + (b) * 2 + (h)) * HTB)
#define PG8_STAGE(bufoff, gbase, voff) do { _Pragma("unroll") for (int _i = 0; _i < 2; ++_i) \
        __builtin_amdgcn_global_load_lds((const unsigned*)((const char*)(gbase) + (voff)[_i]), (LAS unsigned*)(lds + (bufoff) + ldsw + _i * 8192), 16, 0, 0); } while (0)
#define PG8_LDA(dst, b, h) do { _Pragma("unroll") for (int m = 0; m < 4; ++m) _Pragma("unroll") for (int k = 0; k < 2; ++k) dst[m][k] = *(const LAS bf16x8*)(lds + PG8_SA(b, h) + aoff + m * 2048 + k * 1024); } while (0)
#define PG8_LDB(dst, b, h) do { _Pragma("unroll") for (int n = 0; n < 2; ++n) _Pragma("unroll") for (int k = 0; k < 2; ++k) dst[n][k] = *(const LAS bf16x8*)(lds + PG8_SB(b, h) + boff + n * 2048 + k * 1024); } while (0)
#define PG8_MMA(ai, bj, At, Bt) do { __builtin_amdgcn_s_setprio(1); _Pragma("unroll") for (int m = 0; m < 4; ++m) _Pragma("unroll") for (int n = 0; n < 2; ++n) _Pragma("unroll") for (int k = 0; k < 2; ++k) \
        acc[ai][bj][m][n] = __builtin_amdgcn_mfma_f32_16x16x32_bf16(Bt[n][k], At[m][k], acc[ai][bj][m][n], 0, 0, 0); __builtin_amdgcn_s_setprio(0); } while (0)
#define PG8_WAIT_V(n) asm volatile("s_waitcnt vmcnt(" #n ")" ::: "memory")
#define PG8_WAIT_L(n) asm volatile("s_waitcnt lgkmcnt(" #n ")" ::: "memory")
#define PG8_BAR __builtin_amdgcn_s_barrier()
#define PG8_SCHED __builtin_amdgcn_sched_barrier(0)
    Unit cur, nxt; int ui = 0;
    if (!S.next(0, cur)) return;
    f32x4 acc[2][2][4][2];
#pragma unroll
    for (int a = 0; a < 2; ++a)
#pragma unroll
        for (int b = 0; b < 2; ++b)
#pragma unroll
            for (int m = 0; m < 4; ++m)
#pragma unroll
                for (int n = 0; n < 2; ++n) acc[a][b][m][n] = (f32x4){0.f, 0.f, 0.f, 0.f};
    bf16x8 At[4][2], B0[2][2], B1[2][2];
    const char* cA = S.aptr(cur); const char* cB = S.bptr(cur);
    if constexpr (SP2) {
        PG8_STAGE(PG8_SB(0, 0), cB, voffB); PG8_STAGE(PG8_SB(0, 1), cB + hstepB, voffB); PG8_STAGE(PG8_SA(0, 0), cA, voffA); PG8_STAGE(PG8_SA(0, 1), cA + hstepA, voffA);
        if (wr == 1) PG8_BAR;
        PG8_WAIT_V(2); PG8_BAR;
        PG8_STAGE(PG8_SB(1, 0), cB + kstep, voffB); PG8_STAGE(PG8_SA(1, 0), cA + kstep, voffA); PG8_STAGE(PG8_SB(1, 1), cB + hstepB + kstep, voffB);
        PG8_WAIT_V(6); PG8_BAR;
    } else {
        PG8_STAGE(PG8_SB(0, 0), cB, voffB); PG8_STAGE(PG8_SA(0, 0), cA, voffA); PG8_STAGE(PG8_SB(0, 1), cB + hstepB, voffB); PG8_STAGE(PG8_SA(0, 1), cA + hstepA, voffA);
        if (wr == 1) PG8_BAR;
        PG8_WAIT_V(4); PG8_BAR;
        PG8_STAGE(PG8_SB(1, 0), cB + kstep, voffB); PG8_STAGE(PG8_SA(1, 0), cA + kstep, voffA); PG8_STAGE(PG8_SB(1, 1), cB + hstepB + kstep, voffB);
        PG8_WAIT_V(6); PG8_BAR;
    }
    for (;;) {
        const bool has_next = S.next(ui + 1, nxt);
        const char* nA = has_next ? S.aptr(nxt) : cA; const char* nB = has_next ? S.bptr(nxt) : cB;
#pragma unroll 1
        for (int t = 0; t < nt; t += 2) {
            const bool last = (t == nt - 2);
            const char* a1 = cA + (size_t)(t + 1) * kstep;
            const char* a2 = last ? nA : cA + (size_t)(t + 2) * kstep; const char* b2 = last ? nB : cB + (size_t)(t + 2) * kstep;
            const char* a3 = a2 + kstep; const char* b3 = b2 + kstep;
            if constexpr (SP2) {
            PG8_LDB(B0, 0, 0); PG8_LDB(B1, 0, 1); PG8_SCHED; PG8_LDA(At, 0, 0); PG8_STAGE(PG8_SA(1, 1), a1 + hstepA, voffA);
            PG8_WAIT_V(8); PG8_WAIT_L(0); PG8_BAR; PG8_MMA(0, 0, At, B0); PG8_MMA(0, 1, At, B1); PG8_BAR; PG8_SCHED;
            PG8_LDA(At, 0, 1); PG8_STAGE(PG8_SB(0, 0), b2, voffB); PG8_STAGE(PG8_SB(0, 1), b2 + hstepB, voffB); PG8_STAGE(PG8_SA(0, 0), a2, voffA);
            PG8_WAIT_V(8); PG8_WAIT_L(0); PG8_BAR; PG8_MMA(1, 0, At, B0); PG8_MMA(1, 1, At, B1); PG8_BAR; PG8_SCHED;
            PG8_LDB(B0, 1, 0); PG8_LDB(B1, 1, 1); PG8_SCHED; PG8_LDA(At, 1, 0); PG8_STAGE(PG8_SA(0, 1), a2 + hstepA, voffA);
            PG8_WAIT_V(8); PG8_WAIT_L(0); PG8_BAR; PG8_MMA(0, 0, At, B0); PG8_MMA(0, 1, At, B1); PG8_BAR; PG8_SCHED;
            PG8_LDA(At, 1, 1); PG8_STAGE(PG8_SB(1, 0), b3, voffB); PG8_STAGE(PG8_SB(1, 1), b3 + hstepB, voffB); PG8_STAGE(PG8_SA(1, 0), a3, voffA);
            PG8_WAIT_V(8); PG8_WAIT_L(0); PG8_BAR; PG8_MMA(1, 0, At, B0); PG8_MMA(1, 1, At, B1); PG8_BAR; PG8_SCHED;
            } else {
            PG8_LDB(B0, 0, 0); PG8_SCHED; PG8_LDA(At, 0, 0); PG8_STAGE(PG8_SA(1, 1), a1 + hstepA, voffA);
            PG8_WAIT_L(8); PG8_BAR; PG8_WAIT_L(0); PG8_MMA(0, 0, At, B0); PG8_BAR; PG8_SCHED;
            PG8_LDB(B1, 0, 1); PG8_STAGE(PG8_SB(0, 0), b2, voffB);
            PG8_BAR; PG8_WAIT_L(0); PG8_MMA(0, 1, At, B1); PG8_BAR;
            PG8_LDA(At, 0, 1); PG8_STAGE(PG8_SA(0, 0), a2, voffA);
            PG8_BAR; PG8_WAIT_L(0); PG8_MMA(1, 0, At, B0); PG8_BAR; PG8_SCHED;
            PG8_STAGE(PG8_SB(0, 1), b2 + hstepB, voffB);
            PG8_WAIT_V(6); PG8_BAR; PG8_MMA(1, 1, At, B1); PG8_BAR;
            PG8_LDB(B0, 1, 0); PG8_SCHED; PG8_LDA(At, 1, 0); PG8_STAGE(PG8_SA(0, 1), a2 + hstepA, voffA);
            PG8_WAIT_L(8); PG8_BAR; PG8_WAIT_L(0); PG8_MMA(0, 0, At, B0); PG8_BAR; PG8_SCHED;
            PG8_LDB(B1, 1, 1); PG8_STAGE(PG8_SB(1, 0), b3, voffB);
            PG8_BAR; PG8_WAIT_L(0); PG8_MMA(0, 1, At, B1); PG8_BAR;
            PG8_LDA(At, 1, 1); PG8_STAGE(PG8_SA(1, 0), a3, voffA);
            PG8_BAR; PG8_WAIT_L(0); PG8_MMA(1, 0, At, B0); PG8_BAR; PG8_SCHED;
            PG8_STAGE(PG8_SB(1, 1), b3 + hstepB, voffB);
            PG8_WAIT_V(6); PG8_BAR; PG8_MMA(1, 1, At, B1); PG8_BAR;
            }
        }
        if constexpr (ALIGN_EPI) { if (wr == 0) PG8_BAR; }
        E(acc, cur, wr, wc, fr, fq);
        if (!has_next) break;
#pragma unroll
        for (int a = 0; a < 2; ++a)
#pragma unroll
            for (int b = 0; b < 2; ++b)
#pragma unroll
                for (int m = 0; m < 4; ++m)
#pragma unroll
                    for (int n = 0; n < 2; ++n) acc[a][b][m][n] = (f32x4){0.f, 0.f, 0.f, 0.f};
        cur = nxt; cA = nA; cB = nB; ++ui;
        if constexpr (ALIGN_EPI) { if (wr == 1) PG8_BAR; }
    }
    PG8_WAIT_V(0);
    if constexpr (!ALIGN_EPI) { if (wr == 0) PG8_BAR; }
    PG8_BAR;
#undef PG8_SA
#undef PG8_SB
#undef PG8_STAGE
#undef PG8_LDA
#undef PG8_LDB
#undef PG8_MMA
#undef PG8_WAIT_V
#undef PG8_WAIT_L
#undef PG8_BAR
#undef PG8_SCHED
}


template <int ACT> struct EpiBf16 {
    static constexpr bool PERM = true;
    bf16_t* O; int ldc; const float* bias;
    __device__ __forceinline__ void operator()(const f32x4 (&acc)[2][2][4][2], const Unit& u, int wr, int wc, int fr, int fq) const {
        const int row0 = u.pm * BM + wr * 64 + fr, col0 = u.pn * BM + wc * 32 + 8 * fq;
        f32x4 bv[2][2];
#pragma unroll
        for (int bj = 0; bj < 2; ++bj)
#pragma unroll
            for (int n = 0; n < 2; ++n) bv[bj][n] = bias ? *(const f32x4*)(bias + col0 + bj * HALF + 4 * n) : (f32x4){0.f, 0.f, 0.f, 0.f};
#pragma unroll
        for (int ai = 0; ai < 2; ++ai)
#pragma unroll
            for (int m = 0; m < 4; ++m) { bf16_t* rowp = O + (size_t)(row0 + ai * HALF + m * 16) * ldc + col0;
#pragma unroll
                for (int bj = 0; bj < 2; ++bj) { f32x4 v0 = acc[ai][bj][m][0] + bv[bj][0], v1 = acc[ai][bj][m][1] + bv[bj][1];
                    if (ACT == 1) {
#pragma unroll
                        for (int j = 0; j < 4; ++j) { const float a = fmaxf(v0[j], 0.f), b = fmaxf(v1[j], 0.f); v0[j] = a * a; v1[j] = b * b; } }
                    u32x4 w; w.x = cvt_pk_bf16(v0[0], v0[1]); w.y = cvt_pk_bf16(v0[2], v0[3]); w.z = cvt_pk_bf16(v1[0], v1[1]); w.w = cvt_pk_bf16(v1[2], v1[3]);
                    *(u32x4*)(rowp + bj * HALF) = w; } }
    }
};
struct EpiScores {
    static constexpr bool PERM = true;
    bf16_t* O; const float* rdec;
    __device__ __forceinline__ void operator()(const f32x4 (&acc)[2][2][4][2], const Unit& u, int wr, int wc, int fr, int fq) const {
        const int h = (u.z / 9) & 3; const float lf = log1pf(-expf(rdec[h])) * 1.4426950408889634f, lb = log1pf(-expf(rdec[4 + h])) * 1.4426950408889634f;
        bf16_t* base = O + (size_t)u.z * 256 * 768 + (size_t)(wr * 64 + fr) * 768 + wc * 32 + 8 * fq;
        float d00 = (float)(wr * 64 + fr - wc * 32 - 8 * fq);
        asm volatile("" : "+v"(d00));
#pragma unroll
        for (int ai = 0; ai < 2; ++ai)
#pragma unroll
            for (int m = 0; m < 4; ++m) {
#pragma unroll
                for (int bj = 0; bj < 2; ++bj) { float v[8];
#pragma unroll
                    for (int n = 0; n < 2; ++n)
#pragma unroll
                        for (int e = 0; e < 4; ++e) { const float d = d00 + (float)(ai * HALF + m * 16 - bj * HALF - 4 * n - e);
                            const float dp = fmaxf(d, 0.f), dn = fmaxf(-d, 0.f);
                            const float mk = __builtin_amdgcn_exp2f(dp * lf + dn * lb) + (1.0f - fminf(dp + dn, 1.0f));
                            v[4 * n + e] = acc[ai][bj][m][n][e] * mk; }
                    u32x4 w; w.x = cvt_pk_bf16(v[0], v[1]); w.y = cvt_pk_bf16(v[2], v[3]); w.z = cvt_pk_bf16(v[4], v[5]); w.w = cvt_pk_bf16(v[6], v[7]);
                    *(u32x4*)(base + (size_t)(ai * HALF + m * 16) * 768 + bj * HALF) = w; }
                asm volatile("" ::: "memory"); }
    }
};
struct EpiF32 {
    static constexpr bool PERM = false;
    float* C; int ldc; size_t zstride;
    __device__ __forceinline__ void operator()(const f32x4 (&acc)[2][2][4][2], const Unit& u, int wr, int wc, int fr, int fq) const {
        const int row0 = u.pm * BM + wr * 64 + fr, col0 = u.pn * BM + wc * 32 + 4 * fq; float* Cz = C + (size_t)u.z * zstride;
#pragma unroll
        for (int ai = 0; ai < 2; ++ai)
#pragma unroll
            for (int m = 0; m < 4; ++m) { float* rowp = Cz + (size_t)(row0 + ai * HALF + m * 16) * ldc + col0;
#pragma unroll
                for (int bj = 0; bj < 2; ++bj)
#pragma unroll
                    for (int n = 0; n < 2; ++n) *(f32x4*)(rowp + bj * HALF + n * 16) = acc[ai][bj][m][n]; }
    }
};
template <int PASS> struct EpiGate {
    static constexpr bool PERM = false;
    const bf16_t* Z; float* MGF; bf16_t* MG;
    __device__ __forceinline__ void operator()(const f32x4 (&acc)[2][2][4][2], const Unit& u, int wr, int wc, int fr, int fq) const {
        const int row0 = u.pm * BM + wr * 64 + fr, col0 = u.pn * BM + wc * 32 + 4 * fq;
#pragma unroll
        for (int ai = 0; ai < 2; ++ai)
#pragma unroll
            for (int m = 0; m < 4; ++m) { const size_t row = (size_t)(row0 + ai * HALF + m * 16);
#pragma unroll
                for (int bj = 0; bj < 2; ++bj)
#pragma unroll
                    for (int n = 0; n < 2; ++n) { const int col = col0 + bj * HALF + n * 16;
                        const u32x2 gz = *(const u32x2*)(Z + row * DIN + O_GATE + PASS * D + col);
                        f32x4 gt; gt[0] = bflo(gz.x); gt[1] = bfhi(gz.x); gt[2] = bflo(gz.y); gt[3] = bfhi(gz.y);
#pragma unroll
                        for (int e = 0; e < 4; ++e) gt[e] = 1.0f / (1.0f + __expf(-gt[e]));
                        f32x4 r = gt * acc[ai][bj][m][n];
                        float* mp = MGF + row * D + col;
                        if (PASS > 0) r = r + *(const f32x4*)mp;
                        if (PASS < 2) *(f32x4*)mp = r;
                        else { u32x2 w; w.x = cvt_pk_bf16(r[0], r[1]); w.y = cvt_pk_bf16(r[2], r[3]); *(u32x2*)(MG + row * D + col) = w; } } }
    }
};
struct EpiResid {
    static constexpr bool PERM = false;
    const float* X; float* S; const float* bias; const float* gate;
    __device__ __forceinline__ void operator()(const f32x4 (&acc)[2][2][4][2], const Unit& u, int wr, int wc, int fr, int fq) const {
        const int row0 = u.pm * BM + wr * 64 + fr, col0 = u.pn * BM + wc * 32 + 4 * fq;
        const int bmod = u.pm < 4 ? 4 : ((u.pm - 4) >> 3);
        const float* gp = gate + (size_t)bmod * 12288;
        f32x4 bv[2][2], gv[2][2];
#pragma unroll
        for (int bj = 0; bj < 2; ++bj)
#pragma unroll
            for (int n = 0; n < 2; ++n) { bv[bj][n] = *(const f32x4*)(bias + col0 + bj * HALF + n * 16); gv[bj][n] = *(const f32x4*)(gp + col0 + bj * HALF + n * 16); }
#pragma unroll
        for (int ai = 0; ai < 2; ++ai)
#pragma unroll
            for (int m = 0; m < 4; ++m) { const size_t off = (size_t)(row0 + ai * HALF + m * 16) * D + col0;
#pragma unroll
                for (int bj = 0; bj < 2; ++bj)
#pragma unroll
                    for (int n = 0; n < 2; ++n) { const f32x4 xv = *(const f32x4*)(X + off + bj * HALF + n * 16);
                        *(f32x4*)(S + off + bj * HALF + n * 16) = xv * ALPHA + gv[bj][n] * (acc[ai][bj][m][n] + bv[bj][n]); } }
    }
};
}

#define XB_TMO      128
#define XB_XCNT(j)  (256  + 64 * (j))
#define XB_XSUB(j)  (1280 + 64 * (j))
#define XB_XGEN(j)  (2304 + 64 * (j))
#define XB_TOP      3328
#define XB_TOPGEN   3392
#define XCD_BAR_WORDS 3456
#define XB_SPIN_CAP (1u << 22)

__device__ __forceinline__ unsigned xb_ld(unsigned* p)              { return __hip_atomic_load(p, __ATOMIC_RELAXED, __HIP_MEMORY_SCOPE_AGENT); }
__device__ __forceinline__ unsigned xb_add(unsigned* p, unsigned v) { return __hip_atomic_fetch_add(p, v, __ATOMIC_RELAXED, __HIP_MEMORY_SCOPE_AGENT); }
__device__ __forceinline__ unsigned xb_xcc_id() { return (unsigned)__builtin_amdgcn_s_getreg((3 << 11) | 20) & 0xFu; }
#define XB_SPIN(cond, bar) do { unsigned _sp = 0; while (cond) { __builtin_amdgcn_s_sleep(1); \
    if ((++_sp & 255u) == 0u) { if (xb_ld(&(bar)[XB_TMO])) break; if (_sp > XB_SPIN_CAP) { atomicAdd(&(bar)[XB_TMO], 1u); break; } } } } while (0)

struct XcdBarrier { unsigned* bar; unsigned x; volatile LAS unsigned* st; };

__device__ __forceinline__ XcdBarrier xcd_barrier_post(unsigned* bar, volatile LAS unsigned* st) {
    XcdBarrier b; b.bar = bar; b.x = xb_xcc_id(); b.st = st;
    if (threadIdx.x == 0) (void)xb_add(&bar[XB_XCNT(b.x)], 1u);
    return b;
}
__device__ __forceinline__ void xcd_barrier_complete(unsigned* bar, unsigned x, unsigned& nloc, unsigned& nx) {
    const unsigned G = gridDim.x * gridDim.y * gridDim.z;
    unsigned sum, cnt, mine, sp = 0u;
    for (;;) {
        sum = 0u; cnt = 0u; mine = 0u;
#pragma unroll
        for (unsigned j = 0; j < 16; ++j) { const unsigned c = xb_ld(&bar[XB_XCNT(j)]); sum += c; cnt += (c > 0u) ? 1u : 0u; mine = (j == x) ? c : mine; }
        if (sum == G) break;
        __builtin_amdgcn_s_sleep(1);
        if ((++sp & 255u) == 0u) { if (xb_ld(&bar[XB_TMO])) break; if (sp > XB_SPIN_CAP) { atomicAdd(&bar[XB_TMO], 1u); break; } }
    }
    nloc = mine > 0u ? mine : 1u; nx = cnt > 0u ? cnt : 1u;
}
__device__ __forceinline__ void xcd_barrier(const XcdBarrier& b) {
    asm volatile("s_waitcnt vmcnt(0)" ::: "memory");
    __syncthreads();
    if (threadIdx.x == 0) {
        unsigned* bar = b.bar;
        __builtin_amdgcn_s_waitcnt(0);
        unsigned nloc = b.st[0], nx = b.st[1];
        if (nloc == 0u) { xcd_barrier_complete(bar, b.x, nloc, nx); b.st[0] = nloc; b.st[1] = nx; }
        const unsigned old = xb_add(&bar[XB_XSUB(b.x)], 1u);
        const unsigned gen = old / nloc;
        if (old + 1u == (gen + 1u) * nloc) {
            __builtin_amdgcn_fence(__ATOMIC_RELEASE, "agent");
            asm volatile("s_waitcnt vmcnt(0)" ::: "memory");
            const unsigned og = xb_add(&bar[XB_TOP], 1u);
            const unsigned tg = og / nx;
            if (og + 1u == (tg + 1u) * nx) xb_add(&bar[XB_TOPGEN], 1u);
            else XB_SPIN(xb_ld(&bar[XB_TOPGEN]) == tg, bar);
            __builtin_amdgcn_fence(__ATOMIC_ACQUIRE, "agent");
            xb_add(&bar[XB_XGEN(b.x)], 1u);
            asm volatile("s_waitcnt vmcnt(0)" ::: "memory");
        } else {
            XB_SPIN(xb_ld(&bar[XB_XGEN(b.x)]) == gen, bar);
            __builtin_amdgcn_fence(__ATOMIC_ACQUIRE, "agent");
            asm volatile("s_waitcnt vmcnt(0)" ::: "memory");
        }
    }
    __syncthreads();
}

struct Args { const float* in[37]; float* out; unsigned char* ws; int ph_lo, ph_hi; };
typedef const __attribute__((address_space(4))) Args* CArgs;
enum { I_X = 0, I_C, I_CTX, I_CCTX, I_WADA, I_BADA, I_WIN, I_BIN, I_CONVW, I_CONVB, I_POOLW, I_POOLS, I_FW1, I_FB1, I_FF1, I_FW2, I_FB2, I_FF2, I_FW3, I_FB3, I_FF3, I_FW4,
       I_HYD, I_RDEC, I_PA, I_PB, I_PC, I_WO, I_BO, I_LN1G, I_LN1B, I_W1, I_B1, I_W2, I_B2, I_LN2G, I_LN2B };

struct Frame {
    LAS unsigned char* lds;
    int tid, lane, wave, blk, G;
    unsigned char* ws;
};

__device__ __forceinline__ float wave_sum(float v) {
#pragma unroll
    for (int o = 1; o < 64; o <<= 1) v += __shfl_xor(v, o);
    return v;
}
__device__ __forceinline__ float silu_f(float v) { return v / (1.0f + __expf(-v)); }
__device__ __forceinline__ int chunk_row0(int b, int ci) { return ci == 0 ? b * CTXL : MC + b * SEQ + (ci - 1) * 256; }
__device__ __forceinline__ float ret_lg2(const float* rdec, int l, int dirh) { const float p = rdec[l * 8 + dirh]; return log1pf(-expf(p)) * 1.4426950408889634f; }

__device__ __forceinline__ void transpose_item(const float* W, int N, bf16_t* WT, int ldw, int koff, LAS float* scr, int item, int lane) {
    const int nblk = N / 32, kb = item / nblk, nb = item % nblk, k0 = 64 * kb, n0 = 32 * nb;
#pragma unroll 8
    for (int i = 0; i < 32; ++i) { const int kk = 2 * i + (lane >> 5); scr[kk * 33 + (lane & 31)] = W[(size_t)(k0 + kk) * N + n0 + (lane & 31)]; }
    LDS_WAIT(); asm volatile("" ::: "memory");
    const int c = lane & 7;
#pragma unroll
    for (int j = 0; j < 4; ++j) { const int n = (lane >> 3) + 8 * j; const LAS float* s = scr + (8 * c) * 33 + n;
        u32x4 o; o.x = pk2(s[0 * 33], s[1 * 33]); o.y = pk2(s[2 * 33], s[3 * 33]); o.z = pk2(s[4 * 33], s[5 * 33]); o.w = pk2(s[6 * 33], s[7 * 33]);
        *(u32x4*)(WT + (size_t)(n0 + n) * ldw + koff + k0 + 8 * c) = o; }
    LDS_WAIT(); asm volatile("" ::: "memory");
}

__device__ __forceinline__ void pro_a(Frame& F, CArgs a) {
    LAS float* scr = (LAS float*)(F.lds + F.wave * 16384);
    const int gw = F.blk * 8 + F.wave, NGW = F.G * 8, lane = F.lane;
    unsigned char* ws = F.ws;
    constexpr int I_IN = 32 * 384, I_PAB = 8 * 64, I_PCC = 16 * 64, I_O = 32 * 64, I_1 = 32 * 256, I_2 = 128 * 64;
    constexpr int PER_L = I_IN + 2 * I_PAB + I_PCC + I_O + I_1 + I_2;
    for (int it = gw; it < DEPTH * PER_L; it += NGW) {
        const int l = it / PER_L; int r = it % PER_L;
        if (r < I_IN) { transpose_item(a->in[I_WIN] + (size_t)l * D * DIN, DIN, (bf16_t*)(ws + WS_WIN) + (size_t)l * DIN * D, D, 0, scr, r, lane); continue; } r -= I_IN;
        if (r < I_PAB) { transpose_item(a->in[I_PA] + (size_t)l * 512 * D, D, (bf16_t*)(ws + WS_PT) + (size_t)l * D * D, D, 0, scr, r, lane); continue; } r -= I_PAB;
        if (r < I_PAB) { transpose_item(a->in[I_PB] + (size_t)l * 512 * D, D, (bf16_t*)(ws + WS_PT) + (size_t)l * D * D, D, 512, scr, r, lane); continue; } r -= I_PAB;
        if (r < I_PCC) { transpose_item(a->in[I_PC] + (size_t)l * 1024 * D, D, (bf16_t*)(ws + WS_PT) + (size_t)l * D * D, D, 1024, scr, r, lane); continue; } r -= I_PCC;
        if (r < I_O) { transpose_item(a->in[I_WO] + (size_t)l * D * D, D, (bf16_t*)(ws + WS_WO) + (size_t)l * D * D, D, 0, scr, r, lane); continue; } r -= I_O;
        if (r < I_1) { transpose_item(a->in[I_W1] + (size_t)l * D * DFF, DFF, (bf16_t*)(ws + WS_W1) + (size_t)l * DFF * D, D, 0, scr, r, lane); continue; } r -= I_1;
        transpose_item(a->in[I_W2] + (size_t)l * DFF * D, D, (bf16_t*)(ws + WS_W2) + (size_t)l * D * DFF, DFF, 0, scr, r, lane);
    }
    {
        float* modp = (float*)(ws + WS_MODP);
        for (int it = gw; it < DEPTH * 192 * 16; it += NGW) {
            const int ks = it & 15, cb = (it >> 4) % 192, l = it / (16 * 192);
            const int col = cb * 64 + lane, k0 = ks * 128;
            float sv0[5], sv1[5];
#pragma unroll
            for (int b = 0; b < 5; ++b) { const float* cp = b < 4 ? a->in[I_C] + b * D : a->in[I_CCTX]; sv0[b] = silu_f(cp[k0 + lane]); sv1[b] = silu_f(cp[k0 + 64 + lane]); }
            float acc[5] = {0.f, 0.f, 0.f, 0.f, 0.f};
            const float* wp = a->in[I_WADA] + ((size_t)l * D + k0) * 12288 + col;
            for (int kk = 0; kk < 64; ++kk) { const float w = wp[(size_t)kk * 12288];
#pragma unroll
                for (int b = 0; b < 5; ++b) acc[b] += __shfl(sv0[b], kk) * w; }
            for (int kk = 0; kk < 64; ++kk) { const float w = wp[(size_t)(64 + kk) * 12288];
#pragma unroll
                for (int b = 0; b < 5; ++b) acc[b] += __shfl(sv1[b], kk) * w; }
#pragma unroll
            for (int b = 0; b < 5; ++b) modp[(((size_t)ks * DEPTH + l) * 5 + b) * 12288 + col] = acc[b];
        }
    }
    {
        constexpr int PER = SEQ + CTXL;
        for (int it = gw; it < DEPTH * PER; it += NGW) {
            const int l = it / PER, pr = it % PER; const bool isc = pr >= SEQ; const int pos = isc ? pr - SEQ : pr, L = isc ? CTXL : SEQ;
            const float t = (float)pos / (float)(L - 1);
            const float w = 6.2831853071795862f * (float)pos / (float)L;
            float zf = 0.f;
            if (lane == 0) zf = t;
            else if (lane < 33) { const int bi = (lane - 1) & 15; const float f = 1e-4f + (float)bi * ((15.0f - 1e-4f) / 15.0f); const float ang = f * w; zf = lane <= 16 ? cosf(ang) : -sinf(ang); }
            float h = a->in[I_FB1][l * 64 + lane];
            for (int i = 0; i < 33; ++i) h += __shfl(zf, i) * a->in[I_FW1][((size_t)l * 33 + i) * 64 + lane];
            h = sinf(a->in[I_FF1][l * 64 + lane] * h);
            float h2 = a->in[I_FB2][l * 64 + lane];
            for (int i = 0; i < 64; ++i) h2 += __shfl(h, i) * a->in[I_FW2][((size_t)l * 64 + i) * 64 + lane];
            h2 = sinf(a->in[I_FF2][l * 64 + lane] * h2);
            float h3 = a->in[I_FB3][l * 64 + lane];
            for (int i = 0; i < 64; ++i) h3 += __shfl(h2, i) * a->in[I_FW3][((size_t)l * 64 + i) * 64 + lane];
            h3 = sinf(a->in[I_FF3][l * 64 + lane] * h3);
            float o[16];
#pragma unroll
            for (int m = 0; m < 16; ++m) o[m] = 0.f;
            const float* w4 = a->in[I_FW4] + (size_t)l * 64 * 1024 + lane;
            for (int i = 0; i < 64; ++i) { const float hv = __shfl(h3, i);
#pragma unroll
                for (int m = 0; m < 16; ++m) o[m] += hv * w4[(size_t)i * 1024 + 64 * m]; }
            float* dst = isc ? (float*)(ws + WS_FILTC) + ((size_t)l * CTXL + pos) * 1024 : (float*)(ws + WS_FILT) + ((size_t)l * SEQ + pos) * 1024;
            const float min_decay = -3.0701134573253945f, max_decay = -15.350567286626973f;
#pragma unroll
            for (int m = 0; m < 16; ++m) { const int col = lane + 64 * m, ch = col & 511;
                const float delta = min_decay + (float)ch * ((max_decay - min_decay) / 511.0f);
                dst[col] = o[m] * expf(-t * fabsf(delta)); }
        }
    }
    for (int t = gw; t < SEQ; t += NGW) {
        const float inv = exp2f(-(float)lane * (13.287712379549449f / 64.0f));
        const float ar = (float)(t >> 6) * inv, ac = (float)(t & 63) * inv;
        float* rp = (float*)(ws + WS_ROPE) + (size_t)t * 256;
        rp[lane] = cosf(ar); rp[64 + lane] = sinf(ar); rp[128 + lane] = cosf(ac); rp[192 + lane] = sinf(ac);
    }
    {
        bf16_t* wpt = (bf16_t*)(ws + WS_WPT);
        for (int e = F.blk * 512 + F.tid; e < DEPTH * 512 * 512; e += F.G * 512) {
            const int l = e >> 18, n = (e >> 9) & 511, k = e & 511; float v = 0.f;
            if ((n >> 7) == (k >> 7)) v = a->in[I_POOLW][(((size_t)l * 4 + (n >> 7)) * 128 + (k & 127)) * 128 + (n & 127)] * a->in[I_POOLS][l * 512 + n];
            wpt[e] = (bf16_t)f2bf(v);
        }
    }
    {
        f32x4* X = (f32x4*)(ws + WS_X);
        const size_t nc = (size_t)MC * D / 4, nx = (size_t)ML * D / 4;
        for (size_t e = (size_t)F.blk * 512 + F.tid; e < nc + nx; e += (size_t)F.G * 512)
            X[e] = e < nc ? ((const f32x4*)a->in[I_CTX])[e] : ((const f32x4*)a->in[I_X])[e - nc];
    }
}
__device__ __forceinline__ void pro_b(Frame& F, CArgs a) {
    const float* modp = (const float*)(F.ws + WS_MODP); float* mod = (float*)(F.ws + WS_MOD);
    for (int e = F.blk * 512 + F.tid; e < DEPTH * 5 * 12288; e += F.G * 512) {
        const int j = e % 12288, l = e / (5 * 12288);
        float s = a->in[I_BADA][l * 12288 + j];
#pragma unroll
        for (int ks = 0; ks < 16; ++ks) s += modp[(size_t)ks * DEPTH * 5 * 12288 + e];
        mod[e] = s;
    }
}
__device__ __forceinline__ void pro_c(Frame& F) {
    const int gw = F.blk * 8 + F.wave, NGW = F.G * 8, lane = F.lane;
    const float* mod = (const float*)(F.ws + WS_MOD);
    for (int row = gw; row < M; row += NGW) {
        const int bmod = row < MC ? 4 : ((row - MC) >> 11);
        const float* sh = mod + (size_t)bmod * 12288; const float* sc = sh + D;
        const f32x4* xr = (const f32x4*)((const float*)(F.ws + WS_X) + (size_t)row * D);
        u32x2* o = (u32x2*)((bf16_t*)(F.ws + WS_XM) + (size_t)row * D);
#pragma unroll
        for (int j = 0; j < 8; ++j) { const int i4 = lane + 64 * j; const f32x4 v = xr[i4], s4 = ((const f32x4*)sc)[i4], h4 = ((const f32x4*)sh)[i4];
            const f32x4 r = v * (s4 + 1.0f) + h4; u32x2 w; w.x = pk2(r[0], r[1]); w.y = pk2(r[2], r[3]); o[i4] = w; }
    }
}

__device__ __forceinline__ void prep_phase(Frame& F, CArgs a, int l) {
    unsigned char* ws = F.ws;
    const bf16_t* Z = (const bf16_t*)(ws + WS_Z);
    {
        bf16_t* P = (bf16_t*)(ws + WS_POOL);
        for (int e = F.blk * 512 + F.tid; e < M * 64; e += F.G * 512) {
            const int row = e >> 6, cg = e & 63, g = cg >> 4, w = 2 << g;
            int t, L; if (row < MC) { t = row & 255; L = CTXL; } else { t = (row - MC) & 2047; L = SEQ; }
            const int lo = max(t - (w >> 1), 0), hi = min(t + w - (w >> 1), L);
            float s[8] = {0.f, 0.f, 0.f, 0.f, 0.f, 0.f, 0.f, 0.f};
            for (int tt = lo; tt < hi; ++tt) { const u32x4 v = *(const u32x4*)(Z + (size_t)(row - t + tt) * DIN + cg * 8);
                s[0] += bflo(v.x); s[1] += bfhi(v.x); s[2] += bflo(v.y); s[3] += bfhi(v.y); s[4] += bflo(v.z); s[5] += bfhi(v.z); s[6] += bflo(v.w); s[7] += bfhi(v.w); }
            const u32x4 sv = *(const u32x4*)(Z + (size_t)row * DIN + cg * 8);
            const float inv = 1.0f / (float)(hi - lo);
            u32x4 o; o.x = pk2(s[0] * inv - bflo(sv.x), s[1] * inv - bfhi(sv.x)); o.y = pk2(s[2] * inv - bflo(sv.y), s[3] * inv - bfhi(sv.y));
            o.z = pk2(s[4] * inv - bflo(sv.z), s[5] * inv - bfhi(sv.z)); o.w = pk2(s[6] * inv - bflo(sv.w), s[7] * inv - bfhi(sv.w));
            *(u32x4*)(P + (size_t)row * 512 + cg * 8) = o;
        }
    }
    {
        const float* cw = a->in[I_CONVW] + (size_t)l * 3 * 1536; const float* cb = a->in[I_CONVB] + (size_t)l * 1536;
        float* UU = (float*)(ws + WS_UU); float* X0 = (float*)(ws + WS_X0);
        for (int e = F.blk * 512 + F.tid; e < M * 128; e += F.G * 512) {
            const int row = e >> 7, c4 = (e & 127) * 4;
            int t, L; if (row < MC) { t = row & 255; L = CTXL; } else { t = (row - MC) & 2047; L = SEQ; }
            f32x4 r3[3];
#pragma unroll
            for (int s = 0; s < 3; ++s) {
                const int ch = s * 512 + c4; f32x4 acc = *(const f32x4*)(cb + ch);
#pragma unroll
                for (int d = 0; d < 3; ++d) { const int tt = t + d - 1;
                    if (tt >= 0 && tt < L) { const u32x2 zv = *(const u32x2*)(Z + (size_t)(row + d - 1) * DIN + O_HY + ch); const f32x4 wv = *(const f32x4*)(cw + d * 1536 + ch);
                        acc[0] += wv[0] * bflo(zv.x); acc[1] += wv[1] * bfhi(zv.x); acc[2] += wv[2] * bflo(zv.y); acc[3] += wv[3] * bfhi(zv.y); } }
                r3[s] = acc; }
            *(f32x4*)(UU + (size_t)row * 512 + c4) = r3[0] * r3[2];
            *(f32x4*)(X0 + (size_t)row * 512 + c4) = r3[1];
        }
    }
    {
        bf16_t* Zw = (bf16_t*)(ws + WS_Z); bf16_t* AB = (bf16_t*)(ws + WS_ABUF); bf16_t* BB = (bf16_t*)(ws + WS_BBUF); bf16_t* KT = (bf16_t*)(ws + WS_KT);
        const float* rope = (const float*)(ws + WS_ROPE);
        LAS float* LK = (LAS float*)F.lds;
        for (int it = F.blk; it < NU * 4; it += F.G) {
            const int u = it >> 2, pg = it & 3, bh = u / 9, ci = u % 9, b = bh >> 2, h = bh & 3;
            const int row0 = chunk_row0(b, ci); const bool isctx = ci == 0;
            const float lf = ret_lg2(a->in[I_RDEC], l, h), lb = ret_lg2(a->in[I_RDEC], l, 4 + h);
            const int dbase = (pg & 1) * 32 + (pg >> 1) * 128, rbase = (pg >> 1) * 128;
            const int tok = F.tid >> 1, sub = F.tid & 1, dl0 = sub * 16, d1 = dbase + dl0, d2 = d1 + 64;
            const size_t zrow = (size_t)(row0 + tok) * DIN;
            float cs[16], sn[16];
            if (!isctx) { const float* rp = rope + (size_t)((ci - 1) * 256 + tok) * 256 + rbase + (d1 - rbase);
#pragma unroll
                for (int e = 0; e < 16; ++e) { cs[e] = rp[e]; sn[e] = rp[64 + e]; } }
            else {
#pragma unroll
                for (int e = 0; e < 16; ++e) { cs[e] = 1.f; sn[e] = 0.f; } }
            {
                bf16_t* qp = Zw + zrow + O_Q + h * 256;
                u32x4 a0 = *(const u32x4*)(qp + d1), a1 = *(const u32x4*)(qp + d1 + 8), b0 = *(const u32x4*)(qp + d2), b1 = *(const u32x4*)(qp + d2 + 8);
                const unsigned aw[8] = {a0.x, a0.y, a0.z, a0.w, a1.x, a1.y, a1.z, a1.w}, bw[8] = {b0.x, b0.y, b0.z, b0.w, b1.x, b1.y, b1.z, b1.w};
                float o1[16], o2[16];
#pragma unroll
                for (int e = 0; e < 16; ++e) { const float x1 = (e & 1) ? bfhi(aw[e >> 1]) : bflo(aw[e >> 1]), x2 = (e & 1) ? bfhi(bw[e >> 1]) : bflo(bw[e >> 1]);
                    o1[e] = x1 * cs[e] - x2 * sn[e]; o2[e] = x2 * cs[e] + x1 * sn[e]; }
                const float df = exp2f((float)(tok + 1) * lf), db = exp2f((float)(256 - tok) * lb);
                unsigned w1[8], w2[8], f1[8], f2[8], g1[8], g2[8];
#pragma unroll
                for (int e = 0; e < 8; ++e) { w1[e] = pk2(o1[2 * e], o1[2 * e + 1]); w2[e] = pk2(o2[2 * e], o2[2 * e + 1]);
                    f1[e] = pk2(o1[2 * e] * df, o1[2 * e + 1] * df); f2[e] = pk2(o2[2 * e] * df, o2[2 * e + 1] * df);
                    g1[e] = pk2(o1[2 * e] * db, o1[2 * e + 1] * db); g2[e] = pk2(o2[2 * e] * db, o2[2 * e + 1] * db); }
                *(u32x4*)(qp + d1) = (u32x4){w1[0], w1[1], w1[2], w1[3]}; *(u32x4*)(qp + d1 + 8) = (u32x4){w1[4], w1[5], w1[6], w1[7]};
                *(u32x4*)(qp + d2) = (u32x4){w2[0], w2[1], w2[2], w2[3]}; *(u32x4*)(qp + d2 + 8) = (u32x4){w2[4], w2[5], w2[6], w2[7]};
                bf16_t* ap = AB + ((size_t)u * 256 + tok) * 768;
                *(u32x4*)(ap + 256 + d1) = (u32x4){f1[0], f1[1], f1[2], f1[3]}; *(u32x4*)(ap + 256 + d1 + 8) = (u32x4){f1[4], f1[5], f1[6], f1[7]};
                *(u32x4*)(ap + 256 + d2) = (u32x4){f2[0], f2[1], f2[2], f2[3]}; *(u32x4*)(ap + 256 + d2 + 8) = (u32x4){f2[4], f2[5], f2[6], f2[7]};
                *(u32x4*)(ap + 512 + d1) = (u32x4){g1[0], g1[1], g1[2], g1[3]}; *(u32x4*)(ap + 512 + d1 + 8) = (u32x4){g1[4], g1[5], g1[6], g1[7]};
                *(u32x4*)(ap + 512 + d2) = (u32x4){g2[0], g2[1], g2[2], g2[3]}; *(u32x4*)(ap + 512 + d2 + 8) = (u32x4){g2[4], g2[5], g2[6], g2[7]};
            }
            {
                bf16_t* kp = Zw + zrow + O_K + h * 256;
                u32x4 a0 = *(const u32x4*)(kp + d1), a1 = *(const u32x4*)(kp + d1 + 8), b0 = *(const u32x4*)(kp + d2), b1 = *(const u32x4*)(kp + d2 + 8);
                const unsigned aw[8] = {a0.x, a0.y, a0.z, a0.w, a1.x, a1.y, a1.z, a1.w}, bw[8] = {b0.x, b0.y, b0.z, b0.w, b1.x, b1.y, b1.z, b1.w};
                float o1[16], o2[16];
#pragma unroll
                for (int e = 0; e < 16; ++e) { const float x1 = (e & 1) ? bfhi(aw[e >> 1]) : bflo(aw[e >> 1]), x2 = (e & 1) ? bfhi(bw[e >> 1]) : bflo(bw[e >> 1]);
                    o1[e] = (x1 * cs[e] - x2 * sn[e]) * 0.0625f; o2[e] = (x2 * cs[e] + x1 * sn[e]) * 0.0625f; }
                unsigned w1[8], w2[8];
#pragma unroll
                for (int e = 0; e < 8; ++e) { w1[e] = pk2(o1[2 * e], o1[2 * e + 1]); w2[e] = pk2(o2[2 * e], o2[2 * e + 1]); }
                *(u32x4*)(kp + d1) = (u32x4){w1[0], w1[1], w1[2], w1[3]}; *(u32x4*)(kp + d1 + 8) = (u32x4){w1[4], w1[5], w1[6], w1[7]};
                *(u32x4*)(kp + d2) = (u32x4){w2[0], w2[1], w2[2], w2[3]}; *(u32x4*)(kp + d2 + 8) = (u32x4){w2[4], w2[5], w2[6], w2[7]};
#pragma unroll
                for (int e = 0; e < 16; ++e) { LK[(dl0 + e) * 257 + tok] = o1[e]; LK[(32 + dl0 + e) * 257 + tok] = o2[e]; }
            }
            __syncthreads();
            {
                const int dl = F.tid & 63, seg = F.tid >> 6, dg = dl < 32 ? dbase + dl : dbase + 64 + (dl - 32);
                bf16_t* kf = KT + ((size_t)u * 512 + dg) * 256 + seg * 32; bf16_t* kb = KT + ((size_t)u * 512 + 256 + dg) * 256 + seg * 32;
                unsigned wf[16], wb[16];
#pragma unroll
                for (int j = 0; j < 16; ++j) { const int t0 = seg * 32 + 2 * j; const float v0 = LK[dl * 257 + t0], v1 = LK[dl * 257 + t0 + 1];
                    wf[j] = pk2(v0 * exp2f((float)(255 - t0) * lf), v1 * exp2f((float)(254 - t0) * lf));
                    wb[j] = pk2(v0 * exp2f((float)t0 * lb), v1 * exp2f((float)(t0 + 1) * lb)); }
#pragma unroll
                for (int j = 0; j < 4; ++j) { *(u32x4*)(kf + 8 * j) = (u32x4){wf[4 * j], wf[4 * j + 1], wf[4 * j + 2], wf[4 * j + 3]}; *(u32x4*)(kb + 8 * j) = (u32x4){wb[4 * j], wb[4 * j + 1], wb[4 * j + 2], wb[4 * j + 3]}; }
            }
            __syncthreads();
            {
                const bf16_t* vp = Z + zrow + O_V + h * 256;
                u32x4 a0 = *(const u32x4*)(vp + d1), a1 = *(const u32x4*)(vp + d1 + 8), b0 = *(const u32x4*)(vp + d2), b1 = *(const u32x4*)(vp + d2 + 8);
                const unsigned aw[8] = {a0.x, a0.y, a0.z, a0.w, a1.x, a1.y, a1.z, a1.w}, bw[8] = {b0.x, b0.y, b0.z, b0.w, b1.x, b1.y, b1.z, b1.w};
#pragma unroll
                for (int e = 0; e < 16; ++e) { LK[(dl0 + e) * 257 + tok] = (e & 1) ? bfhi(aw[e >> 1]) : bflo(aw[e >> 1]); LK[(32 + dl0 + e) * 257 + tok] = (e & 1) ? bfhi(bw[e >> 1]) : bflo(bw[e >> 1]); }
            }
            __syncthreads();
            {
                const int dl = F.tid & 63, seg = F.tid >> 6, dg = dl < 32 ? dbase + dl : dbase + 64 + (dl - 32);
                bf16_t* vt = BB + ((size_t)u * 256 + dg) * 768 + seg * 32;
                unsigned wv[16];
#pragma unroll
                for (int j = 0; j < 16; ++j) { const int t0 = seg * 32 + 2 * j; wv[j] = pk2(LK[dl * 257 + t0], LK[dl * 257 + t0 + 1]); }
#pragma unroll
                for (int j = 0; j < 4; ++j) *(u32x4*)(vt + 8 * j) = (u32x4){wv[4 * j], wv[4 * j + 1], wv[4 * j + 2], wv[4 * j + 3]};
            }
            __syncthreads();
        }
    }
}

__device__ __forceinline__ void scan_phase(Frame& F, CArgs a, int l) {
    const float* UT = (const float*)(F.ws + WS_UT); bf16_t* BB = (bf16_t*)(F.ws + WS_BBUF);
    for (int e = F.blk * 512 + F.tid; e < 16 * 2 * 16384; e += F.G * 512) {
        const int q = e & 16383, dir = (e >> 14) & 1, bh = e >> 15, dv = q >> 6, dk4 = (q & 63) * 4, h = bh & 3;
        const float cdec = exp2f(256.0f * ret_lg2(a->in[I_RDEC], l, dir * 4 + h));
        f32x4 S = (f32x4){0.f, 0.f, 0.f, 0.f};
#pragma unroll 1
        for (int s = 0; s < 9; ++s) {
            const int ci = dir == 0 ? s : (s == 0 ? 0 : 9 - s);
            const int u = bh * 9 + ci;
            u32x2 w; w.x = pk2(S[0], S[1]); w.y = pk2(S[2], S[3]);
            *(u32x2*)(BB + ((size_t)u * 256 + dv) * 768 + 256 + dir * 256 + dk4) = w;
            const f32x4 uv = *(const f32x4*)(UT + ((size_t)u * 256 + dv) * 512 + dir * 256 + dk4);
            S = S * cdec + uv;
        }
    }
}

__device__ __forceinline__ void conv_phase(Frame& F, CArgs a, int l) {
    const float* UU = (const float*)(F.ws + WS_UU); const float* X0 = (const float*)(F.ws + WS_X0); bf16_t* Y = (bf16_t*)(F.ws + WS_Y);
    const int c = F.tid; const float hd = a->in[I_HYD][l * 512 + c];
    for (int it = F.blk; it < 576; it += F.G) {
        int L, rowb, t0; const float* filt;
        if (it < 512) { const int b = it >> 7; L = SEQ; rowb = MC + b * SEQ; t0 = (it & 127) * 16; filt = (const float*)(F.ws + WS_FILT) + (size_t)l * SEQ * 1024; }
        else { const int j = it - 512, b = j >> 4; L = CTXL; rowb = b * CTXL; t0 = (j & 15) * 16; filt = (const float*)(F.ws + WS_FILTC) + (size_t)l * CTXL * 1024; }
        float y[16];
#pragma unroll
        for (int j = 0; j < 16; ++j) y[j] = 0.f;
        for (int s0 = 0; s0 < L; s0 += 16) {
            const int d0 = t0 - s0;
            float kk[31], uv[16];
#pragma unroll
            for (int i = 0; i < 31; ++i) { const int d = d0 - 15 + i; const int idx = d >= 0 ? d * 1024 + c : (-d) * 1024 + 512 + c; kk[i] = filt[idx]; }
#pragma unroll
            for (int ss = 0; ss < 16; ++ss) uv[ss] = UU[(size_t)(rowb + s0 + ss) * 512 + c];
#pragma unroll
            for (int j = 0; j < 16; ++j)
#pragma unroll
                for (int ss = 0; ss < 16; ++ss) y[j] += kk[j - ss + 15] * uv[ss];
        }
#pragma unroll
        for (int j = 0; j < 16; ++j) { const size_t row = (size_t)(rowb + t0 + j); const float u0 = UU[row * 512 + c], x0 = X0[row * 512 + c];
            Y[row * D + 512 + c] = (bf16_t)f2bf((y[j] + u0 * hd) * x0); }
    }
}

__device__ __forceinline__ void gn_phase(Frame& F) {
    const int gw = F.blk * 8 + F.wave, NGW = F.G * 8, lane = F.lane;
    const float* OB = (const float*)(F.ws + WS_OBUF); const bf16_t* Z = (const bf16_t*)(F.ws + WS_Z); bf16_t* Y = (bf16_t*)(F.ws + WS_Y);
    for (int it = gw; it < NU * 256; it += NGW) {
        const int u = it >> 8, tok = it & 255, bh = u / 9, ci = u % 9, b = bh >> 2, h = bh & 3;
        const size_t row = (size_t)(chunk_row0(b, ci) + tok);
        const f32x4 v = *(const f32x4*)(OB + (size_t)it * 256 + lane * 4);
        const float mean = wave_sum((v[0] + v[1]) + (v[2] + v[3])) * (1.0f / 256.0f);
        const f32x4 dv = v - mean;
        const float var = wave_sum((dv[0] * dv[0] + dv[1] * dv[1]) + (dv[2] * dv[2] + dv[3] * dv[3])) * (1.0f / 256.0f);
        const float rstd = 1.0f / sqrtf(var + GN_EPS);
        const u32x2 gz = *(const u32x2*)(Z + row * DIN + O_G + h * 256 + lane * 4);
        const float g0 = silu_f(bflo(gz.x)), g1 = silu_f(bfhi(gz.x)), g2 = silu_f(bflo(gz.y)), g3 = silu_f(bfhi(gz.y));
        u32x2 w; w.x = pk2(dv[0] * rstd * g0, dv[1] * rstd * g1); w.y = pk2(dv[2] * rstd * g2, dv[3] * rstd * g3);
        *(u32x2*)(Y + row * D + 1024 + h * 256 + lane * 4) = w;
    }
}

__device__ __forceinline__ void ln_phase(Frame& F, CArgs a, int l, int which) {
    const int gw = F.blk * 8 + F.wave, NGW = F.G * 8, lane = F.lane;
    const float* S = (const float*)(F.ws + WS_S); float* X = (float*)(F.ws + WS_X); bf16_t* XM = (bf16_t*)(F.ws + WS_XM);
    const float* g = (which == 0 ? a->in[I_LN1G] : a->in[I_LN2G]) + (size_t)l * D; const float* bb = (which == 0 ? a->in[I_LN1B] : a->in[I_LN2B]) + (size_t)l * D;
    const bool last = (which == 1 && l == DEPTH - 1);
    const float* mod = (const float*)(F.ws + WS_MOD) + (size_t)(which == 0 ? l : (last ? l : l + 1)) * 5 * 12288 + (which == 0 ? 3 * D : 0);
    for (int row = gw; row < M; row += NGW) {
        if (last && row < MC) continue;
        const int bmod = row < MC ? 4 : ((row - MC) >> 11);
        const f32x4* sr = (const f32x4*)(S + (size_t)row * D);
        f32x4 v[8]; float s = 0.f;
#pragma unroll
        for (int j = 0; j < 8; ++j) { v[j] = sr[lane + 64 * j]; s += (v[j][0] + v[j][1]) + (v[j][2] + v[j][3]); }
        const float mean = wave_sum(s) * (1.0f / D); float q = 0.f;
#pragma unroll
        for (int j = 0; j < 8; ++j) { v[j] = v[j] - mean; q += (v[j][0] * v[j][0] + v[j][1] * v[j][1]) + (v[j][2] * v[j][2] + v[j][3] * v[j][3]); }
        const float rstd = 1.0f / sqrtf(wave_sum(q) * (1.0f / D) + LN_EPS);
        const float* sh = mod + (size_t)bmod * 12288; const float* sc = sh + D;
        f32x4* xo = last ? (f32x4*)(a->out + (size_t)(row - MC) * D) : (f32x4*)(X + (size_t)row * D);
        u32x2* xm = (u32x2*)(XM + (size_t)row * D);
#pragma unroll
        for (int j = 0; j < 8; ++j) { const int i4 = lane + 64 * j; const f32x4 y = v[j] * rstd * ((const f32x4*)g)[i4] + ((const f32x4*)bb)[i4];
            xo[i4] = y;
            if (!last) { const f32x4 r = y * (((const f32x4*)sc)[i4] + 1.0f) + ((const f32x4*)sh)[i4]; u32x2 w; w.x = pk2(r[0], r[1]); w.y = pk2(r[2], r[3]); xm[i4] = w; } }
    }
}

struct ScoresOrder {
    const char* Z; int G, c;
    __device__ __forceinline__ bool next(int i, pg8::Unit& u) const { const int L = i * G + c; if (L >= NU) return false; u.z = L; u.pm = 0; u.pn = 0; return true; }
    __device__ __forceinline__ size_t rowoff(const pg8::Unit& u) const { const int bh = u.z / 9, ci = u.z % 9; return (size_t)chunk_row0(bh >> 2, ci) * DIN + (bh & 3) * 256; }
    __device__ __forceinline__ const char* aptr(const pg8::Unit& u) const { return Z + (rowoff(u) + O_Q) * 2; }
    __device__ __forceinline__ const char* bptr(const pg8::Unit& u) const { return Z + (rowoff(u) + O_K) * 2; }
};
struct UtOrder {
    const char* BB; const char* KT; int G, c;
    __device__ __forceinline__ bool next(int i, pg8::Unit& u) const { const int L = i * G + c; if (L >= NU * 2) return false; u.z = L >> 1; u.pm = 0; u.pn = L & 1; return true; }
    __device__ __forceinline__ const char* aptr(const pg8::Unit& u) const { return BB + (size_t)u.z * 256 * 768 * 2; }
    __device__ __forceinline__ const char* bptr(const pg8::Unit& u) const { return KT + ((size_t)u.z * 512 + u.pn * 256) * 256 * 2; }
};
struct OutOrder {
    const char* AB; const char* BB; int G, c;
    __device__ __forceinline__ bool next(int i, pg8::Unit& u) const { const int L = i * G + c; if (L >= NU) return false; u.z = L; u.pm = 0; u.pn = 0; return true; }
    __device__ __forceinline__ const char* aptr(const pg8::Unit& u) const { return AB + (size_t)u.z * 256 * 768 * 2; }
    __device__ __forceinline__ const char* bptr(const pg8::Unit& u) const { return BB + (size_t)u.z * 256 * 768 * 2; }
};

constexpr int PH_PER_LAYER = 12, N_PHASES = 3 + DEPTH * PH_PER_LAYER;

__global__ void __launch_bounds__(512, 2) mk_fwd(Args args_unused) {
    extern __shared__ __attribute__((aligned(16))) unsigned char lds_raw[];
    (void)args_unused;
    CArgs ap = (CArgs)__builtin_amdgcn_kernarg_segment_ptr();
    Frame F;
    F.lds = (LAS unsigned char*)lds_raw;
    F.tid = threadIdx.x; F.lane = F.tid & 63; F.wave = __builtin_amdgcn_readfirstlane(F.tid >> 6);
    F.blk = blockIdx.x; F.G = gridDim.x; F.ws = ap->ws;
    volatile LAS unsigned* MISC = (volatile LAS unsigned*)(F.lds + MISC_OFF);
    if (F.tid < 64) MISC[F.tid] = 0u;
    __syncthreads();
#if MK_PER_PHASE
#define GRID_BAR() do { } while (0)
#else
    XcdBarrier bar = xcd_barrier_post((unsigned*)(ap->ws + WS_CTL) + 4096, MISC + 8);
#define GRID_BAR() xcd_barrier(bar)
#endif
    const int lo = ap->ph_lo, hi = ap->ph_hi;
#define IN(k) (lo <= (k) && (k) < hi)
#define SEAM(k) do { if (IN(k) && IN((k) + 1)) GRID_BAR(); } while (0)
#define LAUNDER() do { int _t = F.tid; asm volatile("" : "+v"(_t)); F.tid = _t; F.lane = _t & 63; F.wave = __builtin_amdgcn_readfirstlane(_t >> 6); \
        asm volatile("" : "+s"(ap)); unsigned char* _w = ap->ws; asm volatile("" : "+s"(_w)); F.ws = _w; ws = _w; } while (0)
    unsigned char* ws = F.ws;

    if (IN(0)) { LAUNDER(); pro_a(F, ap); } SEAM(0);
    if (IN(1)) { LAUNDER(); pro_b(F, ap); } SEAM(1);
    if (IN(2)) { LAUNDER(); pro_c(F); } SEAM(2);

#pragma unroll 1
    for (int l = 0; l < DEPTH; ++l) {
        const int p0 = 3 + l * PH_PER_LAYER;
        if (IN(p0 + 0)) {
            LAUNDER();
            pg8::BigOrder S; S.init(ws + WS_XM, (const bf16_t*)(ws + WS_WIN) + (size_t)l * DIN * D, D, D, M, DIN, F.G, F.blk);
            pg8::EpiBf16<0> E{(bf16_t*)(ws + WS_Z), DIN, ap->in[I_BIN] + (size_t)l * DIN};
            pg8::gemm_phase<pg8::EpiBf16<0>, pg8::BigOrder, true, true>(F.lds, F.tid, pg8::Gemm{D, D, D}, S, E);
        }
        SEAM(p0 + 0);
        if (IN(p0 + 1)) { LAUNDER(); prep_phase(F, ap, l); }
        SEAM(p0 + 1);
        if (IN(p0 + 2)) {
            {
                LAUNDER();
                pg8::BigOrder S; S.init(ws + WS_POOL, (const bf16_t*)(ws + WS_WPT) + (size_t)l * 512 * 512, 512, 512, M, 512, F.G, F.blk);
                pg8::EpiBf16<0> E{(bf16_t*)(ws + WS_Y), D, nullptr};
                pg8::gemm_phase<pg8::EpiBf16<0>, pg8::BigOrder, true, true>(F.lds, F.tid, pg8::Gemm{512, 512, 512}, S, E);
            }
            {
                LAUNDER();
                ScoresOrder S{(const char*)(ws + WS_Z), F.G, (F.blk + 72) % F.G};
                pg8::EpiScores E{(bf16_t*)(ws + WS_ABUF), ap->in[I_RDEC] + l * 8};
                pg8::gemm_phase<pg8::EpiScores, ScoresOrder, true, true>(F.lds, F.tid, pg8::Gemm{DIN, DIN, 256}, S, E);
            }
            {
                LAUNDER();
                UtOrder S{(const char*)(ws + WS_BBUF), (const char*)(ws + WS_KT), F.G, (F.blk + 216) % F.G};
                pg8::EpiF32 E{(float*)(ws + WS_UT), 512, (size_t)256 * 512};
                pg8::gemm_phase<pg8::EpiF32, UtOrder, true, true>(F.lds, F.tid, pg8::Gemm{768, 256, 256}, S, E);
            }
        }
        SEAM(p0 + 2);
        if (IN(p0 + 3)) { LAUNDER(); scan_phase(F, ap, l); LAUNDER(); conv_phase(F, ap, l); }
        SEAM(p0 + 3);
        if (IN(p0 + 4)) {
            LAUNDER();
            OutOrder S{(const char*)(ws + WS_ABUF), (const char*)(ws + WS_BBUF), F.G, F.blk};
            pg8::EpiF32 E{(float*)(ws + WS_OBUF), 256, (size_t)256 * 256};
            pg8::gemm_phase<pg8::EpiF32, OutOrder, true, true>(F.lds, F.tid, pg8::Gemm{768, 768, 768}, S, E);
        }
        SEAM(p0 + 4);
        if (IN(p0 + 5)) { LAUNDER(); gn_phase(F); }
        SEAM(p0 + 5);
        if (IN(p0 + 6)) {
            { LAUNDER(); const bf16_t* PT = (const bf16_t*)(ws + WS_PT) + (size_t)l * D * D; const bf16_t* Y = (const bf16_t*)(ws + WS_Y);
              pg8::BigOrder S; S.init(Y, PT, D, D, M, D, F.G, F.blk); pg8::EpiGate<0> E{(const bf16_t*)(ws + WS_Z), (float*)(ws + WS_MGF), (bf16_t*)(ws + WS_MG)};
              pg8::gemm_phase<pg8::EpiGate<0>, pg8::BigOrder, true, true>(F.lds, F.tid, pg8::Gemm{D, D, 512}, S, E); }
            { LAUNDER(); const bf16_t* PT = (const bf16_t*)(ws + WS_PT) + (size_t)l * D * D; const bf16_t* Y = (const bf16_t*)(ws + WS_Y);
              pg8::BigOrder S; S.init(Y + 512, PT + 512, D, D, M, D, F.G, F.blk); pg8::EpiGate<1> E{(const bf16_t*)(ws + WS_Z), (float*)(ws + WS_MGF), (bf16_t*)(ws + WS_MG)};
              pg8::gemm_phase<pg8::EpiGate<1>, pg8::BigOrder, true, true>(F.lds, F.tid, pg8::Gemm{D, D, 512}, S, E); }
            { LAUNDER(); const bf16_t* PT = (const bf16_t*)(ws + WS_PT) + (size_t)l * D * D; const bf16_t* Y = (const bf16_t*)(ws + WS_Y);
              pg8::BigOrder S; S.init(Y + 1024, PT + 1024, D, D, M, D, F.G, F.blk); pg8::EpiGate<2> E{(const bf16_t*)(ws + WS_Z), (float*)(ws + WS_MGF), (bf16_t*)(ws + WS_MG)};
              pg8::gemm_phase<pg8::EpiGate<2>, pg8::BigOrder, true, true>(F.lds, F.tid, pg8::Gemm{D, D, 1024}, S, E); }
        }
        SEAM(p0 + 6);
        if (IN(p0 + 7)) {
            LAUNDER();
            pg8::BigOrder S; S.init(ws + WS_MG, (const bf16_t*)(ws + WS_WO) + (size_t)l * D * D, D, D, M, D, F.G, F.blk);
            pg8::EpiResid E{(const float*)(ws + WS_X), (float*)(ws + WS_S), ap->in[I_BO] + (size_t)l * D, (const float*)(ws + WS_MOD) + (size_t)l * 5 * 12288 + 2 * D};
            pg8::gemm_phase<pg8::EpiResid, pg8::BigOrder, true, true>(F.lds, F.tid, pg8::Gemm{D, D, D}, S, E);
        }
        SEAM(p0 + 7);
        if (IN(p0 + 8)) { LAUNDER(); ln_phase(F, ap, l, 0); }
        SEAM(p0 + 8);
        if (IN(p0 + 9)) {
            LAUNDER();
            pg8::BigOrder S; S.init(ws + WS_XM, (const bf16_t*)(ws + WS_W1) + (size_t)l * DFF * D, D, D, M, DFF, F.G, F.blk);
            pg8::EpiBf16<1> E{(bf16_t*)(ws + WS_H), DFF, ap->in[I_B1] + (size_t)l * DFF};
            pg8::gemm_phase<pg8::EpiBf16<1>, pg8::BigOrder, true, true>(F.lds, F.tid, pg8::Gemm{D, D, D}, S, E);
        }
        SEAM(p0 + 9);
        if (IN(p0 + 10)) {
            LAUNDER();
            pg8::BigOrder S; S.init(ws + WS_H, (const bf16_t*)(ws + WS_W2) + (size_t)l * D * DFF, DFF, DFF, M, D, F.G, F.blk);
            pg8::EpiResid E{(const float*)(ws + WS_X), (float*)(ws + WS_S), ap->in[I_B2] + (size_t)l * D, (const float*)(ws + WS_MOD) + (size_t)l * 5 * 12288 + 5 * D};
            pg8::gemm_phase<pg8::EpiResid, pg8::BigOrder, true, true>(F.lds, F.tid, pg8::Gemm{DFF, DFF, DFF}, S, E);
        }
        SEAM(p0 + 10);
        if (IN(p0 + 11)) { LAUNDER(); ln_phase(F, ap, l, 1); }
        SEAM(p0 + 11);
    }
#undef IN
#undef SEAM
#undef LAUNDER
}

extern "C" void kernel_launch(void* const* d_in, const int* in_sizes, int n_in, void* d_out, int out_size, void* d_ws, size_t ws_size, hipStream_t stream) {
    static int grid = 0;
    if (grid == 0) {
        if (n_in != 37 || out_size != ML * D || ws_size < WS_END) { fprintf(stderr, "kernel_launch: unexpected shapes (n_in %d, out %d, ws %zu)\n", n_in, out_size, ws_size); grid = -1; return; }
        int dev = 0, cus = 0, per_cu = 0;
        if (hipGetDevice(&dev) != hipSuccess || hipDeviceGetAttribute(&cus, hipDeviceAttributeMultiprocessorCount, dev) != hipSuccess) { grid = -1; return; }
        if (hipFuncSetAttribute((const void*)mk_fwd, hipFuncAttributeMaxDynamicSharedMemorySize, LDS_BYTES) != hipSuccess) { fprintf(stderr, "kernel_launch: hipFuncSetAttribute failed\n"); grid = -1; return; }
        if (hipOccupancyMaxActiveBlocksPerMultiprocessor(&per_cu, (const void*)mk_fwd, 512, LDS_BYTES) != hipSuccess || per_cu < 1) { fprintf(stderr, "kernel_launch: occupancy query says %d\n", per_cu); }
        (void)hipGetLastError();
        grid = cus;
    }
    if (grid < 0) return;
    (void)hipMemsetAsync((char*)d_ws + WS_CTL, 0, 1 * MiB, stream);
    Args a{};
    for (int i = 0; i < 37; ++i) a.in[i] = (const float*)d_in[i];
    a.out = (float*)d_out; a.ws = (unsigned char*)d_ws;
#if MK_PER_PHASE
    for (int p = 0; p < N_PHASES; ++p) { a.ph_lo = p; a.ph_hi = p + 1; hipLaunchKernelGGL(mk_fwd, dim3(grid), dim3(512), LDS_BYTES, stream, a); }
#else
    a.ph_lo = 0; a.ph_hi = N_PHASES;
    hipLaunchKernelGGL(mk_fwd, dim3(grid), dim3(512), LDS_BYTES, stream, a);
#endif
}
```

```cpp
#include <hip/hip_runtime.h>
#include <cstdio>
#include <cstdint>

#ifndef MK_PER_PHASE
#define MK_PER_PHASE 0
#endif

#define LAS __attribute__((address_space(3)))
#define GAS __attribute__((address_space(1)))
typedef unsigned short bf16_t;
typedef short bf16x8 __attribute__((ext_vector_type(8)));
typedef float f32x4 __attribute__((ext_vector_type(4)));
typedef float f32x2 __attribute__((ext_vector_type(2)));
typedef unsigned u32x4 __attribute__((ext_vector_type(4)));
typedef unsigned u32x2 __attribute__((ext_vector_type(2)));

constexpr int D = 2048, NB = 4, SEQ = 2048, DEPTH = 4, CTXL = 256;
constexpr int MC = NB * CTXL, ML = NB * SEQ, M = MC + ML;
constexpr int DIN = 12288, DFF = 8192;
constexpr int O_HY = 512, O_Q = 2048, O_K = 3072, O_V = 4096, O_G = 5120, O_GATE = 6144;
constexpr int NU = 144;
constexpr float LN_EPS = 1e-5f, GN_EPS = 1e-6f;
constexpr float ALPHA = 1.6817928305074290f;

constexpr size_t MiB = 1u << 20;
constexpr size_t WS_CTL = 0;
constexpr size_t WS_MOD = 1 * MiB;
constexpr size_t WS_ROPE = 2 * MiB;
constexpr size_t WS_MODP = 4 * MiB;
constexpr size_t WS_FILT = 20 * MiB;
constexpr size_t WS_FILTC = 52 * MiB;
constexpr size_t WS_WPT = 56 * MiB;
constexpr size_t WS_WIN = 58 * MiB;
constexpr size_t WS_PT = 250 * MiB;
constexpr size_t WS_WO = 282 * MiB;
constexpr size_t WS_W1 = 314 * MiB;
constexpr size_t WS_W2 = 442 * MiB;
constexpr size_t WS_X = 570 * MiB;
constexpr size_t WS_XM = 642 * MiB;
constexpr size_t WS_Z = 678 * MiB;
constexpr size_t WS_H = WS_Z;
constexpr size_t WS_Y = 894 * MiB;
constexpr size_t WS_UU = 930 * MiB;
constexpr size_t WS_X0 = 948 * MiB;
constexpr size_t WS_POOL = 966 * MiB;
constexpr size_t WS_ABUF = 976 * MiB;
constexpr size_t WS_BBUF = 1030 * MiB;
constexpr size_t WS_KT = 1084 * MiB;
constexpr size_t WS_UT = 1120 * MiB;
constexpr size_t WS_OBUF = 1192 * MiB;
constexpr size_t WS_MGF = 1228 * MiB;
constexpr size_t WS_S = WS_MGF;
constexpr size_t WS_MG = 1300 * MiB;
constexpr size_t WS_END = 1336 * MiB;

constexpr int RING_BYTES = 131072;
constexpr int MISC_OFF = RING_BYTES;
constexpr int LDS_BYTES = 147456;

#define RLX_AGENT __ATOMIC_RELAXED, __HIP_MEMORY_SCOPE_AGENT
#define LDS_WAIT() asm volatile("s_waitcnt lgkmcnt(0)" ::: "memory")
#define VM_WAIT() asm volatile("s_waitcnt vmcnt(0)" ::: "memory")

__device__ __forceinline__ unsigned f2bf(float f) { unsigned u = __builtin_bit_cast(unsigned, f); return (u + 0x7fffu + ((u >> 16) & 1u)) >> 16; }
__device__ __forceinline__ unsigned pk2(float lo, float hi) { return f2bf(lo) | (f2bf(hi) << 16); }
__device__ __forceinline__ float bflo(unsigned w) { return __builtin_bit_cast(float, w << 16); }
__device__ __forceinline__ float bfhi(unsigned w) { return __builtin_bit_cast(float, w & 0xffff0000u); }
__device__ __forceinline__ float bf1(bf16_t h) { return __builtin_bit_cast(float, ((unsigned)h) << 16); }

namespace pg8 {
constexpr int BM = 256, BK = 64, HALF = 128, HTB = HALF * BK * 2, STAGE_BYTES = 8 * HTB, NXCD = 8, WGM = 8;
__host__ __device__ __forceinline__ int lds_byte(int r, int c) { const int st = (r >> 4) * 2 + (c >> 5), rr = r & 15, cc = c & 31, ob = rr * 64 + cc * 2; return st * 1024 + (ob ^ (((ob >> 9) & 1) << 5)); }
__host__ __device__ __forceinline__ void stage_rc(int b, int& R, int& C) { const int st = b / 1024, sb = b % 1024, swz = sb ^ (((sb >> 9) & 1) << 5); R = (st >> 1) * 16 + swz / 64; C = (st & 1) * 32 + (swz % 64) / 2; }
__host__ __device__ __forceinline__ int perm32(int rho) { const int n = rho >> 4, i = rho & 15; return 8 * (i >> 2) + 4 * n + (i & 3); }

struct Unit { int pm, pn, z; };
struct Gemm { int lda, ldb, K; };

__device__ __forceinline__ unsigned cvt_pk_bf16(float lo, float hi) { unsigned r; asm volatile("v_cvt_pk_bf16_f32 %0, %1, %2" : "=v"(r) : "v"(lo), "v"(hi)); return r; }

struct BigOrder {
    const char* A; const char* B; size_t astep, bstep; int nM, nN, nwg, G, c;
    __device__ __forceinline__ void init(const void* A_, const void* B_, int lda, int ldb, int M_, int N_, int G_, int c_) {
        A = (const char*)A_; B = (const char*)B_; astep = (size_t)BM * lda * 2; bstep = (size_t)BM * ldb * 2; nM = M_ / BM; nN = N_ / BM; nwg = nM * nN; G = G_; c = c_; }
    __device__ __forceinline__ bool next(int i, Unit& u) const {
        const long L = (long)i * G + c; if (L >= nwg) return false;
        int wgid = (int)L; { const int q = nwg / NXCD, r = nwg % NXCD, xcd = wgid % NXCD, off = wgid / NXCD; wgid = (xcd < r ? xcd * (q + 1) : r * (q + 1) + (xcd - r) * q) + off; }
        const int nig = WGM * nN, gid = wgid / nig, fm = gid * WGM, gsz = (nM - fm) < WGM ? (nM - fm) : WGM;
        u.pm = fm + ((wgid % nig) % gsz); u.pn = (wgid % nig) / gsz; u.z = 0; return true;
    }
    __device__ __forceinline__ const char* aptr(const Unit& u) const { return A + (size_t)u.pm * astep; }
    __device__ __forceinline__ const char* bptr(const Unit& u) const { return B + (size_t)u.pn * bstep; }
};

template <class Epi, class Sched, bool ALIGN_EPI, bool SP2>
__device__ __forceinline__ void gemm_phase(LAS unsigned char* lds, const int tid, const Gemm g, const Sched& S, const Epi& E) {
    const int wid = __builtin_amdgcn_readfirstlane(tid >> 6), lane = tid & 63, wr = wid >> 2, wc = wid & 3, fr = lane & 15, fq = lane >> 4;
    const int K = g.K, nt = K / BK;
    unsigned voffA[2], voffB[2];
#pragma unroll
    for (int i = 0; i < 2; ++i) { int R, C; stage_rc(tid * 16 + i * 8192, R, C); const int Rb = Epi::PERM ? ((R & ~31) + perm32(R & 31)) : R;
        voffA[i] = (unsigned)(R * g.lda + C) * 2u; voffB[i] = (unsigned)(Rb * g.ldb + C) * 2u; }
    const size_t kstep = (size_t)(BK * 2);
    const size_t hstepA = (size_t)HALF * g.lda * 2, hstepB = (size_t)HALF * g.ldb * 2;
    const unsigned ldsw = (unsigned)wid * 1024u;
    const int aoff = lds_byte(wr * 64 + fr, fq * 8), boff = lds_byte(wc * 32 + fr, fq * 8);
#define PG8_SA(b, h) (((b) * 2 + (h)) * HTB)
#define PG8_SB(b, h) ((4 + (b) * 2 + (h)) * HTB)
#define PG8_STAGE(bufoff, gbase, voff) do { _Pragma("unroll") for (int _i = 0; _i < 2; ++_i) \
        __builtin_amdgcn_global_load_lds((const unsigned*)((const char*)(gbase) + (voff)[_i]), (LAS unsigned*)(lds + (bufoff) + ldsw + _i * 8192), 16, 0, 0); } while (0)
#define PG8_LDA(dst, b, h) do { _Pragma("unroll") for (int m = 0; m < 4; ++m) _Pragma("unroll") for (int k = 0; k < 2; ++k) dst[m][k] = *(const LAS bf16x8*)(lds + PG8_SA(b, h) + aoff + m * 2048 + k * 1024); } while (0)
#define PG8_LDB(dst, b, h) do { _Pragma("unroll") for (int n = 0; n < 2; ++n) _Pragma("unroll") for (int k = 0; k < 2; ++k) dst[n][k] = *(const LAS bf16x8*)(lds + PG8_SB(b, h) + boff + n * 2048 + k * 1024); } while (0)
#define PG8_MMA(ai, bj, At, Bt) do { __builtin_amdgcn_s_setprio(1); _Pragma("unroll") for (int m = 0; m < 4; ++m) _Pragma("unroll") for (int n = 0; n < 2; ++n) _Pragma("unroll") for (int k = 0; k < 2; ++k) \
        acc[ai][bj][m][n] = __builtin_amdgcn_mfma_f32_16x16x32_bf16(Bt[n][k], At[m][k], acc[ai][bj][m][n], 0, 0, 0); __builtin_amdgcn_s_setprio(0); } while (0)
#define PG8_WAIT_V(n) asm volatile("s_waitcnt vmcnt(" #n ")" ::: "memory")
#define PG8_WAIT_L(n) asm volatile("s_waitcnt lgkmcnt(" #n ")" ::: "memory")
#define PG8_BAR __builtin_amdgcn_s_barrier()
#define PG8_SCHED __builtin_amdgcn_sched_barrier(0)
    Unit cur, nxt; int ui = 0;
    if (!S.next(0, cur)) return;
    f32x4 acc[2][2][4][2];
#pragma unroll
    for (int a = 0; a < 2; ++a)
#pragma unroll
        for (int b = 0; b < 2; ++b)
#pragma unroll
            for (int m = 0; m < 4; ++m)
#pragma unroll
                for (int n = 0; n < 2; ++n) acc[a][b][m][n] = (f32x4){0.f, 0.f, 0.f, 0.f};
    bf16x8 At[4][2], B0[2][2], B1[2][2];
    const char* cA = S.aptr(cur); const char* cB = S.bptr(cur);
    if constexpr (SP2) {
        PG8_STAGE(PG8_SB(0, 0), cB, voffB); PG8_STAGE(PG8_SB(0, 1), cB + hstepB, voffB); PG8_STAGE(PG8_SA(0, 0), cA, voffA); PG8_STAGE(PG8_SA(0, 1), cA + hstepA, voffA);
        if (wr == 1) PG8_BAR;
        PG8_WAIT_V(2); PG8_BAR;
        PG8_STAGE(PG8_SB(1, 0), cB + kstep, voffB); PG8_STAGE(PG8_SA(1, 0), cA + kstep, voffA); PG8_STAGE(PG8_SB(1, 1), cB + hstepB + kstep, voffB);
        PG8_WAIT_V(6); PG8_BAR;
    } else {
        PG8_STAGE(PG8_SB(0, 0), cB, voffB); PG8_STAGE(PG8_SA(0, 0), cA, voffA); PG8_STAGE(PG8_SB(0, 1), cB + hstepB, voffB); PG8_STAGE(PG8_SA(0, 1), cA + hstepA, voffA);
        if (wr == 1) PG8_BAR;
        PG8_WAIT_V(4); PG8_BAR;
        PG8_STAGE(PG8_SB(1, 0), cB + kstep, voffB); PG8_STAGE(PG8_SA(1, 0), cA + kstep, voffA); PG8_STAGE(PG8_SB(1, 1), cB + hstepB + kstep, voffB);
        PG8_WAIT_V(6); PG8_BAR;
    }
    for (;;) {
        const bool has_next = S.next(ui + 1, nxt);
        const char* nA = has_next ? S.aptr(nxt) : cA; const char* nB = has_next ? S.bptr(nxt) : cB;
#pragma unroll 1
        for (int t = 0; t < nt; t += 2) {
            const bool last = (t == nt - 2);
            const char* a1 = cA + (size_t)(t + 1) * kstep;
            const char* a2 = last ? nA : cA + (size_t)(t + 2) * kstep; const char* b2 = last ? nB : cB + (size_t)(t + 2) * kstep;
            const char* a3 = a2 + kstep; const char* b3 = b2 + kstep;
            if constexpr (SP2) {
            PG8_LDB(B0, 0, 0); PG8_LDB(B1, 0, 1); PG8_SCHED; PG8_LDA(At, 0, 0); PG8_STAGE(PG8_SA(1, 1), a1 + hstepA, voffA);
            PG8_WAIT_V(8); PG8_WAIT_L(0); PG8_BAR; PG8_MMA(0, 0, At, B0); PG8_MMA(0, 1, At, B1); PG8_BAR; PG8_SCHED;
            PG8_LDA(At, 0, 1); PG8_STAGE(PG8_SB(0, 0), b2, voffB); PG8_STAGE(PG8_SB(0, 1), b2 + hstepB, voffB); PG8_STAGE(PG8_SA(0, 0), a2, voffA);
            PG8_WAIT_V(8); PG8_WAIT_L(0); PG8_BAR; PG8_MMA(1, 0, At, B0); PG8_MMA(1, 1, At, B1); PG8_BAR; PG8_SCHED;
            PG8_LDB(B0, 1, 0); PG8_LDB(B1, 1, 1); PG8_SCHED; PG8_LDA(At, 1, 0); PG8_STAGE(PG8_SA(0, 1), a2 + hstepA, voffA);
            PG8_WAIT_V(8); PG8_WAIT_L(0); PG8_BAR; PG8_MMA(0, 0, At, B0); PG8_MMA(0, 1, At, B1); PG8_BAR; PG8_SCHED;
            PG8_LDA(At, 1, 1); PG8_STAGE(PG8_SB(1, 0), b3, voffB); PG8_STAGE(PG8_SB(1, 1), b3 + hstepB, voffB); PG8_STAGE(PG8_SA(1, 0), a3, voffA);
            PG8_WAIT_V(8); PG8_WAIT_L(0); PG8_BAR; PG8_MMA(1, 0, At, B0); PG8_MMA(1, 1, At, B1); PG8_BAR; PG8_SCHED;
            } else {
            PG8_LDB(B0, 0, 0); PG8_SCHED; PG8_LDA(At, 0, 0); PG8_STAGE(PG8_SA(1, 1), a1 + hstepA, voffA);
            PG8_WAIT_L(8); PG8_BAR; PG8_WAIT_L(0); PG8_MMA(0, 0, At, B0); PG8_BAR; PG8_SCHED;
            PG8_LDB(B1, 0, 1); PG8_STAGE(PG8_SB(0, 0), b2, voffB);
            PG8_BAR; PG8_WAIT_L(0); PG8_MMA(0, 1, At, B1); PG8_BAR;
            PG8_LDA(At, 0, 1); PG8_STAGE(PG8_SA(0, 0), a2, voffA);
            PG8_BAR; PG8_WAIT_L(0); PG8_MMA(1, 0, At, B0); PG8_BAR; PG8_SCHED;
            PG8_STAGE(PG8_SB(0, 1), b2 + hstepB, voffB);
            PG8_WAIT_V(6); PG8_BAR; PG8_MMA(1, 1, At, B1); PG8_BAR;
            PG8_LDB(B0, 1, 0); PG8_SCHED; PG8_LDA(At, 1, 0); PG8_STAGE(PG8_SA(0, 1), a2 + hstepA, voffA);
            PG8_WAIT_L(8); PG8_BAR; PG8_WAIT_L(0); PG8_MMA(0, 0, At, B0); PG8_BAR; PG8_SCHED;
            PG8_LDB(B1, 1, 1); PG8_STAGE(PG8_SB(1, 0), b3, voffB);
            PG8_BAR; PG8_WAIT_L(0); PG8_MMA(0, 1, At, B1); PG8_BAR;
            PG8_LDA(At, 1, 1); PG8_STAGE(PG8_SA(1, 0), a3, voffA);
            PG8_BAR; PG8_WAIT_L(0); PG8_MMA(1, 0, At, B0); PG8_BAR; PG8_SCHED;
            PG8_STAGE(PG8_SB(1, 1), b3 + hstepB, voffB);
            PG8_WAIT_V(6); PG8_BAR; PG8_MMA(1, 1, At, B1); PG8_BAR;
            }
        }
        if constexpr (ALIGN_EPI) { if (wr == 0) PG8_BAR; }
        E(acc, cur, wr, wc, fr, fq);
        if (!has_next) break;
#pragma unroll
        for (int a = 0; a < 2; ++a)
#pragma unroll
            for (int b = 0; b < 2; ++b)
#pragma unroll
                for (int m = 0; m < 4; ++m)
#pragma unroll
                    for (int n = 0; n < 2; ++n) acc[a][b][m][n] = (f32x4){0.f, 0.f, 0.f, 0.f};
        cur = nxt; cA = nA; cB = nB; ++ui;
        if constexpr (ALIGN_EPI) { if (wr == 1) PG8_BAR; }
    }
    PG8_WAIT_V(0);
    if constexpr (!ALIGN_EPI) { if (wr == 0) PG8_BAR; }
    PG8_BAR;
#undef PG8_SA
#undef PG8_SB
#undef PG8_STAGE
#undef PG8_LDA
#undef PG8_LDB
#undef PG8_MMA
#undef PG8_WAIT_V
#undef PG8_WAIT_L
#undef PG8_BAR
#undef PG8_SCHED
}


template <int ACT> struct EpiBf16 {
    static constexpr bool PERM = true;
    bf16_t* O; int ldc; const float* bias;
    __device__ __forceinline__ void operator()(const f32x4 (&acc)[2][2][4][2], const Unit& u, int wr, int wc, int fr, int fq) const {
        const int row0 = u.pm * BM + wr * 64 + fr, col0 = u.pn * BM + wc * 32 + 8 * fq;
        f32x4 bv[2][2];
#pragma unroll
        for (int bj = 0; bj < 2; ++bj)
#pragma unroll
            for (int n = 0; n < 2; ++n) bv[bj][n] = bias ? *(const f32x4*)(bias + col0 + bj * HALF + 4 * n) : (f32x4){0.f, 0.f, 0.f, 0.f};
#pragma unroll
        for (int ai = 0; ai < 2; ++ai)
#pragma unroll
            for (int m = 0; m < 4; ++m) { bf16_t* rowp = O + (size_t)(row0 + ai * HALF + m * 16) * ldc + col0;
#pragma unroll
                for (int bj = 0; bj < 2; ++bj) { f32x4 v0 = acc[ai][bj][m][0] + bv[bj][0], v1 = acc[ai][bj][m][1] + bv[bj][1];
                    if (ACT == 1) {
#pragma unroll
                        for (int j = 0; j < 4; ++j) { const float a = fmaxf(v0[j], 0.f), b = fmaxf(v1[j], 0.f); v0[j] = a * a; v1[j] = b * b; } }
                    u32x4 w; w.x = cvt_pk_bf16(v0[0], v0[1]); w.y = cvt_pk_bf16(v0[2], v0[3]); w.z = cvt_pk_bf16(v1[0], v1[1]); w.w = cvt_pk_bf16(v1[2], v1[3]);
                    *(u32x4*)(rowp + bj * HALF) = w; } }
    }
};
struct EpiScores {
    static constexpr bool PERM = true;
    bf16_t* O; const float* rdec;
    __device__ __forceinline__ void operator()(const f32x4 (&acc)[2][2][4][2], const Unit& u, int wr, int wc, int fr, int fq) const {
        const int h = (u.z / 9) & 3; const float lf = log1pf(-expf(rdec[h])) * 1.4426950408889634f, lb = log1pf(-expf(rdec[4 + h])) * 1.4426950408889634f;
        bf16_t* base = O + (size_t)u.z * 256 * 768 + (size_t)(wr * 64 + fr) * 768 + wc * 32 + 8 * fq;
        float d00 = (float)(wr * 64 + fr - wc * 32 - 8 * fq);
        asm volatile("" : "+v"(d00));
#pragma unroll
        for (int ai = 0; ai < 2; ++ai)
#pragma unroll
            for (int m = 0; m < 4; ++m) {
#pragma unroll
                for (int bj = 0; bj < 2; ++bj) { float v[8];
#pragma unroll
                    for (int n = 0; n < 2; ++n)
#pragma unroll
                        for (int e = 0; e < 4; ++e) { const float d = d00 + (float)(ai * HALF + m * 16 - bj * HALF - 4 * n - e);
                            const float dp = fmaxf(d, 0.f), dn = fmaxf(-d, 0.f);
                            const float mk = __builtin_amdgcn_exp2f(dp * lf + dn * lb) + (1.0f - fminf(dp + dn, 1.0f));
                            v[4 * n + e] = acc[ai][bj][m][n][e] * mk; }
                    u32x4 w; w.x = cvt_pk_bf16(v[0], v[1]); w.y = cvt_pk_bf16(v[2], v[3]); w.z = cvt_pk_bf16(v[4], v[5]); w.w = cvt_pk_bf16(v[6], v[7]);
                    *(u32x4*)(base + (size_t)(ai * HALF + m * 16) * 768 + bj * HALF) = w; }
                asm volatile("" ::: "memory"); }
    }
};
struct EpiF32 {
    static constexpr bool PERM = false;
    float* C; int ldc; size_t zstride;
    __device__ __forceinline__ void operator()(const f32x4 (&acc)[2][2][4][2], const Unit& u, int wr, int wc, int fr, int fq) const {
        const int row0 = u.pm * BM + wr * 64 + fr, col0 = u.pn * BM + wc * 32 + 4 * fq; float* Cz = C + (size_t)u.z * zstride;
#pragma unroll
        for (int ai = 0; ai < 2; ++ai)
#pragma unroll
            for (int m = 0; m < 4; ++m) { float* rowp = Cz + (size_t)(row0 + ai * HALF + m * 16) * ldc + col0;
#pragma unroll
                for (int bj = 0; bj < 2; ++bj)
#pragma unroll
                    for (int n = 0; n < 2; ++n) *(f32x4*)(rowp + bj * HALF + n * 16) = acc[ai][bj][m][n]; }
    }
};
template <int PASS> struct EpiGate {
    static constexpr bool PERM = false;
    const bf16_t* Z; float* MGF; bf16_t* MG;
    __device__ __forceinline__ void operator()(const f32x4 (&acc)[2][2][4][2], const Unit& u, int wr, int wc, int fr, int fq) const {
        const int row0 = u.pm * BM + wr * 64 + fr, col0 = u.pn * BM + wc * 32 + 4 * fq;
#pragma unroll
        for (int ai = 0; ai < 2; ++ai)
#pragma unroll
            for (int m = 0; m < 4; ++m) { const size_t row = (size_t)(row0 + ai * HALF + m * 16);
#pragma unroll
                for (int bj = 0; bj < 2; ++bj)
#pragma unroll
                    for (int n = 0; n < 2; ++n) { const int col = col0 + bj * HALF + n * 16;
                        const u32x2 gz = *(const u32x2*)(Z + row * DIN + O_GATE + PASS * D + col);
                        f32x4 gt; gt[0] = bflo(gz.x); gt[1] = bfhi(gz.x); gt[2] = bflo(gz.y); gt[3] = bfhi(gz.y);
#pragma unroll
                        for (int e = 0; e < 4; ++e) gt[e] = 1.0f / (1.0f + __expf(-gt[e]));
                        f32x4 r = gt * acc[ai][bj][m][n];
                        float* mp = MGF + row * D + col;
                        if (PASS > 0) r = r + *(const f32x4*)mp;
                        if (PASS < 2) *(f32x4*)mp = r;
                        else { u32x2 w; w.x = cvt_pk_bf16(r[0], r[1]); w.y = cvt_pk_bf16(r[2], r[3]); *(u32x2*)(MG + row * D + col) = w; } } }
    }
};
struct EpiResid {
    static constexpr bool PERM = false;
    const float* X; float* S; const float* bias; const float* gate;
    __device__ __forceinline__ void operator()(const f32x4 (&acc)[2][2][4][2], const Unit& u, int wr, int wc, int fr, int fq) const {
        const int row0 = u.pm * BM + wr * 64 + fr, col0 = u.pn * BM + wc * 32 + 4 * fq;
        const int bmod = u.pm < 4 ? 4 : ((u.pm - 4) >> 3);
        const float* gp = gate + (size_t)bmod * 12288;
        f32x4 bv[2][2], gv[2][2];
#pragma unroll
        for (int bj = 0; bj < 2; ++bj)
#pragma unroll
            for (int n = 0; n < 2; ++n) { bv[bj][n] = *(const f32x4*)(bias + col0 + bj * HALF + n * 16); gv[bj][n] = *(const f32x4*)(gp + col0 + bj * HALF + n * 16); }
#pragma unroll
        for (int ai = 0; ai < 2; ++ai)
#pragma unroll
            for (int m = 0; m < 4; ++m) { const size_t off = (size_t)(row0 + ai * HALF + m * 16) * D + col0;
#pragma unroll
                for (int bj = 0; bj < 2; ++bj)
#pragma unroll
                    for (int n = 0; n < 2; ++n) { const f32x4 xv = *(const f32x4*)(X + off + bj * HALF + n * 16);
                        *(f32x4*)(S + off + bj * HALF + n * 16) = xv * ALPHA + gv[bj][n] * (acc[ai][bj][m][n] + bv[bj][n]); } }
    }
};
}

#define XB_TMO      128
#define XB_XCNT(j)  (256  + 64 * (j))
#define XB_XSUB(j)  (1280 + 64 * (j))
#define XB_XGEN(j)  (2304 + 64 * (j))
#define XB_TOP      3328
#define XB_TOPGEN   3392
#define XCD_BAR_WORDS 3456
#define XB_SPIN_CAP (1u << 22)

__device__ __forceinline__ unsigned xb_ld(unsigned* p)              { return __hip_atomic_load(p, __ATOMIC_RELAXED, __HIP_MEMORY_SCOPE_AGENT); }
__device__ __forceinline__ unsigned xb_add(unsigned* p, unsigned v) { return __hip_atomic_fetch_add(p, v, __ATOMIC_RELAXED, __HIP_MEMORY_SCOPE_AGENT); }
__device__ __forceinline__ unsigned xb_xcc_id() { return (unsigned)__builtin_amdgcn_s_getreg((3 << 11) | 20) & 0xFu; }
#define XB_SPIN(cond, bar) do { unsigned _sp = 0; while (cond) { __builtin_amdgcn_s_sleep(1); \
    if ((++_sp & 255u) == 0u) { if (xb_ld(&(bar)[XB_TMO])) break; if (_sp > XB_SPIN_CAP) { atomicAdd(&(bar)[XB_TMO], 1u); break; } } } } while (0)

struct XcdBarrier { unsigned* bar; unsigned x; volatile LAS unsigned* st; };

__device__ __forceinline__ XcdBarrier xcd_barrier_post(unsigned* bar, volatile LAS unsigned* st) {
    XcdBarrier b; b.bar = bar; b.x = xb_xcc_id(); b.st = st;
    if (threadIdx.x == 0) (void)xb_add(&bar[XB_XCNT(b.x)], 1u);
    return b;
}
__device__ __forceinline__ void xcd_barrier_complete(unsigned* bar, unsigned x, unsigned& nloc, unsigned& nx) {
    const unsigned G = gridDim.x * gridDim.y * gridDim.z;
    unsigned sum, cnt, mine, sp = 0u;
    for (;;) {
        sum = 0u; cnt = 0u; mine = 0u;
#pragma unroll
        for (unsigned j = 0; j < 16; ++j) { const unsigned c = xb_ld(&bar[XB_XCNT(j)]); sum += c; cnt += (c > 0u) ? 1u : 0u; mine = (j == x) ? c : mine; }
        if (sum == G) break;
        __builtin_amdgcn_s_sleep(1);
        if ((++sp & 255u) == 0u) { if (xb_ld(&bar[XB_TMO])) break; if (sp > XB_SPIN_CAP) { atomicAdd(&bar[XB_TMO], 1u); break; } }
    }
    nloc = mine > 0u ? mine : 1u; nx = cnt > 0u ? cnt : 1u;
}
__device__ __forceinline__ void xcd_barrier(const XcdBarrier& b) {
    asm volatile("s_waitcnt vmcnt(0)" ::: "memory");
    __syncthreads();
    if (threadIdx.x == 0) {
        unsigned* bar = b.bar;
        __builtin_amdgcn_s_waitcnt(0);
        unsigned nloc = b.st[0], nx = b.st[1];
        if (nloc == 0u) { xcd_barrier_complete(bar, b.x, nloc, nx); b.st[0] = nloc; b.st[1] = nx; }
        const unsigned old = xb_add(&bar[XB_XSUB(b.x)], 1u);
        const unsigned gen = old / nloc;
        if (old + 1u == (gen + 1u) * nloc) {
            __builtin_amdgcn_fence(__ATOMIC_RELEASE, "agent");
            asm volatile("s_waitcnt vmcnt(0)" ::: "memory");
            const unsigned og = xb_add(&bar[XB_TOP], 1u);
            const unsigned tg = og / nx;
            if (og + 1u == (tg + 1u) * nx) xb_add(&bar[XB_TOPGEN], 1u);
            else XB_SPIN(xb_ld(&bar[XB_TOPGEN]) == tg, bar);
            __builtin_amdgcn_fence(__ATOMIC_ACQUIRE, "agent");
            xb_add(&bar[XB_XGEN(b.x)], 1u);
            asm volatile("s_waitcnt vmcnt(0)" ::: "memory");
        } else {
            XB_SPIN(xb_ld(&bar[XB_XGEN(b.x)]) == gen, bar);
            __builtin_amdgcn_fence(__ATOMIC_ACQUIRE, "agent");
            asm volatile("s_waitcnt vmcnt(0)" ::: "memory");
        }
    }
    __syncthreads();
}

struct Args { const float* in[37]; float* out; unsigned char* ws; int ph_lo, ph_hi; };
typedef const __attribute__((address_space(4))) Args* CArgs;
enum { I_X = 0, I_C, I_CTX, I_CCTX, I_WADA, I_BADA, I_WIN, I_BIN, I_CONVW, I_CONVB, I_POOLW, I_POOLS, I_FW1, I_FB1, I_FF1, I_FW2, I_FB2, I_FF2, I_FW3, I_FB3, I_FF3, I_FW4,
       I_HYD, I_RDEC, I_PA, I_PB, I_PC, I_WO, I_BO, I_LN1G, I_LN1B, I_W1, I_B1, I_W2, I_B2, I_LN2G, I_LN2B };

struct Frame {
    LAS unsigned char* lds;
    int tid, lane, wave, blk, G;
    unsigned char* ws;
};

__device__ __forceinline__ float wave_sum(float v) {
#pragma unroll
    for (int o = 1; o < 64; o <<= 1) v += __shfl_xor(v, o);
    return v;
}
__device__ __forceinline__ float silu_f(float v) { return v / (1.0f + __expf(-v)); }
__device__ __forceinline__ int chunk_row0(int b, int ci) { return ci == 0 ? b * CTXL : MC + b * SEQ + (ci - 1) * 256; }
__device__ __forceinline__ float ret_lg2(const float* rdec, int l, int dirh) { const float p = rdec[l * 8 + dirh]; return log1pf(-expf(p)) * 1.4426950408889634f; }

__device__ __forceinline__ void transpose_item(const float* W, int N, bf16_t* WT, int ldw, int koff, LAS float* scr, int item, int lane) {
    const int nblk = N / 32, kb = item / nblk, nb = item % nblk, k0 = 64 * kb, n0 = 32 * nb;
#pragma unroll 8
    for (int i = 0; i < 32; ++i) { const int kk = 2 * i + (lane >> 5); scr[kk * 33 + (lane & 31)] = W[(size_t)(k0 + kk) * N + n0 + (lane & 31)]; }
    LDS_WAIT(); asm volatile("" ::: "memory");
    const int c = lane & 7;
#pragma unroll
    for (int j = 0; j < 4; ++j) { const int n = (lane >> 3) + 8 * j; const LAS float* s = scr + (8 * c) * 33 + n;
        u32x4 o; o.x = pk2(s[0 * 33], s[1 * 33]); o.y = pk2(s[2 * 33], s[3 * 33]); o.z = pk2(s[4 * 33], s[5 * 33]); o.w = pk2(s[6 * 33], s[7 * 33]);
        *(u32x4*)(WT + (size_t)(n0 + n) * ldw + koff + k0 + 8 * c) = o; }
    LDS_WAIT(); asm volatile("" ::: "memory");
}

__device__ __forceinline__ void pro_a(Frame& F, CArgs a) {
    LAS float* scr = (LAS float*)(F.lds + F.wave * 16384);
    const int gw = F.blk * 8 + F.wave, NGW = F.G * 8, lane = F.lane;
    unsigned char* ws = F.ws;
    constexpr int I_IN = 32 * 384, I_PAB = 8 * 64, I_PCC = 16 * 64, I_O = 32 * 64, I_1 = 32 * 256, I_2 = 128 * 64;
    constexpr int PER_L = I_IN + 2 * I_PAB + I_PCC + I_O + I_1 + I_2;
    for (int it = gw; it < DEPTH * PER_L; it += NGW) {
        const int l = it / PER_L; int r = it % PER_L;
        if (r < I_IN) { transpose_item(a->in[I_WIN] + (size_t)l * D * DIN, DIN, (bf16_t*)(ws + WS_WIN) + (size_t)l * DIN * D, D, 0, scr, r, lane); continue; } r -= I_IN;
        if (r < I_PAB) { transpose_item(a->in[I_PA] + (size_t)l * 512 * D, D, (bf16_t*)(ws + WS_PT) + (size_t)l * D * D, D, 0, scr, r, lane); continue; } r -= I_PAB;
        if (r < I_PAB) { transpose_item(a->in[I_PB] + (size_t)l * 512 * D, D, (bf16_t*)(ws + WS_PT) + (size_t)l * D * D, D, 512, scr, r, lane); continue; } r -= I_PAB;
        if (r < I_PCC) { transpose_item(a->in[I_PC] + (size_t)l * 1024 * D, D, (bf16_t*)(ws + WS_PT) + (size_t)l * D * D, D, 1024, scr, r, lane); continue; } r -= I_PCC;
        if (r < I_O) { transpose_item(a->in[I_WO] + (size_t)l * D * D, D, (bf16_t*)(ws + WS_WO) + (size_t)l * D * D, D, 0, scr, r, lane); continue; } r -= I_O;
        if (r < I_1) { transpose_item(a->in[I_W1] + (size_t)l * D * DFF, DFF, (bf16_t*)(ws + WS_W1) + (size_t)l * DFF * D, D, 0, scr, r, lane); continue; } r -= I_1;
        transpose_item(a->in[I_W2] + (size_t)l * DFF * D, D, (bf16_t*)(ws + WS_W2) + (size_t)l * D * DFF, DFF, 0, scr, r, lane);
    }
    {
        float* modp = (float*)(ws + WS_MODP);
        for (int it = gw; it < DEPTH * 192 * 16; it += NGW) {
            const int ks = it & 15, cb = (it >> 4) % 192, l = it / (16 * 192);
            const int col = cb * 64 + lane, k0 = ks * 128;
            float sv0[5], sv1[5];
#pragma unroll
            for (int b = 0; b < 5; ++b) { const float* cp = b < 4 ? a->in[I_C] + b * D : a->in[I_CCTX]; sv0[b] = silu_f(cp[k0 + lane]); sv1[b] = silu_f(cp[k0 + 64 + lane]); }
            float acc[5] = {0.f, 0.f, 0.f, 0.f, 0.f};
            const float* wp = a->in[I_WADA] + ((size_t)l * D + k0) * 12288 + col;
            for (int kk = 0; kk < 64; ++kk) { const float w = wp[(size_t)kk * 12288];
#pragma unroll
                for (int b = 0; b < 5; ++b) acc[b] += __shfl(sv0[b], kk) * w; }
            for (int kk = 0; kk < 64; ++kk) { const float w = wp[(size_t)(64 + kk) * 12288];
#pragma unroll
                for (int b = 0; b < 5; ++b) acc[b] += __shfl(sv1[b], kk) * w; }
#pragma unroll
            for (int b = 0; b < 5; ++b) modp[(((size_t)ks * DEPTH + l) * 5 + b) * 12288 + col] = acc[b];
        }
    }
    {
        constexpr int PER = SEQ + CTXL;
        for (int it = gw; it < DEPTH * PER; it += NGW) {
            const int l = it / PER, pr = it % PER; const bool isc = pr >= SEQ; const int pos = isc ? pr - SEQ : pr, L = isc ? CTXL : SEQ;
            const float t = (float)pos / (float)(L - 1);
            const float w = 6.2831853071795862f * (float)pos / (float)L;
            float zf = 0.f;
            if (lane == 0) zf = t;
            else if (lane < 33) { const int bi = (lane - 1) & 15; const float f = 1e-4f + (float)bi * ((15.0f - 1e-4f) / 15.0f); const float ang = f * w; zf = lane <= 16 ? cosf(ang) : -sinf(ang); }
            float h = a->in[I_FB1][l * 64 + lane];
            for (int i = 0; i < 33; ++i) h += __shfl(zf, i) * a->in[I_FW1][((size_t)l * 33 + i) * 64 + lane];
            h = sinf(a->in[I_FF1][l * 64 + lane] * h);
            float h2 = a->in[I_FB2][l * 64 + lane];
            for (int i = 0; i < 64; ++i) h2 += __shfl(h, i) * a->in[I_FW2][((size_t)l * 64 + i) * 64 + lane];
            h2 = sinf(a->in[I_FF2][l * 64 + lane] * h2);
            float h3 = a->in[I_FB3][l * 64 + lane];
            for (int i = 0; i < 64; ++i) h3 += __shfl(h2, i) * a->in[I_FW3][((size_t)l * 64 + i) * 64 + lane];
            h3 = sinf(a->in[I_FF3][l * 64 + lane] * h3);
            float o[16];
#pragma unroll
            for (int m = 0; m < 16; ++m) o[m] = 0.f;
            const float* w4 = a->in[I_FW4] + (size_t)l * 64 * 1024 + lane;
            for (int i = 0; i < 64; ++i) { const float hv = __shfl(h3, i);
#pragma unroll
                for (int m = 0; m < 16; ++m) o[m] += hv * w4[(size_t)i * 1024 + 64 * m]; }
            float* dst = isc ? (float*)(ws + WS_FILTC) + ((size_t)l * CTXL + pos) * 1024 : (float*)(ws + WS_FILT) + ((size_t)l * SEQ + pos) * 1024;
            const float min_decay = -3.0701134573253945f, max_decay = -15.350567286626973f;
#pragma unroll
            for (int m = 0; m < 16; ++m) { const int col = lane + 64 * m, ch = col & 511;
                const float delta = min_decay + (float)ch * ((max_decay - min_decay) / 511.0f);
                dst[col] = o[m] * expf(-t * fabsf(delta)); }
        }
    }
    for (int t = gw; t < SEQ; t += NGW) {
        const float inv = exp2f(-(float)lane * (13.287712379549449f / 64.0f));
        const float ar = (float)(t >> 6) * inv, ac = (float)(t & 63) * inv;
        float* rp = (float*)(ws + WS_ROPE) + (size_t)t * 256;
        rp[lane] = cosf(ar); rp[64 + lane] = sinf(ar); rp[128 + lane] = cosf(ac); rp[192 + lane] = sinf(ac);
    }
    {
        bf16_t* wpt = (bf16_t*)(ws + WS_WPT);
        for (int e = F.blk * 512 + F.tid; e < DEPTH * 512 * 512; e += F.G * 512) {
            const int l = e >> 18, n = (e >> 9) & 511, k = e & 511; float v = 0.f;
            if ((n >> 7) == (k >> 7)) v = a->in[I_POOLW][(((size_t)l * 4 + (n >> 7)) * 128 + (k & 127)) * 128 + (n & 127)] * a->in[I_POOLS][l * 512 + n];
            wpt[e] = (bf16_t)f2bf(v);
        }
    }
    {
        f32x4* X = (f32x4*)(ws + WS_X);
        const size_t nc = (size_t)MC * D / 4, nx = (size_t)ML * D / 4;
        for (size_t e = (size_t)F.blk * 512 + F.tid; e < nc + nx; e += (size_t)F.G * 512)
            X[e] = e < nc ? ((const f32x4*)a->in[I_CTX])[e] : ((const f32x4*)a->in[I_X])[e - nc];
    }
}
__device__ __forceinline__ void pro_b(Frame& F, CArgs a) {
    const float* modp = (const float*)(F.ws + WS_MODP); float* mod = (float*)(F.ws + WS_MOD);
    for (int e = F.blk * 512 + F.tid; e < DEPTH * 5 * 12288; e += F.G * 512) {
        const int j = e % 12288, l = e / (5 * 12288);
        float s = a->in[I_BADA][l * 12288 + j];
#pragma unroll
        for (int ks = 0; ks < 16; ++ks) s += modp[(size_t)ks * DEPTH * 5 * 12288 + e];
        mod[e] = s;
    }
}
__device__ __forceinline__ void pro_c(Frame& F) {
    const int gw = F.blk * 8 + F.wave, NGW = F.G * 8, lane = F.lane;
    const float* mod = (const float*)(F.ws + WS_MOD);
    for (int row = gw; row < M; row += NGW) {
        const int bmod = row < MC ? 4 : ((row - MC) >> 11);
        const float* sh = mod + (size_t)bmod * 12288; const float* sc = sh + D;
        const f32x4* xr = (const f32x4*)((const float*)(F.ws + WS_X) + (size_t)row * D);
        u32x2* o = (u32x2*)((bf16_t*)(F.ws + WS_XM) + (size_t)row * D);
#pragma unroll
        for (int j = 0; j < 8; ++j) { const int i4 = lane + 64 * j; const f32x4 v = xr[i4], s4 = ((const f32x4*)sc)[i4], h4 = ((const f32x4*)sh)[i4];
            const f32x4 r = v * (s4 + 1.0f) + h4; u32x2 w; w.x = pk2(r[0], r[1]); w.y = pk2(r[2], r[3]); o[i4] = w; }
    }
}

__device__ __forceinline__ void prep_phase(Frame& F, CArgs a, int l) {
    unsigned char* ws = F.ws;
    const bf16_t* Z = (const bf16_t*)(ws + WS_Z);
    {
        bf16_t* P = (bf16_t*)(ws + WS_POOL);
        for (int e = F.blk * 512 + F.tid; e < M * 64; e += F.G * 512) {
            const int row = e >> 6, cg = e & 63, g = cg >> 4, w = 2 << g;
            int t, L; if (row < MC) { t = row & 255; L = CTXL; } else { t = (row - MC) & 2047; L = SEQ; }
            const int lo = max(t - (w >> 1), 0), hi = min(t + w - (w >> 1), L);
            float s[8] = {0.f, 0.f, 0.f, 0.f, 0.f, 0.f, 0.f, 0.f};
            for (int tt = lo; tt < hi; ++tt) { const u32x4 v = *(const u32x4*)(Z + (size_t)(row - t + tt) * DIN + cg * 8);
                s[0] += bflo(v.x); s[1] += bfhi(v.x); s[2] += bflo(v.y); s[3] += bfhi(v.y); s[4] += bflo(v.z); s[5] += bfhi(v.z); s[6] += bflo(v.w); s[7] += bfhi(v.w); }
            const u32x4 sv = *(const u32x4*)(Z + (size_t)row * DIN + cg * 8);
            const float inv = 1.0f / (float)(hi - lo);
            u32x4 o; o.x = pk2(s[0] * inv - bflo(sv.x), s[1] * inv - bfhi(sv.x)); o.y = pk2(s[2] * inv - bflo(sv.y), s[3] * inv - bfhi(sv.y));
            o.z = pk2(s[4] * inv - bflo(sv.z), s[5] * inv - bfhi(sv.z)); o.w = pk2(s[6] * inv - bflo(sv.w), s[7] * inv - bfhi(sv.w));
            *(u32x4*)(P + (size_t)row * 512 + cg * 8) = o;
        }
    }
    {
        const float* cw = a->in[I_CONVW] + (size_t)l * 3 * 1536; const float* cb = a->in[I_CONVB] + (size_t)l * 1536;
        float* UU = (float*)(ws + WS_UU); float* X0 = (float*)(ws + WS_X0);
        for (int e = F.blk * 512 + F.tid; e < M * 128; e += F.G * 512) {
            const int row = e >> 7, c4 = (e & 127) * 4;
            int t, L; if (row < MC) { t = row & 255; L = CTXL; } else { t = (row - MC) & 2047; L = SEQ; }
            f32x4 r3[3];
#pragma unroll
            for (int s = 0; s < 3; ++s) {
                const int ch = s * 512 + c4; f32x4 acc = *(const f32x4*)(cb + ch);
#pragma unroll
                for (int d = 0; d < 3; ++d) { const int tt = t + d - 1;
                    if (tt >= 0 && tt < L) { const u32x2 zv = *(const u32x2*)(Z + (size_t)(row + d - 1) * DIN + O_HY + ch); const f32x4 wv = *(const f32x4*)(cw + d * 1536 + ch);
                        acc[0] += wv[0] * bflo(zv.x); acc[1] += wv[1] * bfhi(zv.x); acc[2] += wv[2] * bflo(zv.y); acc[3] += wv[3] * bfhi(zv.y); } }
                r3[s] = acc; }
            *(f32x4*)(UU + (size_t)row * 512 + c4) = r3[0] * r3[2];
            *(f32x4*)(X0 + (size_t)row * 512 + c4) = r3[1];
        }
    }
    {
        bf16_t* Zw = (bf16_t*)(ws + WS_Z); bf16_t* AB = (bf16_t*)(ws + WS_ABUF); bf16_t* BB = (bf16_t*)(ws + WS_BBUF); bf16_t* KT = (bf16_t*)(ws + WS_KT);
        const float* rope = (const float*)(ws + WS_ROPE);
        LAS float* LK = (LAS float*)F.lds;
        for (int it = F.blk; it < NU * 4; it += F.G) {
            const int u = it >> 2, pg = it & 3, bh = u / 9, ci = u % 9, b = bh >> 2, h = bh & 3;
            const int row0 = chunk_row0(b, ci); const bool isctx = ci == 0;
            const float lf = ret_lg2(a->in[I_RDEC], l, h), lb = ret_lg2(a->in[I_RDEC], l, 4 + h);
            const int dbase = (pg & 1) * 32 + (pg >> 1) * 128, rbase = (pg >> 1) * 128;
            const int tok = F.tid >> 1, sub = F.tid & 1, dl0 = sub * 16, d1 = dbase + dl0, d2 = d1 + 64;
            const size_t zrow = (size_t)(row0 + tok) * DIN;
            float cs[16], sn[16];
            if (!isctx) { const float* rp = rope + (size_t)((ci - 1) * 256 + tok) * 256 + rbase + (d1 - rbase);
#pragma unroll
                for (int e = 0; e < 16; ++e) { cs[e] = rp[e]; sn[e] = rp[64 + e]; } }
            else {
#pragma unroll
                for (int e = 0; e < 16; ++e) { cs[e] = 1.f; sn[e] = 0.f; } }
            {
                bf16_t* qp = Zw + zrow + O_Q + h * 256;
                u32x4 a0 = *(const u32x4*)(qp + d1), a1 = *(const u32x4*)(qp + d1 + 8), b0 = *(const u32x4*)(qp + d2), b1 = *(const u32x4*)(qp + d2 + 8);
                const unsigned aw[8] = {a0.x, a0.y, a0.z, a0.w, a1.x, a1.y, a1.z, a1.w}, bw[8] = {b0.x, b0.y, b0.z, b0.w, b1.x, b1.y, b1.z, b1.w};
                float o1[16], o2[16];
#pragma unroll
                for (int e = 0; e < 16; ++e) { const float x1 = (e & 1) ? bfhi(aw[e >> 1]) : bflo(aw[e >> 1]), x2 = (e & 1) ? bfhi(bw[e >> 1]) : bflo(bw[e >> 1]);
                    o1[e] = x1 * cs[e] - x2 * sn[e]; o2[e] = x2 * cs[e] + x1 * sn[e]; }
                const float df = exp2f((float)(tok + 1) * lf), db = exp2f((float)(256 - tok) * lb);
                unsigned w1[8], w2[8], f1[8], f2[8], g1[8], g2[8];
#pragma unroll
                for (int e = 0; e < 8; ++e) { w1[e] = pk2(o1[2 * e], o1[2 * e + 1]); w2[e] = pk2(o2[2 * e], o2[2 * e + 1]);
                    f1[e] = pk2(o1[2 * e] * df, o1[2 * e + 1] * df); f2[e] = pk2(o2[2 * e] * df, o2[2 * e + 1] * df);
                    g1[e] = pk2(o1[2 * e] * db, o1[2 * e + 1] * db); g2[e] = pk2(o2[2 * e] * db, o2[2 * e + 1] * db); }
                *(u32x4*)(qp + d1) = (u32x4){w1[0], w1[1], w1[2], w1[3]}; *(u32x4*)(qp + d1 + 8) = (u32x4){w1[4], w1[5], w1[6], w1[7]};
                *(u32x4*)(qp + d2) = (u32x4){w2[0], w2[1], w2[2], w2[3]}; *(u32x4*)(qp + d2 + 8) = (u32x4){w2[4], w2[5], w2[6], w2[7]};
                bf16_t* ap = AB + ((size_t)u * 256 + tok) * 768;
                *(u32x4*)(ap + 256 + d1) = (u32x4){f1[0], f1[1], f1[2], f1[3]}; *(u32x4*)(ap + 256 + d1 + 8) = (u32x4){f1[4], f1[5], f1[6], f1[7]};
                *(u32x4*)(ap + 256 + d2) = (u32x4){f2[0], f2[1], f2[2], f2[3]}; *(u32x4*)(ap + 256 + d2 + 8) = (u32x4){f2[4], f2[5], f2[6], f2[7]};
                *(u32x4*)(ap + 512 + d1) = (u32x4){g1[0], g1[1], g1[2], g1[3]}; *(u32x4*)(ap + 512 + d1 + 8) = (u32x4){g1[4], g1[5], g1[6], g1[7]};
                *(u32x4*)(ap + 512 + d2) = (u32x4){g2[0], g2[1], g2[2], g2[3]}; *(u32x4*)(ap + 512 + d2 + 8) = (u32x4){g2[4], g2[5], g2[6], g2[7]};
            }
            {
                bf16_t* kp = Zw + zrow + O_K + h * 256;
                u32x4 a0 = *(const u32x4*)(kp + d1), a1 = *(const u32x4*)(kp + d1 + 8), b0 = *(const u32x4*)(kp + d2), b1 = *(const u32x4*)(kp + d2 + 8);
                const unsigned aw[8] = {a0.x, a0.y, a0.z, a0.w, a1.x, a1.y, a1.z, a1.w}, bw[8] = {b0.x, b0.y, b0.z, b0.w, b1.x, b1.y, b1.z, b1.w};
                float o1[16], o2[16];
#pragma unroll
                for (int e = 0; e < 16; ++e) { const float x1 = (e & 1) ? bfhi(aw[e >> 1]) : bflo(aw[e >> 1]), x2 = (e & 1) ? bfhi(bw[e >> 1]) : bflo(bw[e >> 1]);
                    o1[e] = (x1 * cs[e] - x2 * sn[e]) * 0.0625f; o2[e] = (x2 * cs[e] + x1 * sn[e]) * 0.0625f; }
                unsigned w1[8], w2[8];
#pragma unroll
                for (int e = 0; e < 8; ++e) { w1[e] = pk2(o1[2 * e], o1[2 * e + 1]); w2[e] = pk2(o2[2 * e], o2[2 * e + 1]); }
                *(u32x4*)(kp + d1) = (u32x4){w1[0], w1[1], w1[2], w1[3]}; *(u32x4*)(kp + d1 + 8) = (u32x4){w1[4], w1[5], w1[6], w1[7]};
                *(u32x4*)(kp + d2) = (u32x4){w2[0], w2[1], w2[2], w2[3]}; *(u32x4*)(kp + d2 + 8) = (u32x4){w2[4], w2[5], w2[6], w2[7]};
#pragma unroll
                for (int e = 0; e < 16; ++e) { LK[(dl0 + e) * 257 + tok] = o1[e]; LK[(32 + dl0 + e) * 257 + tok] = o2[e]; }
            }
            __syncthreads();
            {
                const int dl = F.tid & 63, seg = F.tid >> 6, dg = dl < 32 ? dbase + dl : dbase + 64 + (dl - 32);
                bf16_t* kf = KT + ((size_t)u * 512 + dg) * 256 + seg * 32; bf16_t* kb = KT + ((size_t)u * 512 + 256 + dg) * 256 + seg * 32;
                unsigned wf[16], wb[16];
#pragma unroll
                for (int j = 0; j < 16; ++j) { const int t0 = seg * 32 + 2 * j; const float v0 = LK[dl * 257 + t0], v1 = LK[dl * 257 + t0 + 1];
                    wf[j] = pk2(v0 * exp2f((float)(255 - t0) * lf), v1 * exp2f((float)(254 - t0) * lf));
                    wb[j] = pk2(v0 * exp2f((float)t0 * lb), v1 * exp2f((float)(t0 + 1) * lb)); }
#pragma unroll
                for (int j = 0; j < 4; ++j) { *(u32x4*)(kf + 8 * j) = (u32x4){wf[4 * j], wf[4 * j + 1], wf[4 * j + 2], wf[4 * j + 3]}; *(u32x4*)(kb + 8 * j) = (u32x4){wb[4 * j], wb[4 * j + 1], wb[4 * j + 2], wb[4 * j + 3]}; }
            }
            __syncthreads();
            {
                const bf16_t* vp = Z + zrow + O_V + h * 256;
                u32x4 a0 = *(const u32x4*)(vp + d1), a1 = *(const u32x4*)(vp + d1 + 8), b0 = *(const u32x4*)(vp + d2), b1 = *(const u32x4*)(vp + d2 + 8);
                const unsigned aw[8] = {a0.x, a0.y, a0.z, a0.w, a1.x, a1.y, a1.z, a1.w}, bw[8] = {b0.x, b0.y, b0.z, b0.w, b1.x, b1.y, b1.z, b1.w};
#pragma unroll
                for (int e = 0; e < 16; ++e) { LK[(dl0 + e) * 257 + tok] = (e & 1) ? bfhi(aw[e >> 1]) : bflo(aw[e >> 1]); LK[(32 + dl0 + e) * 257 + tok] = (e & 1) ? bfhi(bw[e >> 1]) : bflo(bw[e >> 1]); }
            }
            __syncthreads();
            {
                const int dl = F.tid & 63, seg = F.tid >> 6, dg = dl < 32 ? dbase + dl : dbase + 64 + (dl - 32);
                bf16_t* vt = BB + ((size_t)u * 256 + dg) * 768 + seg * 32;
                unsigned wv[16];
#pragma unroll
                for (int j = 0; j < 16; ++j) { const int t0 = seg * 32 + 2 * j; wv[j] = pk2(LK[dl * 257 + t0], LK[dl * 257 + t0 + 1]); }
#pragma unroll
                for (int j = 0; j < 4; ++j) *(u32x4*)(vt + 8 * j) = (u32x4){wv[4 * j], wv[4 * j + 1], wv[4 * j + 2], wv[4 * j + 3]};
            }
            __syncthreads();
        }
    }
}

__device__ __forceinline__ void scan_phase(Frame& F, CArgs a, int l) {
    const float* UT = (const float*)(F.ws + WS_UT); bf16_t* BB = (bf16_t*)(F.ws + WS_BBUF);
    for (int e = F.blk * 512 + F.tid; e < 16 * 2 * 16384; e += F.G * 512) {
        const int q = e & 16383, dir = (e >> 14) & 1, bh = e >> 15, dv = q >> 6, dk4 = (q & 63) * 4, h = bh & 3;
        const float cdec = exp2f(256.0f * ret_lg2(a->in[I_RDEC], l, dir * 4 + h));
        f32x4 S = (f32x4){0.f, 0.f, 0.f, 0.f};
#pragma unroll 1
        for (int s = 0; s < 9; ++s) {
            const int ci = dir == 0 ? s : (s == 0 ? 0 : 9 - s);
            const int u = bh * 9 + ci;
            u32x2 w; w.x = pk2(S[0], S[1]); w.y = pk2(S[2], S[3]);
            *(u32x2*)(BB + ((size_t)u * 256 + dv) * 768 + 256 + dir * 256 + dk4) = w;
            const f32x4 uv = *(const f32x4*)(UT + ((size_t)u * 256 + dv) * 512 + dir * 256 + dk4);
            S = S * cdec + uv;
        }
    }
}

__device__ __forceinline__ void conv_phase(Frame& F, CArgs a, int l) {
    const float* UU = (const float*)(F.ws + WS_UU); const float* X0 = (const float*)(F.ws + WS_X0); bf16_t* Y = (bf16_t*)(F.ws + WS_Y);
    const int c = F.tid; const float hd = a->in[I_HYD][l * 512 + c];
    for (int it = F.blk; it < 576; it += F.G) {
        int L, rowb, t0; const float* filt;
        if (it < 512) { const int b = it >> 7; L = SEQ; rowb = MC + b * SEQ; t0 = (it & 127) * 16; filt = (const float*)(F.ws + WS_FILT) + (size_t)l * SEQ * 1024; }
        else { const int j = it - 512, b = j >> 4; L = CTXL; rowb = b * CTXL; t0 = (j & 15) * 16; filt = (const float*)(F.ws + WS_FILTC) + (size_t)l * CTXL * 1024; }
        float y[16];
#pragma unroll
        for (int j = 0; j < 16; ++j) y[j] = 0.f;
        for (int s0 = 0; s0 < L; s0 += 16) {
            const int d0 = t0 - s0;
            float kk[31], uv[16];
#pragma unroll
            for (int i = 0; i < 31; ++i) { const int d = d0 - 15 + i; const int idx = d >= 0 ? d * 1024 + c : (-d) * 1024 + 512 + c; kk[i] = filt[idx]; }
#pragma unroll
            for (int ss = 0; ss < 16; ++ss) uv[ss] = UU[(size_t)(rowb + s0 + ss) * 512 + c];
#pragma unroll
            for (int j = 0; j < 16; ++j)
#pragma unroll
                for (int ss = 0; ss < 16; ++ss) y[j] += kk[j - ss + 15] * uv[ss];
        }
#pragma unroll
        for (int j = 0; j < 16; ++j) { const size_t row = (size_t)(rowb + t0 + j); const float u0 = UU[row * 512 + c], x0 = X0[row * 512 + c];
            Y[row * D + 512 + c] = (bf16_t)f2bf((y[j] + u0 * hd) * x0); }
    }
}

__device__ __forceinline__ void gn_phase(Frame& F) {
    const int gw = F.blk * 8 + F.wave, NGW = F.G * 8, lane = F.lane;
    const float* OB = (const float*)(F.ws + WS_OBUF); const bf16_t* Z = (const bf16_t*)(F.ws + WS_Z); bf16_t* Y = (bf16_t*)(F.ws + WS_Y);
    for (int it = gw; it < NU * 256; it += NGW) {
        const int u = it >> 8, tok = it & 255, bh = u / 9, ci = u % 9, b = bh >> 2, h = bh & 3;
        const size_t row = (size_t)(chunk_row0(b, ci) + tok);
        const f32x4 v = *(const f32x4*)(OB + (size_t)it * 256 + lane * 4);
        const float mean = wave_sum((v[0] + v[1]) + (v[2] + v[3])) * (1.0f / 256.0f);
        const f32x4 dv = v - mean;
        const float var = wave_sum((dv[0] * dv[0] + dv[1] * dv[1]) + (dv[2] * dv[2] + dv[3] * dv[3])) * (1.0f / 256.0f);
        const float rstd = 1.0f / sqrtf(var + GN_EPS);
        const u32x2 gz = *(const u32x2*)(Z + row * DIN + O_G + h * 256 + lane * 4);
        const float g0 = silu_f(bflo(gz.x)), g1 = silu_f(bfhi(gz.x)), g2 = silu_f(bflo(gz.y)), g3 = silu_f(bfhi(gz.y));
        u32x2 w; w.x = pk2(dv[0] * rstd * g0, dv[1] * rstd * g1); w.y = pk2(dv[2] * rstd * g2, dv[3] * rstd * g3);
        *(u32x2*)(Y + row * D + 1024 + h * 256 + lane * 4) = w;
    }
}

__device__ __forceinline__ void ln_phase(Frame& F, CArgs a, int l, int which) {
    const int gw = F.blk * 8 + F.wave, NGW = F.G * 8, lane = F.lane;
    const float* S = (const float*)(F.ws + WS_S); float* X = (float*)(F.ws + WS_X); bf16_t* XM = (bf16_t*)(F.ws + WS_XM);
    const float* g = (which == 0 ? a->in[I_LN1G] : a->in[I_LN2G]) + (size_t)l * D; const float* bb = (which == 0 ? a->in[I_LN1B] : a->in[I_LN2B]) + (size_t)l * D;
    const bool last = (which == 1 && l == DEPTH - 1);
    const float* mod = (const float*)(F.ws + WS_MOD) + (size_t)(which == 0 ? l : (last ? l : l + 1)) * 5 * 12288 + (which == 0 ? 3 * D : 0);
    for (int row = gw; row < M; row += NGW) {
        if (last && row < MC) continue;
        const int bmod = row < MC ? 4 : ((row - MC) >> 11);
        const f32x4* sr = (const f32x4*)(S + (size_t)row * D);
        f32x4 v[8]; float s = 0.f;
#pragma unroll
        for (int j = 0; j < 8; ++j) { v[j] = sr[lane + 64 * j]; s += (v[j][0] + v[j][1]) + (v[j][2] + v[j][3]); }
        const float mean = wave_sum(s) * (1.0f / D); float q = 0.f;
#pragma unroll
        for (int j = 0; j < 8; ++j) { v[j] = v[j] - mean; q += (v[j][0] * v[j][0] + v[j][1] * v[j][1]) + (v[j][2] * v[j][2] + v[j][3] * v[j][3]); }
        const float rstd = 1.0f / sqrtf(wave_sum(q) * (1.0f / D) + LN_EPS);
        const float* sh = mod + (size_t)bmod * 12288; const float* sc = sh + D;
        f32x4* xo = last ? (f32x4*)(a->out + (size_t)(row - MC) * D) : (f32x4*)(X + (size_t)row * D);
        u32x2* xm = (u32x2*)(XM + (size_t)row * D);
#pragma unroll
        for (int j = 0; j < 8; ++j) { const int i4 = lane + 64 * j; const f32x4 y = v[j] * rstd * ((const f32x4*)g)[i4] + ((const f32x4*)bb)[i4];
            xo[i4] = y;
            if (!last) { const f32x4 r = y * (((const f32x4*)sc)[i4] + 1.0f) + ((const f32x4*)sh)[i4]; u32x2 w; w.x = pk2(r[0], r[1]); w.y = pk2(r[2], r[3]); xm[i4] = w; } }
    }
}

struct ScoresOrder {
    const char* Z; int G, c;
    __device__ __forceinline__ bool next(int i, pg8::Unit& u) const { const int L = i * G + c; if (L >= NU) return false; u.z = L; u.pm = 0; u.pn = 0; return true; }
    __device__ __forceinline__ size_t rowoff(const pg8::Unit& u) const { const int bh = u.z / 9, ci = u.z % 9; return (size_t)chunk_row0(bh >> 2, ci) * DIN + (bh & 3) * 256; }
    __device__ __forceinline__ const char* aptr(const pg8::Unit& u) const { return Z + (rowoff(u) + O_Q) * 2; }
    __device__ __forceinline__ const char* bptr(const pg8::Unit& u) const { return Z + (rowoff(u) + O_K) * 2; }
};
struct UtOrder {
    const char* BB; const char* KT; int G, c;
    __device__ __forceinline__ bool next(int i, pg8::Unit& u) const { const int L = i * G + c; if (L >= NU * 2) return false; u.z = L >> 1; u.pm = 0; u.pn = L & 1; return true; }
    __device__ __forceinline__ const char* aptr(const pg8::Unit& u) const { return BB + (size_t)u.z * 256 * 768 * 2; }
    __device__ __forceinline__ const char* bptr(const pg8::Unit& u) const { return KT + ((size_t)u.z * 512 + u.pn * 256) * 256 * 2; }
};
struct OutOrder {
    const char* AB; const char* BB; int G, c;
    __device__ __forceinline__ bool next(int i, pg8::Unit& u) const { const int L = i * G + c; if (L >= NU) return false; u.z = L; u.pm = 0; u.pn = 0; return true; }
    __device__ __forceinline__ const char* aptr(const pg8::Unit& u) const { return AB + (size_t)u.z * 256 * 768 * 2; }
    __device__ __forceinline__ const char* bptr(const pg8::Unit& u) const { return BB + (size_t)u.z * 256 * 768 * 2; }
};

constexpr int PH_PER_LAYER = 12, N_PHASES = 3 + DEPTH * PH_PER_LAYER;

__global__ void __launch_bounds__(512, 2) mk_fwd(Args args_unused) {
    extern __shared__ __attribute__((aligned(16))) unsigned char lds_raw[];
    (void)args_unused;
    CArgs ap = (CArgs)__builtin_amdgcn_kernarg_segment_ptr();
    Frame F;
    F.lds = (LAS unsigned char*)lds_raw;
    F.tid = threadIdx.x; F.lane = F.tid & 63; F.wave = __builtin_amdgcn_readfirstlane(F.tid >> 6);
    F.blk = blockIdx.x; F.G = gridDim.x; F.ws = ap->ws;
    volatile LAS unsigned* MISC = (volatile LAS unsigned*)(F.lds + MISC_OFF);
    if (F.tid < 64) MISC[F.tid] = 0u;
    __syncthreads();
#if MK_PER_PHASE
#define GRID_BAR() do { } while (0)
#else
    XcdBarrier bar = xcd_barrier_post((unsigned*)(ap->ws + WS_CTL) + 4096, MISC + 8);
#define GRID_BAR() xcd_barrier(bar)
#endif
    const int lo = ap->ph_lo, hi = ap->ph_hi;
#define IN(k) (lo <= (k) && (k) < hi)
#define SEAM(k) do { if (IN(k) && IN((k) + 1)) GRID_BAR(); } while (0)
#define LAUNDER() do { int _t = F.tid; asm volatile("" : "+v"(_t)); F.tid = _t; F.lane = _t & 63; F.wave = __builtin_amdgcn_readfirstlane(_t >> 6); \
        asm volatile("" : "+s"(ap)); unsigned char* _w = ap->ws; asm volatile("" : "+s"(_w)); F.ws = _w; ws = _w; } while (0)
    unsigned char* ws = F.ws;

    if (IN(0)) { LAUNDER(); pro_a(F, ap); } SEAM(0);
    if (IN(1)) { LAUNDER(); pro_b(F, ap); } SEAM(1);
    if (IN(2)) { LAUNDER(); pro_c(F); } SEAM(2);

#pragma unroll 1
    for (int l = 0; l < DEPTH; ++l) {
        const int p0 = 3 + l * PH_PER_LAYER;
        if (IN(p0 + 0)) {
            LAUNDER();
            pg8::BigOrder S; S.init(ws + WS_XM, (const bf16_t*)(ws + WS_WIN) + (size_t)l * DIN * D, D, D, M, DIN, F.G, F.blk);
            pg8::EpiBf16<0> E{(bf16_t*)(ws + WS_Z), DIN, ap->in[I_BIN] + (size_t)l * DIN};
            pg8::gemm_phase<pg8::EpiBf16<0>, pg8::BigOrder, true, true>(F.lds, F.tid, pg8::Gemm{D, D, D}, S, E);
        }
        SEAM(p0 + 0);
        if (IN(p0 + 1)) { LAUNDER(); prep_phase(F, ap, l); }
        SEAM(p0 + 1);
        if (IN(p0 + 2)) {
            {
                LAUNDER();
                pg8::BigOrder S; S.init(ws + WS_POOL, (const bf16_t*)(ws + WS_WPT) + (size_t)l * 512 * 512, 512, 512, M, 512, F.G, F.blk);
                pg8::EpiBf16<0> E{(bf16_t*)(ws + WS_Y), D, nullptr};
                pg8::gemm_phase<pg8::EpiBf16<0>, pg8::BigOrder, true, true>(F.lds, F.tid, pg8::Gemm{512, 512, 512}, S, E);
            }
            {
                LAUNDER();
                ScoresOrder S{(const char*)(ws + WS_Z), F.G, (F.blk + 72) % F.G};
                pg8::EpiScores E{(bf16_t*)(ws + WS_ABUF), ap->in[I_RDEC] + l * 8};
                pg8::gemm_phase<pg8::EpiScores, ScoresOrder, true, true>(F.lds, F.tid, pg8::Gemm{DIN, DIN, 256}, S, E);
            }
            {
                LAUNDER();
                UtOrder S{(const char*)(ws + WS_BBUF), (const char*)(ws + WS_KT), F.G, (F.blk + 216) % F.G};
                pg8::EpiF32 E{(float*)(ws + WS_UT), 512, (size_t)256 * 512};
                pg8::gemm_phase<pg8::EpiF32, UtOrder, true, true>(F.lds, F.tid, pg8::Gemm{768, 256, 256}, S, E);
            }
        }
        SEAM(p0 + 2);
        if (IN(p0 + 3)) { LAUNDER(); scan_phase(F, ap, l); LAUNDER(); conv_phase(F, ap, l); }
        SEAM(p0 + 3);
        if (IN(p0 + 4)) {
            LAUNDER();
            OutOrder S{(const char*)(ws + WS_ABUF), (const char*)(ws + WS_BBUF), F.G, F.blk};
            pg8::EpiF32 E{(float*)(ws + WS_OBUF), 256, (size_t)256 * 256};
            pg8::gemm_phase<pg8::EpiF32, OutOrder, true, true>(F.lds, F.tid, pg8::Gemm{768, 768, 768}, S, E);
        }
        SEAM(p0 + 4);
        if (IN(p0 + 5)) { LAUNDER(); gn_phase(F); }
        SEAM(p0 + 5);
        if (IN(p0 + 6)) {
            { LAUNDER(); const bf16_t* PT = (const bf16_t*)(ws + WS_PT) + (size_t)l * D * D; const bf16_t* Y = (const bf16_t*)(ws + WS_Y);
              pg8::BigOrder S; S.init(Y, PT, D, D, M, D, F.G, F.blk); pg8::EpiGate<0> E{(const bf16_t*)(ws + WS_Z), (float*)(ws + WS_MGF), (bf16_t*)(ws + WS_MG)};
              pg8::gemm_phase<pg8::EpiGate<0>, pg8::BigOrder, true, true>(F.lds, F.tid, pg8::Gemm{D, D, 512}, S, E); }
            { LAUNDER(); const bf16_t* PT = (const bf16_t*)(ws + WS_PT) + (size_t)l * D * D; const bf16_t* Y = (const bf16_t*)(ws + WS_Y);
              pg8::BigOrder S; S.init(Y + 512, PT + 512, D, D, M, D, F.G, F.blk); pg8::EpiGate<1> E{(const bf16_t*)(ws + WS_Z), (float*)(ws + WS_MGF), (bf16_t*)(ws + WS_MG)};
              pg8::gemm_phase<pg8::EpiGate<1>, pg8::BigOrder, true, true>(F.lds, F.tid, pg8::Gemm{D, D, 512}, S, E); }
            { LAUNDER(); const bf16_t* PT = (const bf16_t*)(ws + WS_PT) + (size_t)l * D * D; const bf16_t* Y = (const bf16_t*)(ws + WS_Y);
              pg8::BigOrder S; S.init(Y + 1024, PT + 1024, D, D, M, D, F.G, F.blk); pg8::EpiGate<2> E{(const bf16_t*)(ws + WS_Z), (float*)(ws + WS_MGF), (bf16_t*)(ws + WS_MG)};
              pg8::gemm_phase<pg8::EpiGate<2>, pg8::BigOrder, true, true>(F.lds, F.tid, pg8::Gemm{D, D, 1024}, S, E); }
        }
        SEAM(p0 + 6);
        if (IN(p0 + 7)) {
            LAUNDER();
            pg8::BigOrder S; S.init(ws + WS_MG, (const bf16_t*)(ws + WS_WO) + (size_t)l * D * D, D, D, M, D, F.G, F.blk);
            pg8::EpiResid E{(const float*)(ws + WS_X), (float*)(ws + WS_S), ap->in[I_BO] + (size_t)l * D, (const float*)(ws + WS_MOD) + (size_t)l * 5 * 12288 + 2 * D};
            pg8::gemm_phase<pg8::EpiResid, pg8::BigOrder, true, true>(F.lds, F.tid, pg8::Gemm{D, D, D}, S, E);
        }
        SEAM(p0 + 7);
        if (IN(p0 + 8)) { LAUNDER(); ln_phase(F, ap, l, 0); }
        SEAM(p0 + 8);
        if (IN(p0 + 9)) {
            LAUNDER();
            pg8::BigOrder S; S.init(ws + WS_XM, (const bf16_t*)(ws + WS_W1) + (size_t)l * DFF * D, D, D, M, DFF, F.G, F.blk);
            pg8::EpiBf16<1> E{(bf16_t*)(ws + WS_H), DFF, ap->in[I_B1] + (size_t)l * DFF};
            pg8::gemm_phase<pg8::EpiBf16<1>, pg8::BigOrder, true, true>(F.lds, F.tid, pg8::Gemm{D, D, D}, S, E);
        }
        SEAM(p0 + 9);
        if (IN(p0 + 10)) {
            LAUNDER();
            pg8::BigOrder S; S.init(ws + WS_H, (const bf16_t*)(ws + WS_W2) + (size_t)l * D * DFF, DFF, DFF, M, D, F.G, F.blk);
            pg8::EpiResid E{(const float*)(ws + WS_X), (float*)(ws + WS_S), ap->in[I_B2] + (size_t)l * D, (const float*)(ws + WS_MOD) + (size_t)l * 5 * 12288 + 5 * D};
            pg8::gemm_phase<pg8::EpiResid, pg8::BigOrder, true, true>(F.lds, F.tid, pg8::Gemm{DFF, DFF, DFF}, S, E);
        }
        SEAM(p0 + 10);
        if (IN(p0 + 11)) { LAUNDER(); ln_phase(F, ap, l, 1); }
        SEAM(p0 + 11);
    }
#undef IN
#undef SEAM
#undef LAUNDER
}

extern "C" void kernel_launch(void* const* d_in, const int* in_sizes, int n_in, void* d_out, int out_size, void* d_ws, size_t ws_size, hipStream_t stream) {
    static int grid = 0;
    if (grid == 0) {
        if (n_in != 37 || out_size != ML * D || ws_size < WS_END) { fprintf(stderr, "kernel_launch: unexpected shapes (n_in %d, out %d, ws %zu)\n", n_in, out_size, ws_size); grid = -1; return; }
        int dev = 0, cus = 0, per_cu = 0;
        if (hipGetDevice(&dev) != hipSuccess || hipDeviceGetAttribute(&cus, hipDeviceAttributeMultiprocessorCount, dev) != hipSuccess) { grid = -1; return; }
        if (hipFuncSetAttribute((const void*)mk_fwd, hipFuncAttributeMaxDynamicSharedMemorySize, LDS_BYTES) != hipSuccess) { fprintf(stderr, "kernel_launch: hipFuncSetAttribute failed\n"); grid = -1; return; }
        if (hipOccupancyMaxActiveBlocksPerMultiprocessor(&per_cu, (const void*)mk_fwd, 512, LDS_BYTES) != hipSuccess || per_cu < 1) { fprintf(stderr, "kernel_launch: occupancy query says %d\n", per_cu); }
        (void)hipGetLastError();
        grid = cus;
    }
    if (grid < 0) return;
    (void)hipMemsetAsync((char*)d_ws + WS_CTL, 0, 1 * MiB, stream);
    Args a{};
    for (int i = 0; i < 37; ++i) a.in[i] = (const float*)d_in[i];
    a.out = (float*)d_out; a.ws = (unsigned char*)d_ws;
#if MK_PER_PHASE
    for (int p = 0; p < N_PHASES; ++p) { a.ph_lo = p; a.ph_hi = p + 1; hipLaunchKernelGGL(mk_fwd, dim3(grid), dim3(512), LDS_BYTES, stream, a); }
#else
    a.ph_lo = 0; a.ph_hi = N_PHASES;
    hipLaunchKernelGGL(mk_fwd, dim3(grid), dim3(512), LDS_BYTES, stream, a);
#endif
}
```

```cpp
#include <hip/hip_runtime.h>
#include <cstdio>
#include <cstdint>

#ifndef MK_PER_PHASE
#define MK_PER_PHASE 0
#endif

#define LAS __attribute__((address_space(3)))
#define GAS __attribute__((address_space(1)))
typedef unsigned short bf16_t;
typedef short bf16x8 __attribute__((ext_vector_type(8)));
typedef float f32x4 __attribute__((ext_vector_type(4)));
typedef float f32x2 __attribute__((ext_vector_type(2)));
typedef unsigned u32x4 __attribute__((ext_vector_type(4)));
typedef unsigned u32x2 __attribute__((ext_vector_type(2)));

constexpr int D = 2048, NB = 4, SEQ = 2048, DEPTH = 4, CTXL = 256;
constexpr int MC = NB * CTXL, ML = NB * SEQ, M = MC + ML;
constexpr int DIN = 12288, DFF = 8192;
constexpr int O_HY = 512, O_Q = 2048, O_K = 3072, O_V = 4096, O_G = 5120, O_GATE = 6144;
constexpr int NU = 144;
constexpr float LN_EPS = 1e-5f, GN_EPS = 1e-6f;
constexpr float ALPHA = 1.6817928305074290f;

constexpr size_t MiB = 1u << 20;
constexpr size_t WS_CTL = 0;
constexpr size_t WS_MOD = 1 * MiB;
constexpr size_t WS_ROPE = 2 * MiB;
constexpr size_t WS_MODP = 4 * MiB;
constexpr size_t WS_KRG = 20 * MiB;
constexpr size_t WS_KRC = 36 * MiB;
constexpr size_t WS_WPT = 56 * MiB;
constexpr size_t WS_WIN = 58 * MiB;
constexpr size_t WS_PT = 250 * MiB;
constexpr size_t WS_WO = 282 * MiB;
constexpr size_t WS_W1 = 314 * MiB;
constexpr size_t WS_W2 = 442 * MiB;
constexpr size_t WS_X = 570 * MiB;
constexpr size_t WS_XM = 642 * MiB;
constexpr size_t WS_Z = 678 * MiB;
constexpr size_t WS_H = WS_Z;
constexpr size_t WS_Y = 894 * MiB;
constexpr size_t WS_UTBL = 930 * MiB;
constexpr size_t WS_UTBC = 938 * MiB;
constexpr size_t WS_X0TL = 939 * MiB;
constexpr size_t WS_X0TC = 947 * MiB;
constexpr size_t WS_POOL = 966 * MiB;
constexpr size_t WS_ABUF = 976 * MiB;
constexpr size_t WS_BBUF = 1030 * MiB;
constexpr size_t WS_KT = 1084 * MiB;
constexpr size_t WS_UT = 1120 * MiB;
constexpr size_t WS_OBUF = 1192 * MiB;
constexpr size_t WS_MGF = 1228 * MiB;
constexpr size_t WS_S = WS_MGF;
constexpr size_t WS_MG = 1300 * MiB;
constexpr size_t WS_END = 1336 * MiB;

constexpr int RING_BYTES = 131072;
constexpr int MISC_OFF = RING_BYTES;
constexpr int LDS_BYTES = 147456;

#define RLX_AGENT __ATOMIC_RELAXED, __HIP_MEMORY_SCOPE_AGENT
#define LDS_WAIT() asm volatile("s_waitcnt lgkmcnt(0)" ::: "memory")
#define VM_WAIT() asm volatile("s_waitcnt vmcnt(0)" ::: "memory")

__device__ __forceinline__ unsigned f2bf(float f) { unsigned u = __builtin_bit_cast(unsigned, f); return (u + 0x7fffu + ((u >> 16) & 1u)) >> 16; }
__device__ __forceinline__ unsigned pk2(float lo, float hi) { return f2bf(lo) | (f2bf(hi) << 16); }
__device__ __forceinline__ float bflo(unsigned w) { return __builtin_bit_cast(float, w << 16); }
__device__ __forceinline__ float bfhi(unsigned w) { return __builtin_bit_cast(float, w & 0xffff0000u); }
__device__ __forceinline__ float bf1(bf16_t h) { return __builtin_bit_cast(float, ((unsigned)h) << 16); }

namespace pg8 {
constexpr int BM = 256, BK = 64, HALF = 128, HTB = HALF * BK * 2, STAGE_BYTES = 8 * HTB, NXCD = 8, WGM = 8;
__host__ __device__ __forceinline__ int lds_byte(int r, int c) { const int st = (r >> 4) * 2 + (c >> 5), rr = r & 15, cc = c & 31, ob = rr * 64 + cc * 2; return st * 1024 + (ob ^ (((ob >> 9) & 1) << 5)); }
__host__ __device__ __forceinline__ void stage_rc(int b, int& R, int& C) { const int st = b / 1024, sb = b % 1024, swz = sb ^ (((sb >> 9) & 1) << 5); R = (st >> 1) * 16 + swz / 64; C = (st & 1) * 32 + (swz % 64) / 2; }
__host__ __device__ __forceinline__ int perm32(int rho) { const int n = rho >> 4, i = rho & 15; return 8 * (i >> 2) + 4 * n + (i & 3); }

struct Unit { int pm, pn, z; };
struct Gemm { int lda, ldb, K; };

__device__ __forceinline__ unsigned cvt_pk_bf16(float lo, float hi) { unsigned r; asm volatile("v_cvt_pk_bf16_f32 %0, %1, %2" : "=v"(r) : "v"(lo), "v"(hi)); return r; }

struct BigOrder {
    const char* A; const char* B; size_t astep, bstep; int nM, nN, nwg, G, c;
    __device__ __forceinline__ void init(const void* A_, const void* B_, int lda, int ldb, int M_, int N_, int G_, int c_) {
        A = (const char*)A_; B = (const char*)B_; astep = (size_t)BM * lda * 2; bstep = (size_t)BM * ldb * 2; nM = M_ / BM; nN = N_ / BM; nwg = nM * nN; G = G_; c = c_; }
    __device__ __forceinline__ bool next(int i, Unit& u) const {
        const long L = (long)i * G + c; if (L >= nwg) return false;
        int wgid = (int)L; { const int q = nwg / NXCD, r = nwg % NXCD, xcd = wgid % NXCD, off = wgid / NXCD; wgid = (xcd < r ? xcd * (q + 1) : r * (q + 1) + (xcd - r) * q) + off; }
        const int nig = WGM * nN, gid = wgid / nig, fm = gid * WGM, gsz = (nM - fm) < WGM ? (nM - fm) : WGM;
        u.pm = fm + ((wgid % nig) % gsz); u.pn = (wgid % nig) / gsz; u.z = 0; return true;
    }
    __device__ __forceinline__ const char* aptr(const Unit& u) const { return A + (size_t)u.pm * astep; }
    __device__ __forceinline__ const char* bptr(const Unit& u) const { return B + (size_t)u.pn * bstep; }
};

template <class Epi, class Sched, bool ALIGN_EPI, bool SP2>
__device__ __forceinline__ void gemm_phase(LAS unsigned char* lds, const int tid, const Gemm g, const Sched& S, const Epi& E) {
    const int wid = __builtin_amdgcn_readfirstlane(tid >> 6), lane = tid & 63, wr = wid >> 2, wc = wid & 3, fr = lane & 15, fq = lane >> 4;
    const int K = g.K, nt = K / BK;
    unsigned voffA[2], voffB[2];
#pragma unroll
    for (int i = 0; i < 2; ++i) { int R, C; stage_rc(tid * 16 + i * 8192, R, C); const int Rb = Epi::PERM ? ((R & ~31) + perm32(R & 31)) : R;
        voffA[i] = (unsigned)(R * g.lda + C) * 2u; voffB[i] = (unsigned)(Rb * g.ldb + C) * 2u; }
    const size_t kstep = (size_t)(BK * 2);
    const size_t hstepA = (size_t)HALF * g.lda * 2, hstepB = (size_t)HALF * g.ldb * 2;
    const unsigned ldsw = (unsigned)wid * 1024u;
    const int aoff = lds_byte(wr * 64 + fr, fq * 8), boff = lds_byte(wc * 32 + fr, fq * 8);
#define PG8_SA(b, h) (((b) * 2 + (h)) * HTB)
#define PG8_SB(b, h) ((4 + (b) * 2 + (h)) * HTB)
#define PG8_STAGE(bufoff, gbase, voff) do { _Pragma("unroll") for (int _i = 0; _i < 2; ++_i) \
        __builtin_amdgcn_global_load_lds((const unsigned*)((const char*)(gbase) + (voff)[_i]), (LAS unsigned*)(lds + (bufoff) + ldsw + _i * 8192), 16, 0, 0); } while (0)
#define PG8_LDA(dst, b, h) do { _Pragma("unroll") for (int m = 0; m < 4; ++m) _Pragma("unroll") for (int k = 0; k < 2; ++k) dst[m][k] = *(const LAS bf16x8*)(lds + PG8_SA(b, h) + aoff + m * 2048 + k * 1024); } while (0)
#define PG8_LDB(dst, b, h) do { _Pragma("unroll") for (int n = 0; n < 2; ++n) _Pragma("unroll") for (int k = 0; k < 2; ++k) dst[n][k] = *(const LAS bf16x8*)(lds + PG8_SB(b, h) + boff + n * 2048 + k * 1024); } while (0)
#define PG8_MMA(ai, bj, At, Bt) do { __builtin_amdgcn_s_setprio(1); _Pragma("unroll") for (int m = 0; m < 4; ++m) _Pragma("unroll") for (int n = 0; n < 2; ++n) _Pragma("unroll") for (int k = 0; k < 2; ++k) \
        acc[ai][bj][m][n] = __builtin_amdgcn_mfma_f32_16x16x32_bf16(Bt[n][k], At[m][k], acc[ai][bj][m][n], 0, 0, 0); __builtin_amdgcn_s_setprio(0); } while (0)
#define PG8_WAIT_V(n) asm volatile("s_waitcnt vmcnt(" #n ")" ::: "memory")
#define PG8_WAIT_L(n) asm volatile("s_waitcnt lgkmcnt(" #n ")" ::: "memory")
#define PG8_BAR __builtin_amdgcn_s_barrier()
#define PG8_SCHED __builtin_amdgcn_sched_barrier(0)
    Unit cur, nxt; int ui = 0;
    if (!S.next(0, cur)) return;
    f32x4 acc[2][2][4][2];
#pragma unroll
    for (int a = 0; a < 2; ++a)
#pragma unroll
        for (int b = 0; b < 2; ++b)
#pragma unroll
            for (int m = 0; m < 4; ++m)
#pragma unroll
                for (int n = 0; n < 2; ++n) acc[a][b][m][n] = (f32x4){0.f, 0.f, 0.f, 0.f};
    bf16x8 At[4][2], B0[2][2], B1[2][2];
    const char* cA = S.aptr(cur); const char* cB = S.bptr(cur);
    if constexpr (SP2) {
        PG8_STAGE(PG8_SB(0, 0), cB, voffB); PG8_STAGE(PG8_SB(0, 1), cB + hstepB, voffB); PG8_STAGE(PG8_SA(0, 0), cA, voffA); PG8_STAGE(PG8_SA(0, 1), cA + hstepA, voffA);
        if (wr == 1) PG8_BAR;
        PG8_WAIT_V(2); PG8_BAR;
        PG8_STAGE(PG8_SB(1, 0), cB + kstep, voffB); PG8_STAGE(PG8_SA(1, 0), cA + kstep, voffA); PG8_STAGE(PG8_SB(1, 1), cB + hstepB + kstep, voffB);
        PG8_WAIT_V(6); PG8_BAR;
    } else {
        PG8_STAGE(PG8_SB(0, 0), cB, voffB); PG8_STAGE(PG8_SA(0, 0), cA, voffA); PG8_STAGE(PG8_SB(0, 1), cB + hstepB, voffB); PG8_STAGE(PG8_SA(0, 1), cA + hstepA, voffA);
        if (wr == 1) PG8_BAR;
        PG8_WAIT_V(4); PG8_BAR;
        PG8_STAGE(PG8_SB(1, 0), cB + kstep, voffB); PG8_STAGE(PG8_SA(1, 0), cA + kstep, voffA); PG8_STAGE(PG8_SB(1, 1), cB + hstepB + kstep, voffB);
        PG8_WAIT_V(6); PG8_BAR;
    }
    for (;;) {
        const bool has_next = S.next(ui + 1, nxt);
        const char* nA = has_next ? S.aptr(nxt) : cA; const char* nB = has_next ? S.bptr(nxt) : cB;
#pragma unroll 1
        for (int t = 0; t < nt; t += 2) {
            const bool last = (t == nt - 2);
            const char* a1 = cA + (size_t)(t + 1) * kstep;
            const char* a2 = last ? nA : cA + (size_t)(t + 2) * kstep; const char* b2 = last ? nB : cB + (size_t)(t + 2) * kstep;
            const char* a3 = a2 + kstep; const char* b3 = b2 + kstep;
            if constexpr (SP2) {
            PG8_LDB(B0, 0, 0); PG8_LDB(B1, 0, 1); PG8_SCHED; PG8_LDA(At, 0, 0); PG8_STAGE(PG8_SA(1, 1), a1 + hstepA, voffA);
            PG8_WAIT_V(8); PG8_WAIT_L(0); PG8_BAR; PG8_MMA(0, 0, At, B0); PG8_MMA(0, 1, At, B1); PG8_BAR; PG8_SCHED;
            PG8_LDA(At, 0, 1); PG8_STAGE(PG8_SB(0, 0), b2, voffB); PG8_STAGE(PG8_SB(0, 1), b2 + hstepB, voffB); PG8_STAGE(PG8_SA(0, 0), a2, voffA);
            PG8_WAIT_V(8); PG8_WAIT_L(0); PG8_BAR; PG8_MMA(1, 0, At, B0); PG8_MMA(1, 1, At, B1); PG8_BAR; PG8_SCHED;
            PG8_LDB(B0, 1, 0); PG8_LDB(B1, 1, 1); PG8_SCHED; PG8_LDA(At, 1, 0); PG8_STAGE(PG8_SA(0, 1), a2 + hstepA, voffA);
            PG8_WAIT_V(8); PG8_WAIT_L(0); PG8_BAR; PG8_MMA(0, 0, At, B0); PG8_MMA(0, 1, At, B1); PG8_BAR; PG8_SCHED;
            PG8_LDA(At, 1, 1); PG8_STAGE(PG8_SB(1, 0), b3, voffB); PG8_STAGE(PG8_SB(1, 1), b3 + hstepB, voffB); PG8_STAGE(PG8_SA(1, 0), a3, voffA);
            PG8_WAIT_V(8); PG8_WAIT_L(0); PG8_BAR; PG8_MMA(1, 0, At, B0); PG8_MMA(1, 1, At, B1); PG8_BAR; PG8_SCHED;
            } else {
            PG8_LDB(B0, 0, 0); PG8_SCHED; PG8_LDA(At, 0, 0); PG8_STAGE(PG8_SA(1, 1), a1 + hstepA, voffA);
            PG8_WAIT_L(8); PG8_BAR; PG8_WAIT_L(0); PG8_MMA(0, 0, At, B0); PG8_BAR; PG8_SCHED;
            PG8_LDB(B1, 0, 1); PG8_STAGE(PG8_SB(0, 0), b2, voffB);
            PG8_BAR; PG8_WAIT_L(0); PG8_MMA(0, 1, At, B1); PG8_BAR;
            PG8_LDA(At, 0, 1); PG8_STAGE(PG8_SA(0, 0), a2, voffA);
            PG8_BAR; PG8_WAIT_L(0); PG8_MMA(1, 0, At, B0); PG8_BAR; PG8_SCHED;
            PG8_STAGE(PG8_SB(0, 1), b2 + hstepB, voffB);
            PG8_WAIT_V(6); PG8_BAR; PG8_MMA(1, 1, At, B1); PG8_BAR;
            PG8_LDB(B0, 1, 0); PG8_SCHED; PG8_LDA(At, 1, 0); PG8_STAGE(PG8_SA(0, 1), a2 + hstepA, voffA);
            PG8_WAIT_L(8); PG8_BAR; PG8_WAIT_L(0); PG8_MMA(0, 0, At, B0); PG8_BAR; PG8_SCHED;
            PG8_LDB(B1, 1, 1); PG8_STAGE(PG8_SB(1, 0), b3, voffB);
            PG8_BAR; PG8_WAIT_L(0); PG8_MMA(0, 1, At, B1); PG8_BAR;
            PG8_LDA(At, 1, 1); PG8_STAGE(PG8_SA(1, 0), a3, voffA);
            PG8_BAR; PG8_WAIT_L(0); PG8_MMA(1, 0, At, B0); PG8_BAR; PG8_SCHED;
            PG8_STAGE(PG8_SB(1, 1), b3 + hstepB, voffB);
            PG8_WAIT_V(6); PG8_BAR; PG8_MMA(1, 1, At, B1); PG8_BAR;
            }
        }
        if constexpr (ALIGN_EPI) { if (wr == 0) PG8_BAR; }
        E(acc, cur, wr, wc, fr, fq);
        if (!has_next) break;
#pragma unroll
        for (int a = 0; a < 2; ++a)
#pragma unroll
            for (int b = 0; b < 2; ++b)
#pragma unroll
                for (int m = 0; m < 4; ++m)
#pragma unroll
                    for (int n = 0; n < 2; ++n) acc[a][b][m][n] = (f32x4){0.f, 0.f, 0.f, 0.f};
        cur = nxt; cA = nA; cB = nB; ++ui;
        if constexpr (ALIGN_EPI) { if (wr == 1) PG8_BAR; }
    }
    PG8_WAIT_V(0);
    if constexpr (!ALIGN_EPI) { if (wr == 0) PG8_BAR; }
    PG8_BAR;
#undef PG8_SA
#undef PG8_SB
#undef PG8_STAGE
#undef PG8_LDA
#undef PG8_LDB
#undef PG8_MMA
#undef PG8_WAIT_V
#undef PG8_WAIT_L
#undef PG8_BAR
#undef PG8_SCHED
}


template <int ACT> struct EpiBf16 {
    static constexpr bool PERM = true;
    bf16_t* O; int ldc; const float* bias;
    __device__ __forceinline__ void operator()(const f32x4 (&acc)[2][2][4][2], const Unit& u, int wr, int wc, int fr, int fq) const {
        const int row0 = u.pm * BM + wr * 64 + fr, col0 = u.pn * BM + wc * 32 + 8 * fq;
        f32x4 bv[2][2];
#pragma unroll
        for (int bj = 0; bj < 2; ++bj)
#pragma unroll
            for (int n = 0; n < 2; ++n) bv[bj][n] = bias ? *(const f32x4*)(bias + col0 + bj * HALF + 4 * n) : (f32x4){0.f, 0.f, 0.f, 0.f};
#pragma unroll
        for (int ai = 0; ai < 2; ++ai)
#pragma unroll
            for (int m = 0; m < 4; ++m) { bf16_t* rowp = O + (size_t)(row0 + ai * HALF + m * 16) * ldc + col0;
#pragma unroll
                for (int bj = 0; bj < 2; ++bj) { f32x4 v0 = acc[ai][bj][m][0] + bv[bj][0], v1 = acc[ai][bj][m][1] + bv[bj][1];
                    if (ACT == 1) {
#pragma unroll
                        for (int j = 0; j < 4; ++j) { const float a = fmaxf(v0[j], 0.f), b = fmaxf(v1[j], 0.f); v0[j] = a * a; v1[j] = b * b; } }
                    u32x4 w; w.x = cvt_pk_bf16(v0[0], v0[1]); w.y = cvt_pk_bf16(v0[2], v0[3]); w.z = cvt_pk_bf16(v1[0], v1[1]); w.w = cvt_pk_bf16(v1[2], v1[3]);
                    *(u32x4*)(rowp + bj * HALF) = w; } }
    }
};
struct EpiScores {
    static constexpr bool PERM = true;
    bf16_t* O; const float* rdec;
    __device__ __forceinline__ void operator()(const f32x4 (&acc)[2][2][4][2], const Unit& u, int wr, int wc, int fr, int fq) const {
        const int h = (u.z / 9) & 3; const float lf = log1pf(-expf(rdec[h])) * 1.4426950408889634f, lb = log1pf(-expf(rdec[4 + h])) * 1.4426950408889634f;
        bf16_t* base = O + (size_t)u.z * 256 * 768 + (size_t)(wr * 64 + fr) * 768 + wc * 32 + 8 * fq;
        float d00 = (float)(wr * 64 + fr - wc * 32 - 8 * fq);
        asm volatile("" : "+v"(d00));
#pragma unroll
        for (int ai = 0; ai < 2; ++ai)
#pragma unroll
            for (int m = 0; m < 4; ++m) {
#pragma unroll
                for (int bj = 0; bj < 2; ++bj) { float v[8];
#pragma unroll
                    for (int n = 0; n < 2; ++n)
#pragma unroll
                        for (int e = 0; e < 4; ++e) { const float d = d00 + (float)(ai * HALF + m * 16 - bj * HALF - 4 * n - e);
                            const float dp = fmaxf(d, 0.f), dn = fmaxf(-d, 0.f);
                            const float mk = __builtin_amdgcn_exp2f(dp * lf + dn * lb) + (1.0f - fminf(dp + dn, 1.0f));
                            v[4 * n + e] = acc[ai][bj][m][n][e] * mk; }
                    u32x4 w; w.x = cvt_pk_bf16(v[0], v[1]); w.y = cvt_pk_bf16(v[2], v[3]); w.z = cvt_pk_bf16(v[4], v[5]); w.w = cvt_pk_bf16(v[6], v[7]);
                    *(u32x4*)(base + (size_t)(ai * HALF + m * 16) * 768 + bj * HALF) = w; }
                asm volatile("" ::: "memory"); }
    }
};
struct EpiF32 {
    static constexpr bool PERM = false;
    float* C; int ldc; size_t zstride;
    __device__ __forceinline__ void operator()(const f32x4 (&acc)[2][2][4][2], const Unit& u, int wr, int wc, int fr, int fq) const {
        const int row0 = u.pm * BM + wr * 64 + fr, col0 = u.pn * BM + wc * 32 + 4 * fq; float* Cz = C + (size_t)u.z * zstride;
#pragma unroll
        for (int ai = 0; ai < 2; ++ai)
#pragma unroll
            for (int m = 0; m < 4; ++m) { float* rowp = Cz + (size_t)(row0 + ai * HALF + m * 16) * ldc + col0;
#pragma unroll
                for (int bj = 0; bj < 2; ++bj)
#pragma unroll
                    for (int n = 0; n < 2; ++n) *(f32x4*)(rowp + bj * HALF + n * 16) = acc[ai][bj][m][n]; }
    }
};
template <int PASS> struct EpiGate {
    static constexpr bool PERM = false;
    const bf16_t* Z; float* MGF; bf16_t* MG;
    __device__ __forceinline__ void operator()(const f32x4 (&acc)[2][2][4][2], const Unit& u, int wr, int wc, int fr, int fq) const {
        const int row0 = u.pm * BM + wr * 64 + fr, col0 = u.pn * BM + wc * 32 + 4 * fq;
#pragma unroll
        for (int ai = 0; ai < 2; ++ai)
#pragma unroll
            for (int m = 0; m < 4; ++m) { const size_t row = (size_t)(row0 + ai * HALF + m * 16);
#pragma unroll
                for (int bj = 0; bj < 2; ++bj)
#pragma unroll
                    for (int n = 0; n < 2; ++n) { const int col = col0 + bj * HALF + n * 16;
                        const u32x2 gz = *(const u32x2*)(Z + row * DIN + O_GATE + PASS * D + col);
                        f32x4 gt; gt[0] = bflo(gz.x); gt[1] = bfhi(gz.x); gt[2] = bflo(gz.y); gt[3] = bfhi(gz.y);
#pragma unroll
                        for (int e = 0; e < 4; ++e) gt[e] = 1.0f / (1.0f + __expf(-gt[e]));
                        f32x4 r = gt * acc[ai][bj][m][n];
                        float* mp = MGF + row * D + col;
                        if (PASS > 0) r = r + *(const f32x4*)mp;
                        if (PASS < 2) *(f32x4*)mp = r;
                        else { u32x2 w; w.x = cvt_pk_bf16(r[0], r[1]); w.y = cvt_pk_bf16(r[2], r[3]); *(u32x2*)(MG + row * D + col) = w; } } }
    }
};
struct EpiResid {
    static constexpr bool PERM = false;
    const float* X; float* S; const float* bias; const float* gate;
    __device__ __forceinline__ void operator()(const f32x4 (&acc)[2][2][4][2], const Unit& u, int wr, int wc, int fr, int fq) const {
        const int row0 = u.pm * BM + wr * 64 + fr, col0 = u.pn * BM + wc * 32 + 4 * fq;
        const int bmod = u.pm < 4 ? 4 : ((u.pm - 4) >> 3);
        const float* gp = gate + (size_t)bmod * 12288;
        f32x4 bv[2][2], gv[2][2];
#pragma unroll
        for (int bj = 0; bj < 2; ++bj)
#pragma unroll
            for (int n = 0; n < 2; ++n) { bv[bj][n] = *(const f32x4*)(bias + col0 + bj * HALF + n * 16); gv[bj][n] = *(const f32x4*)(gp + col0 + bj * HALF + n * 16); }
#pragma unroll
        for (int ai = 0; ai < 2; ++ai)
#pragma unroll
            for (int m = 0; m < 4; ++m) { const size_t off = (size_t)(row0 + ai * HALF + m * 16) * D + col0;
#pragma unroll
                for (int bj = 0; bj < 2; ++bj)
#pragma unroll
                    for (int n = 0; n < 2; ++n) { const f32x4 xv = *(const f32x4*)(X + off + bj * HALF + n * 16);
                        *(f32x4*)(S + off + bj * HALF + n * 16) = xv * ALPHA + gv[bj][n] * (acc[ai][bj][m][n] + bv[bj][n]); } }
    }
};
}

#define XB_TMO      128
#define XB_XCNT(j)  (256  + 64 * (j))
#define XB_XSUB(j)  (1280 + 64 * (j))
#define XB_XGEN(j)  (2304 + 64 * (j))
#define XB_TOP      3328
#define XB_TOPGEN   3392
#define XCD_BAR_WORDS 3456
#define XB_SPIN_CAP (1u << 22)

__device__ __forceinline__ unsigned xb_ld(unsigned* p)              { return __hip_atomic_load(p, __ATOMIC_RELAXED, __HIP_MEMORY_SCOPE_AGENT); }
__device__ __forceinline__ unsigned xb_add(unsigned* p, unsigned v) { return __hip_atomic_fetch_add(p, v, __ATOMIC_RELAXED, __HIP_MEMORY_SCOPE_AGENT); }
__device__ __forceinline__ unsigned xb_xcc_id() { return (unsigned)__builtin_amdgcn_s_getreg((3 << 11) | 20) & 0xFu; }
#define XB_SPIN(cond, bar) do { unsigned _sp = 0; while (cond) { __builtin_amdgcn_s_sleep(1); \
    if ((++_sp & 255u) == 0u) { if (xb_ld(&(bar)[XB_TMO])) break; if (_sp > XB_SPIN_CAP) { atomicAdd(&(bar)[XB_TMO], 1u); break; } } } } while (0)

struct XcdBarrier { unsigned* bar; unsigned x; volatile LAS unsigned* st; };

__device__ __forceinline__ XcdBarrier xcd_barrier_post(unsigned* bar, volatile LAS unsigned* st) {
    XcdBarrier b; b.bar = bar; b.x = xb_xcc_id(); b.st = st;
    if (threadIdx.x == 0) (void)xb_add(&bar[XB_XCNT(b.x)], 1u);
    return b;
}
__device__ __forceinline__ void xcd_barrier_complete(unsigned* bar, unsigned x, unsigned& nloc, unsigned& nx) {
    const unsigned G = gridDim.x * gridDim.y * gridDim.z;
    unsigned sum, cnt, mine, sp = 0u;
    for (;;) {
        sum = 0u; cnt = 0u; mine = 0u;
#pragma unroll
        for (unsigned j = 0; j < 16; ++j) { const unsigned c = xb_ld(&bar[XB_XCNT(j)]); sum += c; cnt += (c > 0u) ? 1u : 0u; mine = (j == x) ? c : mine; }
        if (sum == G) break;
        __builtin_amdgcn_s_sleep(1);
        if ((++sp & 255u) == 0u) { if (xb_ld(&bar[XB_TMO])) break; if (sp > XB_SPIN_CAP) { atomicAdd(&bar[XB_TMO], 1u); break; } }
    }
    nloc = mine > 0u ? mine : 1u; nx = cnt > 0u ? cnt : 1u;
}
__device__ __forceinline__ void xcd_barrier(const XcdBarrier& b) {
    asm volatile("s_waitcnt vmcnt(0)" ::: "memory");
    __syncthreads();
    if (threadIdx.x == 0) {
        unsigned* bar = b.bar;
        __builtin_amdgcn_s_waitcnt(0);
        unsigned nloc = b.st[0], nx = b.st[1];
        if (nloc == 0u) { xcd_barrier_complete(bar, b.x, nloc, nx); b.st[0] = nloc; b.st[1] = nx; }
        const unsigned old = xb_add(&bar[XB_XSUB(b.x)], 1u);
        const unsigned gen = old / nloc;
        if (old + 1u == (gen + 1u) * nloc) {
            __builtin_amdgcn_fence(__ATOMIC_RELEASE, "agent");
            asm volatile("s_waitcnt vmcnt(0)" ::: "memory");
            const unsigned og = xb_add(&bar[XB_TOP], 1u);
            const unsigned tg = og / nx;
            if (og + 1u == (tg + 1u) * nx) xb_add(&bar[XB_TOPGEN], 1u);
            else XB_SPIN(xb_ld(&bar[XB_TOPGEN]) == tg, bar);
            __builtin_amdgcn_fence(__ATOMIC_ACQUIRE, "agent");
            xb_add(&bar[XB_XGEN(b.x)], 1u);
            asm volatile("s_waitcnt vmcnt(0)" ::: "memory");
        } else {
            XB_SPIN(xb_ld(&bar[XB_XGEN(b.x)]) == gen, bar);
            __builtin_amdgcn_fence(__ATOMIC_ACQUIRE, "agent");
            asm volatile("s_waitcnt vmcnt(0)" ::: "memory");
        }
    }
    __syncthreads();
}

struct Args { const float* in[37]; float* out; unsigned char* ws; int ph_lo, ph_hi; };
typedef const __attribute__((address_space(4))) Args* CArgs;
enum { I_X = 0, I_C, I_CTX, I_CCTX, I_WADA, I_BADA, I_WIN, I_BIN, I_CONVW, I_CONVB, I_POOLW, I_POOLS, I_FW1, I_FB1, I_FF1, I_FW2, I_FB2, I_FF2, I_FW3, I_FB3, I_FF3, I_FW4,
       I_HYD, I_RDEC, I_PA, I_PB, I_PC, I_WO, I_BO, I_LN1G, I_LN1B, I_W1, I_B1, I_W2, I_B2, I_LN2G, I_LN2B };

struct Frame {
    LAS unsigned char* lds;
    int tid, lane, wave, blk, G;
    unsigned char* ws;
};

__device__ __forceinline__ float wave_sum(float v) {
#pragma unroll
    for (int o = 1; o < 64; o <<= 1) v += __shfl_xor(v, o);
    return v;
}
__device__ __forceinline__ float silu_f(float v) { return v / (1.0f + __expf(-v)); }
__device__ __forceinline__ int chunk_row0(int b, int ci) { return ci == 0 ? b * CTXL : MC + b * SEQ + (ci - 1) * 256; }
__device__ __forceinline__ float ret_lg2(const float* rdec, int l, int dirh) { const float p = rdec[l * 8 + dirh]; return log1pf(-expf(p)) * 1.4426950408889634f; }

__device__ __forceinline__ void transpose_item(const float* W, int N, bf16_t* WT, int ldw, int koff, LAS float* scr, int item, int lane) {
    const int nblk = N / 32, kb = item / nblk, nb = item % nblk, k0 = 64 * kb, n0 = 32 * nb;
#pragma unroll 8
    for (int i = 0; i < 32; ++i) { const int kk = 2 * i + (lane >> 5); scr[kk * 33 + (lane & 31)] = W[(size_t)(k0 + kk) * N + n0 + (lane & 31)]; }
    LDS_WAIT(); asm volatile("" ::: "memory");
    const int c = lane & 7;
#pragma unroll
    for (int j = 0; j < 4; ++j) { const int n = (lane >> 3) + 8 * j; const LAS float* s = scr + (8 * c) * 33 + n;
        u32x4 o; o.x = pk2(s[0 * 33], s[1 * 33]); o.y = pk2(s[2 * 33], s[3 * 33]); o.z = pk2(s[4 * 33], s[5 * 33]); o.w = pk2(s[6 * 33], s[7 * 33]);
        *(u32x4*)(WT + (size_t)(n0 + n) * ldw + koff + k0 + 8 * c) = o; }
    LDS_WAIT(); asm volatile("" ::: "memory");
}

__device__ __forceinline__ void pro_a(Frame& F, CArgs a) {
    LAS float* scr = (LAS float*)(F.lds + F.wave * 16384);
    const int gw = F.blk * 8 + F.wave, NGW = F.G * 8, lane = F.lane;
    unsigned char* ws = F.ws;
    constexpr int I_IN = 32 * 384, I_PAB = 8 * 64, I_PCC = 16 * 64, I_O = 32 * 64, I_1 = 32 * 256, I_2 = 128 * 64;
    constexpr int PER_L = I_IN + 2 * I_PAB + I_PCC + I_O + I_1 + I_2;
    for (int it = gw; it < DEPTH * PER_L; it += NGW) {
        const int l = it / PER_L; int r = it % PER_L;
        if (r < I_IN) { transpose_item(a->in[I_WIN] + (size_t)l * D * DIN, DIN, (bf16_t*)(ws + WS_WIN) + (size_t)l * DIN * D, D, 0, scr, r, lane); continue; } r -= I_IN;
        if (r < I_PAB) { transpose_item(a->in[I_PA] + (size_t)l * 512 * D, D, (bf16_t*)(ws + WS_PT) + (size_t)l * D * D, D, 0, scr, r, lane); continue; } r -= I_PAB;
        if (r < I_PAB) { transpose_item(a->in[I_PB] + (size_t)l * 512 * D, D, (bf16_t*)(ws + WS_PT) + (size_t)l * D * D, D, 512, scr, r, lane); continue; } r -= I_PAB;
        if (r < I_PCC) { transpose_item(a->in[I_PC] + (size_t)l * 1024 * D, D, (bf16_t*)(ws + WS_PT) + (size_t)l * D * D, D, 1024, scr, r, lane); continue; } r -= I_PCC;
        if (r < I_O) { transpose_item(a->in[I_WO] + (size_t)l * D * D, D, (bf16_t*)(ws + WS_WO) + (size_t)l * D * D, D, 0, scr, r, lane); continue; } r -= I_O;
        if (r < I_1) { transpose_item(a->in[I_W1] + (size_t)l * D * DFF, DFF, (bf16_t*)(ws + WS_W1) + (size_t)l * DFF * D, D, 0, scr, r, lane); continue; } r -= I_1;
        transpose_item(a->in[I_W2] + (size_t)l * DFF * D, D, (bf16_t*)(ws + WS_W2) + (size_t)l * D * DFF, DFF, 0, scr, r, lane);
    }
    {
        float* modp = (float*)(ws + WS_MODP);
        for (int it = gw; it < DEPTH * 192 * 16; it += NGW) {
            const int ks = it & 15, cb = (it >> 4) % 192, l = it / (16 * 192);
            const int col = cb * 64 + lane, k0 = ks * 128;
            float sv0[5], sv1[5];
#pragma unroll
            for (int b = 0; b < 5; ++b) { const float* cp = b < 4 ? a->in[I_C] + b * D : a->in[I_CCTX]; sv0[b] = silu_f(cp[k0 + lane]); sv1[b] = silu_f(cp[k0 + 64 + lane]); }
            float acc[5] = {0.f, 0.f, 0.f, 0.f, 0.f};
            const float* wp = a->in[I_WADA] + ((size_t)l * D + k0) * 12288 + col;
            for (int kk = 0; kk < 64; ++kk) { const float w = wp[(size_t)kk * 12288];
#pragma unroll
                for (int b = 0; b < 5; ++b) acc[b] += __shfl(sv0[b], kk) * w; }
            for (int kk = 0; kk < 64; ++kk) { const float w = wp[(size_t)(64 + kk) * 12288];
#pragma unroll
                for (int b = 0; b < 5; ++b) acc[b] += __shfl(sv1[b], kk) * w; }
#pragma unroll
            for (int b = 0; b < 5; ++b) modp[(((size_t)ks * DEPTH + l) * 5 + b) * 12288 + col] = acc[b];
        }
    }
    {
        LAS float* H3 = (LAS float*)F.lds;
        bf16_t* krg = (bf16_t*)(ws + WS_KRG); bf16_t* krc = (bf16_t*)(ws + WS_KRC);
        for (int it = F.blk; it < DEPTH * 36; it += F.G) {
            const int l = it / 36, grp = it % 36; const bool isc = grp >= 32; const int L = isc ? CTXL : SEQ, p0 = (isc ? grp - 32 : grp) * 64;
            __syncthreads();
            for (int pp = 0; pp < 8; ++pp) {
                const int pos = p0 + F.wave * 8 + pp;
                const float t = (float)pos / (float)(L - 1);
                const float w = 6.2831853071795862f * (float)pos / (float)L;
                float zf = 0.f;
                if (lane == 0) zf = t;
                else if (lane < 33) { const int bi = (lane - 1) & 15; const float f = 1e-4f + (float)bi * ((15.0f - 1e-4f) / 15.0f); const float ang = f * w; zf = lane <= 16 ? cosf(ang) : -sinf(ang); }
                float h = a->in[I_FB1][l * 64 + lane];
                for (int i = 0; i < 33; ++i) h += __shfl(zf, i) * a->in[I_FW1][((size_t)l * 33 + i) * 64 + lane];
                h = sinf(a->in[I_FF1][l * 64 + lane] * h);
                float h2 = a->in[I_FB2][l * 64 + lane];
                for (int i = 0; i < 64; ++i) h2 += __shfl(h, i) * a->in[I_FW2][((size_t)l * 64 + i) * 64 + lane];
                h2 = sinf(a->in[I_FF2][l * 64 + lane] * h2);
                float h3 = a->in[I_FB3][l * 64 + lane];
                for (int i = 0; i < 64; ++i) h3 += __shfl(h2, i) * a->in[I_FW3][((size_t)l * 64 + i) * 64 + lane];
                h3 = sinf(a->in[I_FF3][l * 64 + lane] * h3);
                H3[(F.wave * 8 + pp) * 64 + lane] = h3;
            }
            __syncthreads();
            const int c = F.tid;
            const float min_decay = -3.0701134573253945f, max_decay = -15.350567286626973f;
            const float adelta = fabsf(min_decay + (float)c * ((max_decay - min_decay) / 511.0f));
            bf16_t* dst = isc ? krc + ((size_t)l * 512 + c) * 512 : krg + ((size_t)l * 512 + c) * 4096;
            const int center = isc ? CTXL : SEQ;
            if (p0 == 0) dst[0] = (bf16_t)0;
#pragma unroll 1
            for (int dir = 0; dir < 2; ++dir) {
                float wc[64];
#pragma unroll
                for (int i = 0; i < 64; ++i) wc[i] = a->in[I_FW4][((size_t)l * 64 + i) * 1024 + dir * 512 + c];
#pragma unroll 2
                for (int pp = 0; pp < 64; ++pp) {
                    float acc = 0.f;
#pragma unroll
                    for (int i4 = 0; i4 < 16; ++i4) { const f32x4 hv = *(const LAS f32x4*)(H3 + pp * 64 + 4 * i4);
                        acc += hv[0] * wc[4 * i4] + hv[1] * wc[4 * i4 + 1] + hv[2] * wc[4 * i4 + 2] + hv[3] * wc[4 * i4 + 3]; }
                    const int pos = p0 + pp; const float t = (float)pos / (float)(L - 1);
                    const bf16_t v = (bf16_t)f2bf(acc * expf(-t * adelta));
                    if (dir == 0) dst[center - pos] = v; else if (pos > 0) dst[center + pos] = v;
                }
            }
        }
        __syncthreads();
    }
    for (int t = gw; t < SEQ; t += NGW) {
        const float inv = exp2f(-(float)lane * (13.287712379549449f / 64.0f));
        const float ar = (float)(t >> 6) * inv, ac = (float)(t & 63) * inv;
        float* rp = (float*)(ws + WS_ROPE) + (size_t)t * 256;
        rp[lane] = cosf(ar); rp[64 + lane] = sinf(ar); rp[128 + lane] = cosf(ac); rp[192 + lane] = sinf(ac);
    }
    {
        bf16_t* wpt = (bf16_t*)(ws + WS_WPT);
        for (int e = F.blk * 512 + F.tid; e < DEPTH * 512 * 512; e += F.G * 512) {
            const int l = e >> 18, n = (e >> 9) & 511, k = e & 511; float v = 0.f;
            if ((n >> 7) == (k >> 7)) v = a->in[I_POOLW][(((size_t)l * 4 + (n >> 7)) * 128 + (k & 127)) * 128 + (n & 127)] * a->in[I_POOLS][l * 512 + n];
            wpt[e] = (bf16_t)f2bf(v);
        }
    }
    {
        f32x4* X = (f32x4*)(ws + WS_X);
        const size_t nc = (size_t)MC * D / 4, nx = (size_t)ML * D / 4;
        for (size_t e = (size_t)F.blk * 512 + F.tid; e < nc + nx; e += (size_t)F.G * 512)
            X[e] = e < nc ? ((const f32x4*)a->in[I_CTX])[e] : ((const f32x4*)a->in[I_X])[e - nc];
    }
}
__device__ __forceinline__ void pro_b(Frame& F, CArgs a) {
    const float* modp = (const float*)(F.ws + WS_MODP); float* mod = (float*)(F.ws + WS_MOD);
    for (int e = F.blk * 512 + F.tid; e < DEPTH * 5 * 12288; e += F.G * 512) {
        const int j = e % 12288, l = e / (5 * 12288);
        float s = a->in[I_BADA][l * 12288 + j];
#pragma unroll
        for (int ks = 0; ks < 16; ++ks) s += modp[(size_t)ks * DEPTH * 5 * 12288 + e];
        mod[e] = s;
    }
}
__device__ __forceinline__ void pro_c(Frame& F) {
    const int gw = F.blk * 8 + F.wave, NGW = F.G * 8, lane = F.lane;
    const float* mod = (const float*)(F.ws + WS_MOD);
    for (int row = gw; row < M; row += NGW) {
        const int bmod = row < MC ? 4 : ((row - MC) >> 11);
        const float* sh = mod + (size_t)bmod * 12288; const float* sc = sh + D;
        const f32x4* xr = (const f32x4*)((const float*)(F.ws + WS_X) + (size_t)row * D);
        u32x2* o = (u32x2*)((bf16_t*)(F.ws + WS_XM) + (size_t)row * D);
#pragma unroll
        for (int j = 0; j < 8; ++j) { const int i4 = lane + 64 * j; const f32x4 v = xr[i4], s4 = ((const f32x4*)sc)[i4], h4 = ((const f32x4*)sh)[i4];
            const f32x4 r = v * (s4 + 1.0f) + h4; u32x2 w; w.x = pk2(r[0], r[1]); w.y = pk2(r[2], r[3]); o[i4] = w; }
    }
}

__device__ __forceinline__ void prep_phase(Frame& F, CArgs a, int l) {
    unsigned char* ws = F.ws;
    const bf16_t* Z = (const bf16_t*)(ws + WS_Z);
    {
        bf16_t* P = (bf16_t*)(ws + WS_POOL);
        for (int e = F.blk * 512 + F.tid; e < M * 64; e += F.G * 512) {
            const int row = e >> 6, cg = e & 63, g = cg >> 4, w = 2 << g;
            int t, L; if (row < MC) { t = row & 255; L = CTXL; } else { t = (row - MC) & 2047; L = SEQ; }
            const int lo = max(t - (w >> 1), 0), hi = min(t + w - (w >> 1), L);
            float s[8] = {0.f, 0.f, 0.f, 0.f, 0.f, 0.f, 0.f, 0.f};
            for (int tt = lo; tt < hi; ++tt) { const u32x4 v = *(const u32x4*)(Z + (size_t)(row - t + tt) * DIN + cg * 8);
                s[0] += bflo(v.x); s[1] += bfhi(v.x); s[2] += bflo(v.y); s[3] += bfhi(v.y); s[4] += bflo(v.z); s[5] += bfhi(v.z); s[6] += bflo(v.w); s[7] += bfhi(v.w); }
            const u32x4 sv = *(const u32x4*)(Z + (size_t)row * DIN + cg * 8);
            const float inv = 1.0f / (float)(hi - lo);
            u32x4 o; o.x = pk2(s[0] * inv - bflo(sv.x), s[1] * inv - bfhi(sv.x)); o.y = pk2(s[2] * inv - bflo(sv.y), s[3] * inv - bfhi(sv.y));
            o.z = pk2(s[4] * inv - bflo(sv.z), s[5] * inv - bfhi(sv.z)); o.w = pk2(s[6] * inv - bflo(sv.w), s[7] * inv - bfhi(sv.w));
            *(u32x4*)(P + (size_t)row * 512 + cg * 8) = o;
        }
    }
    {
        const float* cw = a->in[I_CONVW] + (size_t)l * 3 * 1536; const float* cb = a->in[I_CONVB] + (size_t)l * 1536;
        LAS bf16_t* LU = (LAS bf16_t*)F.lds; LAS bf16_t* LX = LU + 128 * 72;
        for (int it = F.blk; it < 144 * 4; it += F.G) {
            const int tile = it >> 2, c0 = (it & 3) * 128, row0 = tile * 64;
            int t0, L; bf16_t *ud, *xd;
            if (row0 < MC) { const int sq = row0 >> 8; t0 = row0 & 255; L = CTXL; ud = (bf16_t*)(ws + WS_UTBC) + (size_t)sq * 512 * CTXL; xd = (bf16_t*)(ws + WS_X0TC) + (size_t)sq * 512 * CTXL; }
            else { const int r = row0 - MC, sq = r >> 11; t0 = r & 2047; L = SEQ; ud = (bf16_t*)(ws + WS_UTBL) + (size_t)sq * 512 * SEQ; xd = (bf16_t*)(ws + WS_X0TL) + (size_t)sq * 512 * SEQ; }
            __syncthreads();
#pragma unroll 1
            for (int k = 0; k < 4; ++k) {
                const int tl = (F.tid >> 5) + 16 * k, c4 = (F.tid & 31) * 4, row = row0 + tl, t = t0 + tl;
                f32x4 r3[3];
#pragma unroll
                for (int sgm = 0; sgm < 3; ++sgm) {
                    const int ch = sgm * 512 + c0 + c4; f32x4 acc = *(const f32x4*)(cb + ch);
#pragma unroll
                    for (int d = 0; d < 3; ++d) { const int tt = t + d - 1;
                        if (tt >= 0 && tt < L) { const u32x2 zv = *(const u32x2*)(Z + (size_t)(row + d - 1) * DIN + O_HY + ch); const f32x4 wv = *(const f32x4*)(cw + d * 1536 + ch);
                            acc[0] += wv[0] * bflo(zv.x); acc[1] += wv[1] * bfhi(zv.x); acc[2] += wv[2] * bflo(zv.y); acc[3] += wv[3] * bfhi(zv.y); } }
                    r3[sgm] = acc; }
                const f32x4 uu = r3[0] * r3[2];
#pragma unroll
                for (int e = 0; e < 4; ++e) { LU[(c4 + e) * 72 + tl] = (bf16_t)f2bf(uu[e]); LX[(c4 + e) * 72 + tl] = (bf16_t)f2bf(r3[1][e]); }
            }
            __syncthreads();
            {
                const int c = F.tid >> 2, seg = F.tid & 3;
                const u32x4 u0 = *(const LAS u32x4*)(LU + c * 72 + 16 * seg), u1 = *(const LAS u32x4*)(LU + c * 72 + 16 * seg + 8);
                const u32x4 x0 = *(const LAS u32x4*)(LX + c * 72 + 16 * seg), x1 = *(const LAS u32x4*)(LX + c * 72 + 16 * seg + 8);
                bf16_t* up = ud + (size_t)(c0 + c) * L + t0 + 16 * seg; bf16_t* xp = xd + (size_t)(c0 + c) * L + t0 + 16 * seg;
                *(u32x4*)up = u0; *(u32x4*)(up + 8) = u1; *(u32x4*)xp = x0; *(u32x4*)(xp + 8) = x1;
            }
        }
        __syncthreads();
    }
    {
        bf16_t* Zw = (bf16_t*)(ws + WS_Z); bf16_t* AB = (bf16_t*)(ws + WS_ABUF); bf16_t* BB = (bf16_t*)(ws + WS_BBUF); bf16_t* KT = (bf16_t*)(ws + WS_KT);
        const float* rope = (const float*)(ws + WS_ROPE);
        LAS float* LK = (LAS float*)F.lds;
        for (int it = F.blk; it < NU * 4; it += F.G) {
            const int u = it >> 2, pg = it & 3, bh = u / 9, ci = u % 9, b = bh >> 2, h = bh & 3;
            const int row0 = chunk_row0(b, ci); const bool isctx = ci == 0;
            const float lf = ret_lg2(a->in[I_RDEC], l, h), lb = ret_lg2(a->in[I_RDEC], l, 4 + h);
            const int dbase = (pg & 1) * 32 + (pg >> 1) * 128, rbase = (pg >> 1) * 128;
            const int tok = F.tid >> 1, sub = F.tid & 1, dl0 = sub * 16, d1 = dbase + dl0, d2 = d1 + 64;
            const size_t zrow = (size_t)(row0 + tok) * DIN;
            float cs[16], sn[16];
            if (!isctx) { const float* rp = rope + (size_t)((ci - 1) * 256 + tok) * 256 + rbase + (d1 - rbase);
#pragma unroll
                for (int e = 0; e < 16; ++e) { cs[e] = rp[e]; sn[e] = rp[64 + e]; } }
            else {
#pragma unroll
                for (int e = 0; e < 16; ++e) { cs[e] = 1.f; sn[e] = 0.f; } }
            {
                bf16_t* qp = Zw + zrow + O_Q + h * 256;
                u32x4 a0 = *(const u32x4*)(qp + d1), a1 = *(const u32x4*)(qp + d1 + 8), b0 = *(const u32x4*)(qp + d2), b1 = *(const u32x4*)(qp + d2 + 8);
                const unsigned aw[8] = {a0.x, a0.y, a0.z, a0.w, a1.x, a1.y, a1.z, a1.w}, bw[8] = {b0.x, b0.y, b0.z, b0.w, b1.x, b1.y, b1.z, b1.w};
                float o1[16], o2[16];
#pragma unroll
                for (int e = 0; e < 16; ++e) { const float x1 = (e & 1) ? bfhi(aw[e >> 1]) : bflo(aw[e >> 1]), x2 = (e & 1) ? bfhi(bw[e >> 1]) : bflo(bw[e >> 1]);
                    o1[e] = x1 * cs[e] - x2 * sn[e]; o2[e] = x2 * cs[e] + x1 * sn[e]; }
                const float df = exp2f((float)(tok + 1) * lf), db = exp2f((float)(256 - tok) * lb);
                unsigned w1[8], w2[8], f1[8], f2[8], g1[8], g2[8];
#pragma unroll
                for (int e = 0; e < 8; ++e) { w1[e] = pk2(o1[2 * e], o1[2 * e + 1]); w2[e] = pk2(o2[2 * e], o2[2 * e + 1]);
                    f1[e] = pk2(o1[2 * e] * df, o1[2 * e + 1] * df); f2[e] = pk2(o2[2 * e] * df, o2[2 * e + 1] * df);
                    g1[e] = pk2(o1[2 * e] * db, o1[2 * e + 1] * db); g2[e] = pk2(o2[2 * e] * db, o2[2 * e + 1] * db); }
                *(u32x4*)(qp + d1) = (u32x4){w1[0], w1[1], w1[2], w1[3]}; *(u32x4*)(qp + d1 + 8) = (u32x4){w1[4], w1[5], w1[6], w1[7]};
                *(u32x4*)(qp + d2) = (u32x4){w2[0], w2[1], w2[2], w2[3]}; *(u32x4*)(qp + d2 + 8) = (u32x4){w2[4], w2[5], w2[6], w2[7]};
                bf16_t* ap = AB + ((size_t)u * 256 + tok) * 768;
                *(u32x4*)(ap + 256 + d1) = (u32x4){f1[0], f1[1], f1[2], f1[3]}; *(u32x4*)(ap + 256 + d1 + 8) = (u32x4){f1[4], f1[5], f1[6], f1[7]};
                *(u32x4*)(ap + 256 + d2) = (u32x4){f2[0], f2[1], f2[2], f2[3]}; *(u32x4*)(ap + 256 + d2 + 8) = (u32x4){f2[4], f2[5], f2[6], f2[7]};
                *(u32x4*)(ap + 512 + d1) = (u32x4){g1[0], g1[1], g1[2], g1[3]}; *(u32x4*)(ap + 512 + d1 + 8) = (u32x4){g1[4], g1[5], g1[6], g1[7]};
                *(u32x4*)(ap + 512 + d2) = (u32x4){g2[0], g2[1], g2[2], g2[3]}; *(u32x4*)(ap + 512 + d2 + 8) = (u32x4){g2[4], g2[5], g2[6], g2[7]};
            }
            {
                bf16_t* kp = Zw + zrow + O_K + h * 256;
                u32x4 a0 = *(const u32x4*)(kp + d1), a1 = *(const u32x4*)(kp + d1 + 8), b0 = *(const u32x4*)(kp + d2), b1 = *(const u32x4*)(kp + d2 + 8);
                const unsigned aw[8] = {a0.x, a0.y, a0.z, a0.w, a1.x, a1.y, a1.z, a1.w}, bw[8] = {b0.x, b0.y, b0.z, b0.w, b1.x, b1.y, b1.z, b1.w};
                float o1[16], o2[16];
#pragma unroll
                for (int e = 0; e < 16; ++e) { const float x1 = (e & 1) ? bfhi(aw[e >> 1]) : bflo(aw[e >> 1]), x2 = (e & 1) ? bfhi(bw[e >> 1]) : bflo(bw[e >> 1]);
                    o1[e] = (x1 * cs[e] - x2 * sn[e]) * 0.0625f; o2[e] = (x2 * cs[e] + x1 * sn[e]) * 0.0625f; }
                unsigned w1[8], w2[8];
#pragma unroll
                for (int e = 0; e < 8; ++e) { w1[e] = pk2(o1[2 * e], o1[2 * e + 1]); w2[e] = pk2(o2[2 * e], o2[2 * e + 1]); }
                *(u32x4*)(kp + d1) = (u32x4){w1[0], w1[1], w1[2], w1[3]}; *(u32x4*)(kp + d1 + 8) = (u32x4){w1[4], w1[5], w1[6], w1[7]};
                *(u32x4*)(kp + d2) = (u32x4){w2[0], w2[1], w2[2], w2[3]}; *(u32x4*)(kp + d2 + 8) = (u32x4){w2[4], w2[5], w2[6], w2[7]};
#pragma unroll
                for (int e = 0; e < 16; ++e) { LK[(dl0 + e) * 257 + tok] = o1[e]; LK[(32 + dl0 + e) * 257 + tok] = o2[e]; }
            }
            __syncthreads();
            {
                const int dl = F.tid & 63, seg = F.tid >> 6, dg = dl < 32 ? dbase + dl : dbase + 64 + (dl - 32);
                bf16_t* kf = KT + ((size_t)u * 512 + dg) * 256 + seg * 32; bf16_t* kb = KT + ((size_t)u * 512 + 256 + dg) * 256 + seg * 32;
                unsigned wf[16], wb[16];
#pragma unroll
                for (int j = 0; j < 16; ++j) { const int t0 = seg * 32 + 2 * j; const float v0 = LK[dl * 257 + t0], v1 = LK[dl * 257 + t0 + 1];
                    wf[j] = pk2(v0 * exp2f((float)(255 - t0) * lf), v1 * exp2f((float)(254 - t0) * lf));
                    wb[j] = pk2(v0 * exp2f((float)t0 * lb), v1 * exp2f((float)(t0 + 1) * lb)); }
#pragma unroll
                for (int j = 0; j < 4; ++j) { *(u32x4*)(kf + 8 * j) = (u32x4){wf[4 * j], wf[4 * j + 1], wf[4 * j + 2], wf[4 * j + 3]}; *(u32x4*)(kb + 8 * j) = (u32x4){wb[4 * j], wb[4 * j + 1], wb[4 * j + 2], wb[4 * j + 3]}; }
            }
            __syncthreads();
            {
                const bf16_t* vp = Z + zrow + O_V + h * 256;
                u32x4 a0 = *(const u32x4*)(vp + d1), a1 = *(const u32x4*)(vp + d1 + 8), b0 = *(const u32x4*)(vp + d2), b1 = *(const u32x4*)(vp + d2 + 8);
                const unsigned aw[8] = {a0.x, a0.y, a0.z, a0.w, a1.x, a1.y, a1.z, a1.w}, bw[8] = {b0.x, b0.y, b0.z, b0.w, b1.x, b1.y, b1.z, b1.w};
#pragma unroll
                for (int e = 0; e < 16; ++e) { LK[(dl0 + e) * 257 + tok] = (e & 1) ? bfhi(aw[e >> 1]) : bflo(aw[e >> 1]); LK[(32 + dl0 + e) * 257 + tok] = (e & 1) ? bfhi(bw[e >> 1]) : bflo(bw[e >> 1]); }
            }
            __syncthreads();
            {
                const int dl = F.tid & 63, seg = F.tid >> 6, dg = dl < 32 ? dbase + dl : dbase + 64 + (dl - 32);
                bf16_t* vt = BB + ((size_t)u * 256 + dg) * 768 + seg * 32;
                unsigned wv[16];
#pragma unroll
                for (int j = 0; j < 16; ++j) { const int t0 = seg * 32 + 2 * j; wv[j] = pk2(LK[dl * 257 + t0], LK[dl * 257 + t0 + 1]); }
#pragma unroll
                for (int j = 0; j < 4; ++j) *(u32x4*)(vt + 8 * j) = (u32x4){wv[4 * j], wv[4 * j + 1], wv[4 * j + 2], wv[4 * j + 3]};
            }
            __syncthreads();
        }
    }
}

__device__ __forceinline__ void scan_phase(Frame& F, CArgs a, int l) {
    const float* UT = (const float*)(F.ws + WS_UT); bf16_t* BB = (bf16_t*)(F.ws + WS_BBUF);
    for (int e = F.blk * 512 + F.tid; e < 16 * 2 * 16384; e += F.G * 512) {
        const int q = e & 16383, dir = (e >> 14) & 1, bh = e >> 15, dv = q >> 6, dk4 = (q & 63) * 4, h = bh & 3;
        const float cdec = exp2f(256.0f * ret_lg2(a->in[I_RDEC], l, dir * 4 + h));
        f32x4 S = (f32x4){0.f, 0.f, 0.f, 0.f};
#pragma unroll 1
        for (int s = 0; s < 9; ++s) {
            const int ci = dir == 0 ? s : (s == 0 ? 0 : 9 - s);
            const int u = bh * 9 + ci;
            u32x2 w; w.x = pk2(S[0], S[1]); w.y = pk2(S[2], S[3]);
            *(u32x2*)(BB + ((size_t)u * 256 + dv) * 768 + 256 + dir * 256 + dk4) = w;
            const f32x4 uv = *(const f32x4*)(UT + ((size_t)u * 256 + dv) * 512 + dir * 256 + dk4);
            S = S * cdec + uv;
        }
    }
}

typedef float f32x16 __attribute__((ext_vector_type(16)));
template <bool CTX>
__device__ __forceinline__ void conv_mfma(Frame& F, CArgs a, int l) {
    constexpr int NA = CTX ? 8 : 64, L = NA * 32, FLEN = 2 * L, CST = FLEN + 8, PB = CTX ? 7 : 31, UB = (2 * PB + NA) * 40, NCB = CTX ? 1 : 8, RST = NCB * 32 + 1;
    constexpr int F8_BYTES = 8 * CST * 2, U_OFF = (F8_BYTES + 255) & ~255, U_BYTES = 4 * UB * 2;
    static_assert(U_OFF + U_BYTES <= RING_BYTES && 32 * RST * 4 <= F8_BYTES, "conv LDS map");
    LAS unsigned char* lds = F.lds;
    const int tid = F.tid, lane = F.lane, wave = F.wave, r = lane & 31, h = lane >> 5;
    const bf16_t* KR = CTX ? (const bf16_t*)(F.ws + WS_KRC) + (size_t)l * 512 * FLEN : (const bf16_t*)(F.ws + WS_KRG) + (size_t)l * 512 * FLEN;
    const bf16_t* UT = (const bf16_t*)(F.ws + (CTX ? WS_UTBC : WS_UTBL)); const bf16_t* XT = (const bf16_t*)(F.ws + (CTX ? WS_X0TC : WS_X0TL));
    bf16_t* Y = (bf16_t*)(F.ws + WS_Y);
    __syncthreads();
    for (int e = tid; e < U_BYTES / 16; e += 512) *(LAS u32x4*)(lds + U_OFF + e * 16) = (u32x4){0u, 0u, 0u, 0u};
    const int sA = (-r) & 7;
    const int abase = (sA * CST + L - r + 8 * h - sA) * 2;
    const int bl = CTX ? (r >> 3) : 0, al = CTX ? (r & 7) : r;
    const int bbase = U_OFF + (bl * UB + (PB + al) * 40 + 8 * h) * 2;
    for (int ch = F.blk; ch < 512; ch += F.G) {
        __syncthreads();
        for (int x8 = tid; x8 < FLEN / 8; x8 += 512) {
            const bf16_t* kp = KR + (size_t)ch * FLEN + x8 * 8;
            const u32x4 lo = *(const u32x4*)kp; u32x4 hi = (u32x4){0u, 0u, 0u, 0u}; if (x8 + 1 < FLEN / 8) hi = *(const u32x4*)(kp + 8);
            unsigned w[8] = {lo.x, lo.y, lo.z, lo.w, hi.x, hi.y, hi.z, hi.w};
            if (x8 == 0) w[0] &= 0xffff0000u;
#pragma unroll
            for (int sft = 0; sft < 8; ++sft) { u32x4 o;
                if ((sft & 1) == 0) { o.x = w[sft / 2]; o.y = w[sft / 2 + 1]; o.z = w[sft / 2 + 2]; o.w = w[sft / 2 + 3]; }
                else { const int q = sft / 2; o.x = (w[q] >> 16) | (w[q + 1] << 16); o.y = (w[q + 1] >> 16) | (w[q + 2] << 16); o.z = (w[q + 2] >> 16) | (w[q + 3] << 16); o.w = (w[q + 3] >> 16) | (w[q + 4] << 16); }
                *(LAS u32x4*)(lds + (sft * CST + x8 * 8) * 2) = o; }
        }
        if (tid < 8) *(LAS u32x4*)(lds + (tid * CST + FLEN) * 2) = (u32x4){0u, 0u, 0u, 0u};
        for (int q = tid; q < 4 * L / 8; q += 512) { const int b = q / (L / 8), qq = q % (L / 8);
            const u32x4 v = *(const u32x4*)(UT + ((size_t)b * 512 + ch) * L + qq * 8);
            *(LAS u32x4*)(lds + U_OFF + (b * UB + (PB + (qq >> 2)) * 40 + (qq & 3) * 8) * 2) = v; }
        __syncthreads();
        f32x16 acc[NCB];
#pragma unroll
        for (int cb = 0; cb < NCB; ++cb)
#pragma unroll
            for (int e = 0; e < 16; ++e) acc[cb][e] = 0.f;
#pragma unroll 1
        for (int q = wave; q < 2 * (2 * NA - 1); q += 8) {
            const int delta = (q >> 1) - (NA - 1), j0 = (q & 1) * 16;
            const bf16x8 af = *(const LAS bf16x8*)(lds + abase + (j0 - 32 * delta) * 2);
            const LAS unsigned char* bp = lds + bbase + (j0 - 40 * delta) * 2;
            if constexpr (CTX) {
                const bf16x8 bf = *(const LAS bf16x8*)bp;
                acc[0] = __builtin_amdgcn_mfma_f32_32x32x16_bf16(af, bf, acc[0], 0, 0, 0);
            } else {
                if (delta <= 31) {
#pragma unroll
                    for (int b = 0; b < 4; ++b) { const bf16x8 bf = *(const LAS bf16x8*)(bp + b * UB * 2);
                        acc[2 * b] = __builtin_amdgcn_mfma_f32_32x32x16_bf16(af, bf, acc[2 * b], 0, 0, 0); } }
                if (delta >= -31) {
#pragma unroll
                    for (int b = 0; b < 4; ++b) { const bf16x8 bf = *(const LAS bf16x8*)(bp + b * UB * 2 + 32 * 40 * 2);
                        acc[2 * b + 1] = __builtin_amdgcn_mfma_f32_32x32x16_bf16(af, bf, acc[2 * b + 1], 0, 0, 0); } }
            }
        }
        __syncthreads();
        LAS float* R = (LAS float*)lds;
        for (int e = tid; e < 32 * RST; e += 512) R[e] = 0.f;
        __syncthreads();
#pragma unroll
        for (int cb = 0; cb < NCB; ++cb)
#pragma unroll
            for (int e = 0; e < 16; ++e) { const int row = (e & 3) + 8 * (e >> 2) + 4 * h;
                __hip_atomic_fetch_add(R + row * RST + cb * 32 + r, acc[cb][e], __ATOMIC_RELAXED, __HIP_MEMORY_SCOPE_WORKGROUP); }
        __syncthreads();
        const float hd = a->in[I_HYD][l * 512 + ch];
#pragma unroll 4
        for (int idx = tid; idx < 4 * L; idx += 512) {
            const int b = idx / L, t = idx % L;
            const float cv = R[(t & 31) * RST + (CTX ? b * 8 + (t >> 5) : b * 64 + (t >> 5))];
            const float uu = bf1(UT[((size_t)b * 512 + ch) * L + t]), x0 = bf1(XT[((size_t)b * 512 + ch) * L + t]);
            const size_t row = CTX ? (size_t)(b * CTXL + t) : (size_t)(MC + b * SEQ + t);
            Y[row * D + 512 + ch] = (bf16_t)f2bf((cv + uu * hd) * x0);
        }
    }
    __syncthreads();
}
__device__ __forceinline__ void conv_phase(Frame& F, CArgs a, int l) {
    conv_mfma<false>(F, a, l);
    if (l < DEPTH - 1) conv_mfma<true>(F, a, l);
}

__device__ __forceinline__ void gn_phase(Frame& F) {
    const int gw = F.blk * 8 + F.wave, NGW = F.G * 8, lane = F.lane;
    const float* OB = (const float*)(F.ws + WS_OBUF); const bf16_t* Z = (const bf16_t*)(F.ws + WS_Z); bf16_t* Y = (bf16_t*)(F.ws + WS_Y);
    for (int it = gw; it < NU * 256; it += NGW) {
        const int u = it >> 8, tok = it & 255, bh = u / 9, ci = u % 9, b = bh >> 2, h = bh & 3;
        const size_t row = (size_t)(chunk_row0(b, ci) + tok);
        const f32x4 v = *(const f32x4*)(OB + (size_t)it * 256 + lane * 4);
        const float mean = wave_sum((v[0] + v[1]) + (v[2] + v[3])) * (1.0f / 256.0f);
        const f32x4 dv = v - mean;
        const float var = wave_sum((dv[0] * dv[0] + dv[1] * dv[1]) + (dv[2] * dv[2] + dv[3] * dv[3])) * (1.0f / 256.0f);
        const float rstd = 1.0f / sqrtf(var + GN_EPS);
        const u32x2 gz = *(const u32x2*)(Z + row * DIN + O_G + h * 256 + lane * 4);
        const float g0 = silu_f(bflo(gz.x)), g1 = silu_f(bfhi(gz.x)), g2 = silu_f(bflo(gz.y)), g3 = silu_f(bfhi(gz.y));
        u32x2 w; w.x = pk2(dv[0] * rstd * g0, dv[1] * rstd * g1); w.y = pk2(dv[2] * rstd * g2, dv[3] * rstd * g3);
        *(u32x2*)(Y + row * D + 1024 + h * 256 + lane * 4) = w;
    }
}

__device__ __forceinline__ void ln_phase(Frame& F, CArgs a, int l, int which) {
    const int gw = F.blk * 8 + F.wave, NGW = F.G * 8, lane = F.lane;
    const float* S = (const float*)(F.ws + WS_S); float* X = (float*)(F.ws + WS_X); bf16_t* XM = (bf16_t*)(F.ws + WS_XM);
    const float* g = (which == 0 ? a->in[I_LN1G] : a->in[I_LN2G]) + (size_t)l * D; const float* bb = (which == 0 ? a->in[I_LN1B] : a->in[I_LN2B]) + (size_t)l * D;
    const bool last = (which == 1 && l == DEPTH - 1);
    const float* mod = (const float*)(F.ws + WS_MOD) + (size_t)(which == 0 ? l : (last ? l : l + 1)) * 5 * 12288 + (which == 0 ? 3 * D : 0);
    for (int row = gw; row < M; row += NGW) {
        if (last && row < MC) continue;
        const int bmod = row < MC ? 4 : ((row - MC) >> 11);
        const f32x4* sr = (const f32x4*)(S + (size_t)row * D);
        f32x4 v[8]; float s = 0.f;
#pragma unroll
        for (int j = 0; j < 8; ++j) { v[j] = sr[lane + 64 * j]; s += (v[j][0] + v[j][1]) + (v[j][2] + v[j][3]); }
        const float mean = wave_sum(s) * (1.0f / D); float q = 0.f;
#pragma unroll
        for (int j = 0; j < 8; ++j) { v[j] = v[j] - mean; q += (v[j][0] * v[j][0] + v[j][1] * v[j][1]) + (v[j][2] * v[j][2] + v[j][3] * v[j][3]); }
        const float rstd = 1.0f / sqrtf(wave_sum(q) * (1.0f / D) + LN_EPS);
        const float* sh = mod + (size_t)bmod * 12288; const float* sc = sh + D;
        f32x4* xo = last ? (f32x4*)(a->out + (size_t)(row - MC) * D) : (f32x4*)(X + (size_t)row * D);
        u32x2* xm = (u32x2*)(XM + (size_t)row * D);
#pragma unroll
        for (int j = 0; j < 8; ++j) { const int i4 = lane + 64 * j; const f32x4 y = v[j] * rstd * ((const f32x4*)g)[i4] + ((const f32x4*)bb)[i4];
            xo[i4] = y;
            if (!last) { const f32x4 r = y * (((const f32x4*)sc)[i4] + 1.0f) + ((const f32x4*)sh)[i4]; u32x2 w; w.x = pk2(r[0], r[1]); w.y = pk2(r[2], r[3]); xm[i4] = w; } }
    }
}

struct ScoresOrder {
    const char* Z; int G, c;
    __device__ __forceinline__ bool next(int i, pg8::Unit& u) const { const int L = i * G + c; if (L >= NU) return false; u.z = L; u.pm = 0; u.pn = 0; return true; }
    __device__ __forceinline__ size_t rowoff(const pg8::Unit& u) const { const int bh = u.z / 9, ci = u.z % 9; return (size_t)chunk_row0(bh >> 2, ci) * DIN + (bh & 3) * 256; }
    __device__ __forceinline__ const char* aptr(const pg8::Unit& u) const { return Z + (rowoff(u) + O_Q) * 2; }
    __device__ __forceinline__ const char* bptr(const pg8::Unit& u) const { return Z + (rowoff(u) + O_K) * 2; }
};
struct UtOrder {
    const char* BB; const char* KT; int G, c;
    __device__ __forceinline__ bool next(int i, pg8::Unit& u) const { const int L = i * G + c; if (L >= NU * 2) return false; u.z = L >> 1; u.pm = 0; u.pn = L & 1; return true; }
    __device__ __forceinline__ const char* aptr(const pg8::Unit& u) const { return BB + (size_t)u.z * 256 * 768 * 2; }
    __device__ __forceinline__ const char* bptr(const pg8::Unit& u) const { return KT + ((size_t)u.z * 512 + u.pn * 256) * 256 * 2; }
};
struct OutOrder {
    const char* AB; const char* BB; int G, c;
    __device__ __forceinline__ bool next(int i, pg8::Unit& u) const { const int L = i * G + c; if (L >= NU) return false; u.z = L; u.pm = 0; u.pn = 0; return true; }
    __device__ __forceinline__ const char* aptr(const pg8::Unit& u) const { return AB + (size_t)u.z * 256 * 768 * 2; }
    __device__ __forceinline__ const char* bptr(const pg8::Unit& u) const { return BB + (size_t)u.z * 256 * 768 * 2; }
};

constexpr int PH_PER_LAYER = 12, N_PHASES = 3 + DEPTH * PH_PER_LAYER;

__global__ void __launch_bounds__(512, 2) mk_fwd(Args args_unused) {
    extern __shared__ __attribute__((aligned(16))) unsigned char lds_raw[];
    (void)args_unused;
    CArgs ap = (CArgs)__builtin_amdgcn_kernarg_segment_ptr();
    Frame F;
    F.lds = (LAS unsigned char*)lds_raw;
    F.tid = threadIdx.x; F.lane = F.tid & 63; F.wave = __builtin_amdgcn_readfirstlane(F.tid >> 6);
    F.blk = blockIdx.x; F.G = gridDim.x; F.ws = ap->ws;
    volatile LAS unsigned* MISC = (volatile LAS unsigned*)(F.lds + MISC_OFF);
    if (F.tid < 64) MISC[F.tid] = 0u;
    __syncthreads();
#if MK_PER_PHASE
#define GRID_BAR() do { } while (0)
#else
    XcdBarrier bar = xcd_barrier_post((unsigned*)(ap->ws + WS_CTL) + 4096, MISC + 8);
#define GRID_BAR() xcd_barrier(bar)
#endif
    const int lo = ap->ph_lo, hi = ap->ph_hi;
#ifndef DUPMASK
#define DUPMASK 0u
#endif
#define REP(k) _Pragma("unroll 1") for (int _r = 0; _r < (((DUPMASK >> (k)) & 1u) ? 2 : 1); ++_r)
#define IN(k) (lo <= (k) && (k) < hi)
#define SEAM(k) do { if (IN(k) && IN((k) + 1)) GRID_BAR(); } while (0)
#define LAUNDER() do { int _t = F.tid; asm volatile("" : "+v"(_t)); F.tid = _t; F.lane = _t & 63; F.wave = __builtin_amdgcn_readfirstlane(_t >> 6); \
        asm volatile("" : "+s"(ap)); unsigned char* _w = ap->ws; asm volatile("" : "+s"(_w)); F.ws = _w; ws = _w; } while (0)
    unsigned char* ws = F.ws;

    if (IN(0)) REP(12) { LAUNDER(); pro_a(F, ap); } SEAM(0);
    if (IN(1)) REP(13) { LAUNDER(); pro_b(F, ap); } SEAM(1);
    if (IN(2)) REP(14) { LAUNDER(); pro_c(F); } SEAM(2);

#pragma unroll 1
    for (int l = 0; l < DEPTH; ++l) {
        const int p0 = 3 + l * PH_PER_LAYER;
        if (IN(p0 + 0)) REP(0) {
            LAUNDER();
            pg8::BigOrder S; S.init(ws + WS_XM, (const bf16_t*)(ws + WS_WIN) + (size_t)l * DIN * D, D, D, M, DIN, F.G, F.blk);
            pg8::EpiBf16<0> E{(bf16_t*)(ws + WS_Z), DIN, ap->in[I_BIN] + (size_t)l * DIN};
            pg8::gemm_phase<pg8::EpiBf16<0>, pg8::BigOrder, true, true>(F.lds, F.tid, pg8::Gemm{D, D, D}, S, E);
        }
        SEAM(p0 + 0);
        if (IN(p0 + 1)) { LAUNDER(); prep_phase(F, ap, l); }
        SEAM(p0 + 1);
        if (IN(p0 + 2)) REP(2) {
            {
                LAUNDER();
                pg8::BigOrder S; S.init(ws + WS_POOL, (const bf16_t*)(ws + WS_WPT) + (size_t)l * 512 * 512, 512, 512, M, 512, F.G, F.blk);
                pg8::EpiBf16<0> E{(bf16_t*)(ws + WS_Y), D, nullptr};
                pg8::gemm_phase<pg8::EpiBf16<0>, pg8::BigOrder, true, true>(F.lds, F.tid, pg8::Gemm{512, 512, 512}, S, E);
            }
            {
                LAUNDER();
                ScoresOrder S{(const char*)(ws + WS_Z), F.G, (F.blk + 72) % F.G};
                pg8::EpiScores E{(bf16_t*)(ws + WS_ABUF), ap->in[I_RDEC] + l * 8};
                pg8::gemm_phase<pg8::EpiScores, ScoresOrder, true, true>(F.lds, F.tid, pg8::Gemm{DIN, DIN, 256}, S, E);
            }
            {
                LAUNDER();
                UtOrder S{(const char*)(ws + WS_BBUF), (const char*)(ws + WS_KT), F.G, (F.blk + 216) % F.G};
                pg8::EpiF32 E{(float*)(ws + WS_UT), 512, (size_t)256 * 512};
                pg8::gemm_phase<pg8::EpiF32, UtOrder, true, true>(F.lds, F.tid, pg8::Gemm{768, 256, 256}, S, E);
            }
        }
        SEAM(p0 + 2);
        if (IN(p0 + 3)) { REP(3) { LAUNDER(); scan_phase(F, ap, l); } REP(15) { LAUNDER(); conv_phase(F, ap, l); } }
        SEAM(p0 + 3);
        if (IN(p0 + 4)) REP(4) {
            LAUNDER();
            OutOrder S{(const char*)(ws + WS_ABUF), (const char*)(ws + WS_BBUF), F.G, F.blk};
            pg8::EpiF32 E{(float*)(ws + WS_OBUF), 256, (size_t)256 * 256};
            pg8::gemm_phase<pg8::EpiF32, OutOrder, true, true>(F.lds, F.tid, pg8::Gemm{768, 768, 768}, S, E);
        }
        SEAM(p0 + 4);
        if (IN(p0 + 5)) REP(5) { LAUNDER(); gn_phase(F); }
        SEAM(p0 + 5);
        if (IN(p0 + 6)) REP(6) {
            { LAUNDER(); const bf16_t* PT = (const bf16_t*)(ws + WS_PT) + (size_t)l * D * D; const bf16_t* Y = (const bf16_t*)(ws + WS_Y);
              pg8::BigOrder S; S.init(Y, PT, D, D, M, D, F.G, F.blk); pg8::EpiGate<0> E{(const bf16_t*)(ws + WS_Z), (float*)(ws + WS_MGF), (bf16_t*)(ws + WS_MG)};
              pg8::gemm_phase<pg8::EpiGate<0>, pg8::BigOrder, true, true>(F.lds, F.tid, pg8::Gemm{D, D, 512}, S, E); }
            { LAUNDER(); const bf16_t* PT = (const bf16_t*)(ws + WS_PT) + (size_t)l * D * D; const bf16_t* Y = (const bf16_t*)(ws + WS_Y);
              pg8::BigOrder S; S.init(Y + 512, PT + 512, D, D, M, D, F.G, F.blk); pg8::EpiGate<1> E{(const bf16_t*)(ws + WS_Z), (float*)(ws + WS_MGF), (bf16_t*)(ws + WS_MG)};
              pg8::gemm_phase<pg8::EpiGate<1>, pg8::BigOrder, true, true>(F.lds, F.tid, pg8::Gemm{D, D, 512}, S, E); }
            { LAUNDER(); const bf16_t* PT = (const bf16_t*)(ws + WS_PT) + (size_t)l * D * D; const bf16_t* Y = (const bf16_t*)(ws + WS_Y);
              pg8::BigOrder S; S.init(Y + 1024, PT + 1024, D, D, M, D, F.G, F.blk); pg8::EpiGate<2> E{(const bf16_t*)(ws + WS_Z), (float*)(ws + WS_MGF), (bf16_t*)(ws + WS_MG)};
              pg8::gemm_phase<pg8::EpiGate<2>, pg8::BigOrder, true, true>(F.lds, F.tid, pg8::Gemm{D, D, 1024}, S, E); }
        }
        SEAM(p0 + 6);
        if (IN(p0 + 7)) REP(7) {
            LAUNDER();
            pg8::BigOrder S; S.init(ws + WS_MG, (const bf16_t*)(ws + WS_WO) + (size_t)l * D * D, D, D, M, D, F.G, F.blk);
            pg8::EpiResid E{(const float*)(ws + WS_X), (float*)(ws + WS_S), ap->in[I_BO] + (size_t)l * D, (const float*)(ws + WS_MOD) + (size_t)l * 5 * 12288 + 2 * D};
            pg8::gemm_phase<pg8::EpiResid, pg8::BigOrder, true, true>(F.lds, F.tid, pg8::Gemm{D, D, D}, S, E);
        }
        SEAM(p0 + 7);
        if (IN(p0 + 8)) REP(8) { LAUNDER(); ln_phase(F, ap, l, 0); }
        SEAM(p0 + 8);
        if (IN(p0 + 9)) REP(9) {
            LAUNDER();
            pg8::BigOrder S; S.init(ws + WS_XM, (const bf16_t*)(ws + WS_W1) + (size_t)l * DFF * D, D, D, M, DFF, F.G, F.blk);
            pg8::EpiBf16<1> E{(bf16_t*)(ws + WS_H), DFF, ap->in[I_B1] + (size_t)l * DFF};
            pg8::gemm_phase<pg8::EpiBf16<1>, pg8::BigOrder, true, true>(F.lds, F.tid, pg8::Gemm{D, D, D}, S, E);
        }
        SEAM(p0 + 9);
        if (IN(p0 + 10)) REP(10) {
            LAUNDER();
            pg8::BigOrder S; S.init(ws + WS_H, (const bf16_t*)(ws + WS_W2) + (size_t)l * D * DFF, DFF, DFF, M, D, F.G, F.blk);
            pg8::EpiResid E{(const float*)(ws + WS_X), (float*)(ws + WS_S), ap->in[I_B2] + (size_t)l * D, (const float*)(ws + WS_MOD) + (size_t)l * 5 * 12288 + 5 * D};
            pg8::gemm_phase<pg8::EpiResid, pg8::BigOrder, true, true>(F.lds, F.tid, pg8::Gemm{DFF, DFF, DFF}, S, E);
        }
        SEAM(p0 + 10);
        if (IN(p0 + 11)) REP(11) { LAUNDER(); ln_phase(F, ap, l, 1); }
        SEAM(p0 + 11);
    }
#undef IN
#undef SEAM
#undef LAUNDER
}

extern "C" void kernel_launch(void* const* d_in, const int* in_sizes, int n_in, void* d_out, int out_size, void* d_ws, size_t ws_size, hipStream_t stream) {
    static int grid = 0;
    if (grid == 0) {
        if (n_in != 37 || out_size != ML * D || ws_size < WS_END) { fprintf(stderr, "kernel_launch: unexpected shapes (n_in %d, out %d, ws %zu)\n", n_in, out_size, ws_size); grid = -1; return; }
        int dev = 0, cus = 0, per_cu = 0;
        if (hipGetDevice(&dev) != hipSuccess || hipDeviceGetAttribute(&cus, hipDeviceAttributeMultiprocessorCount, dev) != hipSuccess) { grid = -1; return; }
        if (hipFuncSetAttribute((const void*)mk_fwd, hipFuncAttributeMaxDynamicSharedMemorySize, LDS_BYTES) != hipSuccess) { fprintf(stderr, "kernel_launch: hipFuncSetAttribute failed\n"); grid = -1; return; }
        if (hipOccupancyMaxActiveBlocksPerMultiprocessor(&per_cu, (const void*)mk_fwd, 512, LDS_BYTES) != hipSuccess || per_cu < 1) { fprintf(stderr, "kernel_launch: occupancy query says %d\n", per_cu); }
        (void)hipGetLastError();
        grid = cus;
    }
    if (grid < 0) return;
    (void)hipMemsetAsync((char*)d_ws + WS_CTL, 0, 1 * MiB, stream);
    Args a{};
    for (int i = 0; i < 37; ++i) a.in[i] = (const float*)d_in[i];
    a.out = (float*)d_out; a.ws = (unsigned char*)d_ws;
#if MK_PER_PHASE
    for (int p = 0; p < N_PHASES; ++p) { a.ph_lo = p; a.ph_hi = p + 1; hipLaunchKernelGGL(mk_fwd, dim3(grid), dim3(512), LDS_BYTES, stream, a); }
#else
    a.ph_lo = 0; a.ph_hi = N_PHASES;
    hipLaunchKernelGGL(mk_fwd, dim3(grid), dim3(512), LDS_BYTES, stream, a);
#endif
}
```

```cpp
#include <hip/hip_runtime.h>
#include <cstdio>
#include <cstdint>

#ifndef MK_PER_PHASE
#define MK_PER_PHASE 0
#endif

#define LAS __attribute__((address_space(3)))
#define GAS __attribute__((address_space(1)))
typedef unsigned short bf16_t;
typedef short bf16x8 __attribute__((ext_vector_type(8)));
typedef float f32x4 __attribute__((ext_vector_type(4)));
typedef float f32x2 __attribute__((ext_vector_type(2)));
typedef unsigned u32x4 __attribute__((ext_vector_type(4)));
typedef unsigned u32x2 __attribute__((ext_vector_type(2)));

constexpr int D = 2048, NB = 4, SEQ = 2048, DEPTH = 4, CTXL = 256;
constexpr int MC = NB * CTXL, ML = NB * SEQ, M = MC + ML;
constexpr int DIN = 12288, DFF = 8192;
constexpr int O_HY = 512, O_Q = 2048, O_K = 3072, O_V = 4096, O_G = 5120, O_GATE = 6144;
constexpr int NU = 144;
constexpr float LN_EPS = 1e-5f, GN_EPS = 1e-6f;
constexpr float ALPHA = 1.6817928305074290f;

constexpr size_t MiB = 1u << 20;
constexpr size_t WS_CTL = 0;
constexpr size_t WS_MOD = 1 * MiB;
constexpr size_t WS_ROPE = 2 * MiB;
constexpr size_t WS_MODP = 4 * MiB;
constexpr size_t WS_KRG = 20 * MiB;
constexpr size_t WS_KRC = 36 * MiB;
constexpr size_t WS_WPT = 56 * MiB;
constexpr size_t WS_WIN = 58 * MiB;
constexpr size_t WS_PT = 250 * MiB;
constexpr size_t WS_WO = 282 * MiB;
constexpr size_t WS_W1 = 314 * MiB;
constexpr size_t WS_W2 = 442 * MiB;
constexpr size_t WS_X = 570 * MiB;
constexpr size_t WS_XM = 642 * MiB;
constexpr size_t WS_Z = 678 * MiB;
constexpr size_t WS_H = WS_Z;
constexpr size_t WS_Y = 894 * MiB;
constexpr size_t WS_UTBL = 930 * MiB;
constexpr size_t WS_UTBC = 938 * MiB;
constexpr size_t WS_X0TL = 939 * MiB;
constexpr size_t WS_X0TC = 947 * MiB;
constexpr size_t WS_YBTL = 948 * MiB;
constexpr size_t WS_YBTC = 956 * MiB;
constexpr size_t WS_POOL = 966 * MiB;
constexpr size_t WS_ABUF = 976 * MiB;
constexpr size_t WS_BBUF = 1030 * MiB;
constexpr size_t WS_KT = 1084 * MiB;
constexpr size_t WS_UT = 1120 * MiB;
constexpr size_t WS_PB = WS_UT;
constexpr size_t WS_OBUF = 1192 * MiB;
constexpr size_t WS_MGF = 1228 * MiB;
constexpr size_t WS_S = WS_MGF;
constexpr size_t WS_MG = 1300 * MiB;
constexpr size_t WS_END = 1336 * MiB;

constexpr int RING_BYTES = 131072;
constexpr int MISC_OFF = RING_BYTES;
constexpr int LDS_BYTES = 147456;

#define RLX_AGENT __ATOMIC_RELAXED, __HIP_MEMORY_SCOPE_AGENT
#define LDS_WAIT() asm volatile("s_waitcnt lgkmcnt(0)" ::: "memory")
#define VM_WAIT() asm volatile("s_waitcnt vmcnt(0)" ::: "memory")

__device__ __forceinline__ unsigned f2bf(float f) { unsigned u = __builtin_bit_cast(unsigned, f); return (u + 0x7fffu + ((u >> 16) & 1u)) >> 16; }
__device__ __forceinline__ unsigned pk2(float lo, float hi) { return f2bf(lo) | (f2bf(hi) << 16); }
__device__ __forceinline__ float bflo(unsigned w) { return __builtin_bit_cast(float, w << 16); }
__device__ __forceinline__ float bfhi(unsigned w) { return __builtin_bit_cast(float, w & 0xffff0000u); }
__device__ __forceinline__ float bf1(bf16_t h) { return __builtin_bit_cast(float, ((unsigned)h) << 16); }

namespace pg8 {
constexpr int BM = 256, BK = 64, HALF = 128, HTB = HALF * BK * 2, STAGE_BYTES = 8 * HTB, NXCD = 8, WGM = 8;
__host__ __device__ __forceinline__ int lds_byte(int r, int c) { const int st = (r >> 4) * 2 + (c >> 5), rr = r & 15, cc = c & 31, ob = rr * 64 + cc * 2; return st * 1024 + (ob ^ (((ob >> 9) & 1) << 5)); }
__host__ __device__ __forceinline__ void stage_rc(int b, int& R, int& C) { const int st = b / 1024, sb = b % 1024, swz = sb ^ (((sb >> 9) & 1) << 5); R = (st >> 1) * 16 + swz / 64; C = (st & 1) * 32 + (swz % 64) / 2; }
__host__ __device__ __forceinline__ int perm32(int rho) { const int n = rho >> 4, i = rho & 15; return 8 * (i >> 2) + 4 * n + (i & 3); }

struct Unit { int pm, pn, z; };
struct Gemm { int lda, ldb, K; };

__device__ __forceinline__ unsigned cvt_pk_bf16(float lo, float hi) { unsigned r; asm volatile("v_cvt_pk_bf16_f32 %0, %1, %2" : "=v"(r) : "v"(lo), "v"(hi)); return r; }

struct BigOrder {
    const GAS char* A; const GAS char* B; size_t astep, bstep; int nM, nN, nwg, G, c;
    __device__ __forceinline__ void init(const GAS void* A_, const GAS void* B_, int lda, int ldb, int M_, int N_, int G_, int c_) {
        A = (const GAS char*)A_; B = (const GAS char*)B_; astep = (size_t)BM * lda * 2; bstep = (size_t)BM * ldb * 2; nM = M_ / BM; nN = N_ / BM; nwg = nM * nN; G = G_; c = c_; }
    __device__ __forceinline__ bool next(int i, Unit& u) const {
        const long L = (long)i * G + c; if (L >= nwg) return false;
        int wgid = (int)L; { const int q = nwg / NXCD, r = nwg % NXCD, xcd = wgid % NXCD, off = wgid / NXCD; wgid = (xcd < r ? xcd * (q + 1) : r * (q + 1) + (xcd - r) * q) + off; }
        const int nig = WGM * nN, gid = wgid / nig, fm = gid * WGM, gsz = (nM - fm) < WGM ? (nM - fm) : WGM;
        u.pm = fm + ((wgid % nig) % gsz); u.pn = (wgid % nig) / gsz; u.z = 0; return true;
    }
    __device__ __forceinline__ int nt(const Unit&, int d) const { return d; }
    __device__ __forceinline__ const GAS char* aptr(const Unit& u) const { return A + (size_t)u.pm * astep; }
    __device__ __forceinline__ const GAS char* bptr(const Unit& u) const { return B + (size_t)u.pn * bstep; }
};

template <class Epi, class Sched, bool ALIGN_EPI, bool SP2>
__device__ __forceinline__ void gemm_phase(LAS unsigned char* lds, const int tid, const Gemm g, const Sched& S, const Epi& E) {
    const int wid = __builtin_amdgcn_readfirstlane(tid >> 6), lane = tid & 63, wr = wid >> 2, wc = wid & 3, fr = lane & 15, fq = lane >> 4;
    const int nt0 = g.K / BK;
    unsigned voffA[2], voffB[2];
#pragma unroll
    for (int i = 0; i < 2; ++i) { int R, C; stage_rc(tid * 16 + i * 8192, R, C); const int Rb = Epi::PERM ? ((R & ~31) + perm32(R & 31)) : R;
        voffA[i] = (unsigned)(R * g.lda + C) * 2u; voffB[i] = (unsigned)(Rb * g.ldb + C) * 2u; }
    const size_t kstep = (size_t)(BK * 2);
    const size_t hstepA = (size_t)HALF * g.lda * 2, hstepB = (size_t)HALF * g.ldb * 2;
    const unsigned ldsw = (unsigned)wid * 1024u;
    const int aoff = lds_byte(wr * 64 + fr, fq * 8), boff = lds_byte(wc * 32 + fr, fq * 8);
#define PG8_SA(b, h) (((b) * 2 + (h)) * HTB)
#define PG8_SB(b, h) ((4 + (b) * 2 + (h)) * HTB)
#define PG8_STAGE(bufoff, gbase, voff) do { _Pragma("unroll") for (int _i = 0; _i < 2; ++_i) \
        __builtin_amdgcn_global_load_lds((const GAS unsigned*)((const GAS char*)(gbase) + (voff)[_i]), (LAS unsigned*)(lds + (bufoff) + ldsw + _i * 8192), 16, 0, 0); } while (0)
#define PG8_LDA(dst, b, h) do { _Pragma("unroll") for (int m = 0; m < 4; ++m) _Pragma("unroll") for (int k = 0; k < 2; ++k) dst[m][k] = *(const LAS bf16x8*)(lds + PG8_SA(b, h) + aoff + m * 2048 + k * 1024); } while (0)
#define PG8_LDB(dst, b, h) do { _Pragma("unroll") for (int n = 0; n < 2; ++n) _Pragma("unroll") for (int k = 0; k < 2; ++k) dst[n][k] = *(const LAS bf16x8*)(lds + PG8_SB(b, h) + boff + n * 2048 + k * 1024); } while (0)
#define PG8_MMA(ai, bj, At, Bt) do { __builtin_amdgcn_s_setprio(1); _Pragma("unroll") for (int m = 0; m < 4; ++m) _Pragma("unroll") for (int n = 0; n < 2; ++n) _Pragma("unroll") for (int k = 0; k < 2; ++k) \
        acc[ai][bj][m][n] = __builtin_amdgcn_mfma_f32_16x16x32_bf16(Bt[n][k], At[m][k], acc[ai][bj][m][n], 0, 0, 0); __builtin_amdgcn_s_setprio(0); } while (0)
#define PG8_WAIT_V(n) asm volatile("s_waitcnt vmcnt(" #n ")" ::: "memory")
#define PG8_WAIT_L(n) asm volatile("s_waitcnt lgkmcnt(" #n ")" ::: "memory")
#define PG8_BAR __builtin_amdgcn_s_barrier()
#define PG8_SCHED __builtin_amdgcn_sched_barrier(0)
    Unit cur, nxt; int ui = 0;
    if (!S.next(0, cur)) return;
    f32x4 acc[2][2][4][2];
#pragma unroll
    for (int a = 0; a < 2; ++a)
#pragma unroll
        for (int b = 0; b < 2; ++b)
#pragma unroll
            for (int m = 0; m < 4; ++m)
#pragma unroll
                for (int n = 0; n < 2; ++n) acc[a][b][m][n] = (f32x4){0.f, 0.f, 0.f, 0.f};
    bf16x8 At[4][2], B0[2][2], B1[2][2];
    const GAS char* cA = S.aptr(cur); const GAS char* cB = S.bptr(cur);
    if constexpr (SP2) {
        PG8_STAGE(PG8_SB(0, 0), cB, voffB); PG8_STAGE(PG8_SB(0, 1), cB + hstepB, voffB); PG8_STAGE(PG8_SA(0, 0), cA, voffA); PG8_STAGE(PG8_SA(0, 1), cA + hstepA, voffA);
        if (wr == 1) PG8_BAR;
        PG8_WAIT_V(2); PG8_BAR;
        PG8_STAGE(PG8_SB(1, 0), cB + kstep, voffB); PG8_STAGE(PG8_SA(1, 0), cA + kstep, voffA); PG8_STAGE(PG8_SB(1, 1), cB + hstepB + kstep, voffB);
        PG8_WAIT_V(6); PG8_BAR;
    } else {
        PG8_STAGE(PG8_SB(0, 0), cB, voffB); PG8_STAGE(PG8_SA(0, 0), cA, voffA); PG8_STAGE(PG8_SB(0, 1), cB + hstepB, voffB); PG8_STAGE(PG8_SA(0, 1), cA + hstepA, voffA);
        if (wr == 1) PG8_BAR;
        PG8_WAIT_V(4); PG8_BAR;
        PG8_STAGE(PG8_SB(1, 0), cB + kstep, voffB); PG8_STAGE(PG8_SA(1, 0), cA + kstep, voffA); PG8_STAGE(PG8_SB(1, 1), cB + hstepB + kstep, voffB);
        PG8_WAIT_V(6); PG8_BAR;
    }
    for (;;) {
        const bool has_next = S.next(ui + 1, nxt);
        const int nt = S.nt(cur, nt0);
        const GAS char* nA = has_next ? S.aptr(nxt) : cA; const GAS char* nB = has_next ? S.bptr(nxt) : cB;
#pragma unroll 1
        for (int t = 0; t < nt; t += 2) {
            const bool last = (t == nt - 2);
            const GAS char* a1 = cA + (size_t)(t + 1) * kstep;
            const GAS char* a2 = last ? nA : cA + (size_t)(t + 2) * kstep; const GAS char* b2 = last ? nB : cB + (size_t)(t + 2) * kstep;
            const GAS char* a3 = a2 + kstep; const GAS char* b3 = b2 + kstep;
            if constexpr (SP2) {
            PG8_LDB(B0, 0, 0); PG8_LDB(B1, 0, 1); PG8_SCHED; PG8_LDA(At, 0, 0); PG8_STAGE(PG8_SA(1, 1), a1 + hstepA, voffA);
            PG8_WAIT_V(8); PG8_WAIT_L(0); PG8_BAR; PG8_MMA(0, 0, At, B0); PG8_MMA(0, 1, At, B1); PG8_BAR; PG8_SCHED;
            PG8_LDA(At, 0, 1); PG8_STAGE(PG8_SB(0, 0), b2, voffB); PG8_STAGE(PG8_SB(0, 1), b2 + hstepB, voffB); PG8_STAGE(PG8_SA(0, 0), a2, voffA);
            PG8_WAIT_V(8); PG8_WAIT_L(0); PG8_BAR; PG8_MMA(1, 0, At, B0); PG8_MMA(1, 1, At, B1); PG8_BAR; PG8_SCHED;
            PG8_LDB(B0, 1, 0); PG8_LDB(B1, 1, 1); PG8_SCHED; PG8_LDA(At, 1, 0); PG8_STAGE(PG8_SA(0, 1), a2 + hstepA, voffA);
            PG8_WAIT_V(8); PG8_WAIT_L(0); PG8_BAR; PG8_MMA(0, 0, At, B0); PG8_MMA(0, 1, At, B1); PG8_BAR; PG8_SCHED;
            PG8_LDA(At, 1, 1); PG8_STAGE(PG8_SB(1, 0), b3, voffB); PG8_STAGE(PG8_SB(1, 1), b3 + hstepB, voffB); PG8_STAGE(PG8_SA(1, 0), a3, voffA);
            PG8_WAIT_V(8); PG8_WAIT_L(0); PG8_BAR; PG8_MMA(1, 0, At, B0); PG8_MMA(1, 1, At, B1); PG8_BAR; PG8_SCHED;
            } else {
            PG8_LDB(B0, 0, 0); PG8_SCHED; PG8_LDA(At, 0, 0); PG8_STAGE(PG8_SA(1, 1), a1 + hstepA, voffA);
            PG8_WAIT_L(8); PG8_BAR; PG8_WAIT_L(0); PG8_MMA(0, 0, At, B0); PG8_BAR; PG8_SCHED;
            PG8_LDB(B1, 0, 1); PG8_STAGE(PG8_SB(0, 0), b2, voffB);
            PG8_BAR; PG8_WAIT_L(0); PG8_MMA(0, 1, At, B1); PG8_BAR;
            PG8_LDA(At, 0, 1); PG8_STAGE(PG8_SA(0, 0), a2, voffA);
            PG8_BAR; PG8_WAIT_L(0); PG8_MMA(1, 0, At, B0); PG8_BAR; PG8_SCHED;
            PG8_STAGE(PG8_SB(0, 1), b2 + hstepB, voffB);
            PG8_WAIT_V(6); PG8_BAR; PG8_MMA(1, 1, At, B1); PG8_BAR;
            PG8_LDB(B0, 1, 0); PG8_SCHED; PG8_LDA(At, 1, 0); PG8_STAGE(PG8_SA(0, 1), a2 + hstepA, voffA);
            PG8_WAIT_L(8); PG8_BAR; PG8_WAIT_L(0); PG8_MMA(0, 0, At, B0); PG8_BAR; PG8_SCHED;
            PG8_LDB(B1, 1, 1); PG8_STAGE(PG8_SB(1, 0), b3, voffB);
            PG8_BAR; PG8_WAIT_L(0); PG8_MMA(0, 1, At, B1); PG8_BAR;
            PG8_LDA(At, 1, 1); PG8_STAGE(PG8_SA(1, 0), a3, voffA);
            PG8_BAR; PG8_WAIT_L(0); PG8_MMA(1, 0, At, B0); PG8_BAR; PG8_SCHED;
            PG8_STAGE(PG8_SB(1, 1), b3 + hstepB, voffB);
            PG8_WAIT_V(6); PG8_BAR; PG8_MMA(1, 1, At, B1); PG8_BAR;
            }
        }
        if constexpr (ALIGN_EPI) { if (wr == 0) PG8_BAR; }
        E(acc, cur, wr, wc, fr, fq);
        if (!has_next) break;
        bool rst = true; if constexpr (Epi::KEEPS) rst = E.reset(cur);
        if (rst) {
#pragma unroll
        for (int a = 0; a < 2; ++a)
#pragma unroll
            for (int b = 0; b < 2; ++b)
#pragma unroll
                for (int m = 0; m < 4; ++m)
#pragma unroll
                    for (int n = 0; n < 2; ++n) acc[a][b][m][n] = (f32x4){0.f, 0.f, 0.f, 0.f};
        }
        cur = nxt; cA = nA; cB = nB; ++ui;
        if constexpr (ALIGN_EPI) { if (wr == 1) PG8_BAR; }
    }
    PG8_WAIT_V(0);
    if constexpr (!ALIGN_EPI) { if (wr == 0) PG8_BAR; }
    PG8_BAR;
#undef PG8_SA
#undef PG8_SB
#undef PG8_STAGE
#undef PG8_LDA
#undef PG8_LDB
#undef PG8_MMA
#undef PG8_WAIT_V
#undef PG8_WAIT_L
#undef PG8_BAR
#undef PG8_SCHED
}


template <int ACT> struct EpiBf16 {
    static constexpr bool PERM = true; static constexpr bool KEEPS = false;
    GAS bf16_t* O; int ldc; const GAS float* bias;
    __device__ __forceinline__ void operator()(const f32x4 (&acc)[2][2][4][2], const Unit& u, int wr, int wc, int fr, int fq) const {
        const int row0 = u.pm * BM + wr * 64 + fr, col0 = u.pn * BM + wc * 32 + 8 * fq;
        f32x4 bv[2][2];
#pragma unroll
        for (int bj = 0; bj < 2; ++bj)
#pragma unroll
            for (int n = 0; n < 2; ++n) bv[bj][n] = bias ? *(const GAS f32x4*)(bias + col0 + bj * HALF + 4 * n) : (f32x4){0.f, 0.f, 0.f, 0.f};
#pragma unroll
        for (int ai = 0; ai < 2; ++ai)
#pragma unroll
            for (int m = 0; m < 4; ++m) { GAS bf16_t* rowp = O + (size_t)(row0 + ai * HALF + m * 16) * ldc + col0;
#pragma unroll
                for (int bj = 0; bj < 2; ++bj) { f32x4 v0 = acc[ai][bj][m][0] + bv[bj][0], v1 = acc[ai][bj][m][1] + bv[bj][1];
                    if (ACT == 1) {
#pragma unroll
                        for (int j = 0; j < 4; ++j) { const float a = fmaxf(v0[j], 0.f), b = fmaxf(v1[j], 0.f); v0[j] = a * a; v1[j] = b * b; } }
                    u32x4 w; w.x = cvt_pk_bf16(v0[0], v0[1]); w.y = cvt_pk_bf16(v0[2], v0[3]); w.z = cvt_pk_bf16(v1[0], v1[1]); w.w = cvt_pk_bf16(v1[2], v1[3]);
                    *(GAS u32x4*)(rowp + bj * HALF) = w; } }
    }
};
struct EpiScores {
    static constexpr bool PERM = true; static constexpr bool KEEPS = false;
    GAS bf16_t* O; const GAS float* rdec;
    __device__ __forceinline__ void operator()(const f32x4 (&acc)[2][2][4][2], const Unit& u, int wr, int wc, int fr, int fq) const {
        const int h = (u.z / 9) & 3; const float lf = log1pf(-expf(rdec[h])) * 1.4426950408889634f, lb = log1pf(-expf(rdec[4 + h])) * 1.4426950408889634f;
        GAS bf16_t* base = O + (size_t)u.z * 256 * 768 + (size_t)(wr * 64 + fr) * 768 + wc * 32 + 8 * fq;
        float d00 = (float)(wr * 64 + fr - wc * 32 - 8 * fq);
        asm volatile("" : "+v"(d00));
#pragma unroll
        for (int ai = 0; ai < 2; ++ai)
#pragma unroll
            for (int m = 0; m < 4; ++m) {
#pragma unroll
                for (int bj = 0; bj < 2; ++bj) { float v[8];
#pragma unroll
                    for (int n = 0; n < 2; ++n)
#pragma unroll
                        for (int e = 0; e < 4; ++e) { const float d = d00 + (float)(ai * HALF + m * 16 - bj * HALF - 4 * n - e);
                            const float dp = fmaxf(d, 0.f), dn = fmaxf(-d, 0.f);
                            const float mk = __builtin_amdgcn_exp2f(dp * lf + dn * lb) + (1.0f - fminf(dp + dn, 1.0f));
                            v[4 * n + e] = acc[ai][bj][m][n][e] * mk; }
                    u32x4 w; w.x = cvt_pk_bf16(v[0], v[1]); w.y = cvt_pk_bf16(v[2], v[3]); w.z = cvt_pk_bf16(v[4], v[5]); w.w = cvt_pk_bf16(v[6], v[7]);
                    *(GAS u32x4*)(base + (size_t)(ai * HALF + m * 16) * 768 + bj * HALF) = w; }
                asm volatile("" ::: "memory"); }
    }
};
struct EpiF32 {
    static constexpr bool PERM = false; static constexpr bool KEEPS = false;
    GAS float* C; int ldc; size_t zstride;
    __device__ __forceinline__ void operator()(const f32x4 (&acc)[2][2][4][2], const Unit& u, int wr, int wc, int fr, int fq) const {
        const int row0 = u.pm * BM + wr * 64 + fr, col0 = u.pn * BM + wc * 32 + 4 * fq; GAS float* Cz = C + (size_t)u.z * zstride;
#pragma unroll
        for (int ai = 0; ai < 2; ++ai)
#pragma unroll
            for (int m = 0; m < 4; ++m) { GAS float* rowp = Cz + (size_t)(row0 + ai * HALF + m * 16) * ldc + col0;
#pragma unroll
                for (int bj = 0; bj < 2; ++bj)
#pragma unroll
                    for (int n = 0; n < 2; ++n) *(GAS f32x4*)(rowp + bj * HALF + n * 16) = acc[ai][bj][m][n]; }
    }
};
struct EpiMerged {
    static constexpr bool PERM = true; static constexpr bool KEEPS = true;
    const GAS bf16_t* Z; GAS bf16_t* MG;
    __device__ __forceinline__ bool reset(const Unit& u) const { return u.z == 2; }
    __device__ __forceinline__ void operator()(f32x4 (&acc)[2][2][4][2], const Unit& u, int wr, int wc, int fr, int fq) const {
        int row0 = u.pm * BM + wr * 64 + fr, col0 = u.pn * BM + wc * 32 + 8 * fq;
        const bool fin = u.z == 2;
        const int offn = O_GATE + u.z * D, offd = O_GATE + (fin ? 2 : u.z + 1) * D;
#pragma unroll
        for (int ai = 0; ai < 2; ++ai)
#pragma unroll
            for (int m = 0; m < 4; ++m) { int rowi = row0 + ai * HALF + m * 16; asm volatile("" : "+v"(rowi)); const size_t row = (size_t)rowi;
#pragma unroll
                for (int bj = 0; bj < 2; ++bj) { const int col = col0 + bj * HALF;
                    const GAS bf16_t* zp = Z + row * DIN + col;
                    const u32x4 zn = *(const GAS u32x4*)(zp + offn), zd = *(const GAS u32x4*)(zp + offd);
                    const unsigned nn[4] = {zn.x, zn.y, zn.z, zn.w}, dd[4] = {zd.x, zd.y, zd.z, zd.w};
                    float f[8];
#pragma unroll
                    for (int e = 0; e < 4; ++e) {
                        const float n0 = __builtin_amdgcn_rcpf(1.0f + __expf(-bflo(nn[e]))), n1 = __builtin_amdgcn_rcpf(1.0f + __expf(-bfhi(nn[e])));
                        const float d0 = fin ? 1.0f : 1.0f + __expf(-bflo(dd[e])), d1 = fin ? 1.0f : 1.0f + __expf(-bfhi(dd[e]));
                        f[2 * e] = n0 * d0; f[2 * e + 1] = n1 * d1; }
#pragma unroll
                    for (int n = 0; n < 2; ++n)
#pragma unroll
                        for (int e = 0; e < 4; ++e) acc[ai][bj][m][n][e] *= f[4 * n + e];
                    if (fin) { u32x4 w; w.x = cvt_pk_bf16(acc[ai][bj][m][0][0], acc[ai][bj][m][0][1]); w.y = cvt_pk_bf16(acc[ai][bj][m][0][2], acc[ai][bj][m][0][3]);
                        w.z = cvt_pk_bf16(acc[ai][bj][m][1][0], acc[ai][bj][m][1][1]); w.w = cvt_pk_bf16(acc[ai][bj][m][1][2], acc[ai][bj][m][1][3]);
                        *(GAS u32x4*)(MG + row * D + col) = w; } }
                asm volatile("" ::: "memory"); }
    }
};
struct EpiResid {
    static constexpr bool PERM = false; static constexpr bool KEEPS = false;
    const GAS float* X; GAS float* S; const GAS float* bias; const GAS float* gate; GAS float* PB;
    __device__ __forceinline__ void operator()(const f32x4 (&acc)[2][2][4][2], const Unit& u, int wr, int wc, int fr, int fq) const {
        const int row0 = u.pm * BM + wr * 64 + fr, col0 = u.pn * BM + wc * 32 + 4 * fq;
        const int bmod = u.pm < 4 ? 4 : ((u.pm - 4) >> 3);
        const GAS float* gp = gate + (size_t)bmod * 12288;
        f32x4 bv[2][2], gv[2][2];
#pragma unroll
        for (int bj = 0; bj < 2; ++bj)
#pragma unroll
            for (int n = 0; n < 2; ++n) { bv[bj][n] = *(const GAS f32x4*)(bias + col0 + bj * HALF + n * 16); gv[bj][n] = *(const GAS f32x4*)(gp + col0 + bj * HALF + n * 16); }
        if (u.z == 0) {
#pragma unroll
            for (int ai = 0; ai < 2; ++ai)
#pragma unroll
                for (int m = 0; m < 4; ++m) { const size_t off = (size_t)(row0 + ai * HALF + m * 16) * D + col0;
#pragma unroll
                    for (int bj = 0; bj < 2; ++bj)
#pragma unroll
                        for (int n = 0; n < 2; ++n) { const f32x4 xv = *(const GAS f32x4*)(X + off + bj * HALF + n * 16);
                            *(GAS f32x4*)(S + off + bj * HALF + n * 16) = xv * ALPHA + gv[bj][n] * (acc[ai][bj][m][n] + bv[bj][n]); } }
        } else {
            GAS float* pb = PB + (size_t)(u.z - 1) * 1024 * D;
#pragma unroll
            for (int ai = 0; ai < 2; ++ai)
#pragma unroll
                for (int m = 0; m < 4; ++m) { const size_t off = (size_t)(row0 - 8192 + ai * HALF + m * 16) * D + col0;
#pragma unroll
                    for (int bj = 0; bj < 2; ++bj)
#pragma unroll
                        for (int n = 0; n < 2; ++n) *(GAS f32x4*)(pb + off + bj * HALF + n * 16) = gv[bj][n] * acc[ai][bj][m][n]; }
        }
    }
};
struct SplitOrder {
    const GAS char* A; const GAS char* B; size_t astep, bstep; int c, nt_full;
    __device__ __forceinline__ void init(const GAS void* A_, const GAS void* B_, int lda, int ldb, int K, int c_) {
        A = (const GAS char*)A_; B = (const GAS char*)B_; astep = (size_t)BM * lda * 2; bstep = (size_t)BM * ldb * 2; c = c_; nt_full = K / BK; }
    __device__ __forceinline__ bool next(int i, Unit& u) const {
        const int x = c & 7, j = c >> 3;
        if (i == 0) { u.pm = x * 4 + (j >> 3); u.pn = j & 7; u.z = 0; return true; }
        if (i == 1) { u.pm = 32 + (j >> 3); u.pn = j & 7; u.z = x; return true; }
        return false;
    }
    __device__ __forceinline__ int nt(const Unit& u, int) const { return u.pm < 32 ? nt_full : nt_full / 8; }
    __device__ __forceinline__ size_t koff(const Unit& u) const { return u.pm < 32 ? 0 : (size_t)u.z * (nt_full / 8) * BK * 2; }
    __device__ __forceinline__ const GAS char* aptr(const Unit& u) const { return A + (size_t)u.pm * astep + koff(u); }
    __device__ __forceinline__ const GAS char* bptr(const Unit& u) const { return B + (size_t)u.pn * bstep + koff(u); }
};
}

#define XB_TMO      128
#define XB_XCNT(j)  (256  + 64 * (j))
#define XB_XSUB(j)  (1280 + 64 * (j))
#define XB_XGEN(j)  (2304 + 64 * (j))
#define XB_TOP      3328
#define XB_TOPGEN   3392
#define XCD_BAR_WORDS 3456
#define XB_SPIN_CAP (1u << 22)

__device__ __forceinline__ unsigned xb_ld(unsigned* p)              { return __hip_atomic_load(p, __ATOMIC_RELAXED, __HIP_MEMORY_SCOPE_AGENT); }
__device__ __forceinline__ unsigned xb_add(unsigned* p, unsigned v) { return __hip_atomic_fetch_add(p, v, __ATOMIC_RELAXED, __HIP_MEMORY_SCOPE_AGENT); }
__device__ __forceinline__ unsigned xb_xcc_id() { return (unsigned)__builtin_amdgcn_s_getreg((3 << 11) | 20) & 0xFu; }
#define XB_SPIN(cond, bar) do { unsigned _sp = 0; while (cond) { __builtin_amdgcn_s_sleep(1); \
    if ((++_sp & 255u) == 0u) { if (xb_ld(&(bar)[XB_TMO])) break; if (_sp > XB_SPIN_CAP) { atomicAdd(&(bar)[XB_TMO], 1u); break; } } } } while (0)

struct XcdBarrier { unsigned* bar; unsigned x; volatile LAS unsigned* st; };

__device__ __forceinline__ XcdBarrier xcd_barrier_post(unsigned* bar, volatile LAS unsigned* st) {
    XcdBarrier b; b.bar = bar; b.x = xb_xcc_id(); b.st = st;
    if (threadIdx.x == 0) (void)xb_add(&bar[XB_XCNT(b.x)], 1u);
    return b;
}
__device__ __forceinline__ void xcd_barrier_complete(unsigned* bar, unsigned x, unsigned& nloc, unsigned& nx) {
    const unsigned G = gridDim.x * gridDim.y * gridDim.z;
    unsigned sum, cnt, mine, sp = 0u;
    for (;;) {
        sum = 0u; cnt = 0u; mine = 0u;
#pragma unroll
        for (unsigned j = 0; j < 16; ++j) { const unsigned c = xb_ld(&bar[XB_XCNT(j)]); sum += c; cnt += (c > 0u) ? 1u : 0u; mine = (j == x) ? c : mine; }
        if (sum == G) break;
        __builtin_amdgcn_s_sleep(1);
        if ((++sp & 255u) == 0u) { if (xb_ld(&bar[XB_TMO])) break; if (sp > XB_SPIN_CAP) { atomicAdd(&bar[XB_TMO], 1u); break; } }
    }
    nloc = mine > 0u ? mine : 1u; nx = cnt > 0u ? cnt : 1u;
}
__device__ __forceinline__ void xcd_barrier(const XcdBarrier& b) {
    asm volatile("s_waitcnt vmcnt(0)" ::: "memory");
    __syncthreads();
    if (threadIdx.x == 0) {
        unsigned* bar = b.bar;
        __builtin_amdgcn_s_waitcnt(0);
        unsigned nloc = b.st[0], nx = b.st[1];
        if (nloc == 0u) { xcd_barrier_complete(bar, b.x, nloc, nx); b.st[0] = nloc; b.st[1] = nx; }
        const unsigned old = xb_add(&bar[XB_XSUB(b.x)], 1u);
        const unsigned gen = old / nloc;
        if (old + 1u == (gen + 1u) * nloc) {
            __builtin_amdgcn_fence(__ATOMIC_RELEASE, "agent");
            asm volatile("s_waitcnt vmcnt(0)" ::: "memory");
            const unsigned og = xb_add(&bar[XB_TOP], 1u);
            const unsigned tg = og / nx;
            if (og + 1u == (tg + 1u) * nx) xb_add(&bar[XB_TOPGEN], 1u);
            else XB_SPIN(xb_ld(&bar[XB_TOPGEN]) == tg, bar);
            __builtin_amdgcn_fence(__ATOMIC_ACQUIRE, "agent");
            xb_add(&bar[XB_XGEN(b.x)], 1u);
            asm volatile("s_waitcnt vmcnt(0)" ::: "memory");
        } else {
            XB_SPIN(xb_ld(&bar[XB_XGEN(b.x)]) == gen, bar);
            __builtin_amdgcn_fence(__ATOMIC_ACQUIRE, "agent");
            asm volatile("s_waitcnt vmcnt(0)" ::: "memory");
        }
    }
    __syncthreads();
}

struct Args { const float* in[37]; float* out; unsigned char* ws; int ph_lo, ph_hi; };
typedef const __attribute__((address_space(4))) Args* CArgs;
enum { I_X = 0, I_C, I_CTX, I_CCTX, I_WADA, I_BADA, I_WIN, I_BIN, I_CONVW, I_CONVB, I_POOLW, I_POOLS, I_FW1, I_FB1, I_FF1, I_FW2, I_FB2, I_FF2, I_FW3, I_FB3, I_FF3, I_FW4,
       I_HYD, I_RDEC, I_PA, I_PB, I_PC, I_WO, I_BO, I_LN1G, I_LN1B, I_W1, I_B1, I_W2, I_B2, I_LN2G, I_LN2B };

struct Frame {
    LAS unsigned char* lds;
    int tid, lane, wave, blk, G;
    GAS unsigned char* ws;
};

__device__ __forceinline__ float wave_sum(float v) {
#pragma unroll
    for (int o = 1; o < 64; o <<= 1) v += __shfl_xor(v, o);
    return v;
}
__device__ __forceinline__ float silu_f(float v) { return v / (1.0f + __expf(-v)); }
__device__ __forceinline__ int chunk_row0(int b, int ci) { return ci == 0 ? b * CTXL : MC + b * SEQ + (ci - 1) * 256; }
__device__ __forceinline__ float ret_lg2(const GAS float* rdec, int l, int dirh) { const float p = rdec[l * 8 + dirh]; return log1pf(-expf(p)) * 1.4426950408889634f; }

__device__ __forceinline__ void transpose_item(const GAS float* W, int N, GAS bf16_t* WT, int ldw, int koff, LAS float* scr, int item, int lane) {
    const int nblk = N / 32, kb = item / nblk, nb = item % nblk, k0 = 64 * kb, n0 = 32 * nb;
#pragma unroll 8
    for (int i = 0; i < 32; ++i) { const int kk = 2 * i + (lane >> 5); scr[kk * 33 + (lane & 31)] = W[(size_t)(k0 + kk) * N + n0 + (lane & 31)]; }
    LDS_WAIT(); asm volatile("" ::: "memory");
    const int c = lane & 7;
#pragma unroll
    for (int j = 0; j < 4; ++j) { const int n = (lane >> 3) + 8 * j; const LAS float* s = scr + (8 * c) * 33 + n;
        u32x4 o; o.x = pk2(s[0 * 33], s[1 * 33]); o.y = pk2(s[2 * 33], s[3 * 33]); o.z = pk2(s[4 * 33], s[5 * 33]); o.w = pk2(s[6 * 33], s[7 * 33]);
        *(GAS u32x4*)(WT + (size_t)(n0 + n) * ldw + koff + k0 + 8 * c) = o; }
    LDS_WAIT(); asm volatile("" ::: "memory");
}

__device__ __forceinline__ void pro_a(Frame& F, CArgs a) {
    LAS float* scr = (LAS float*)(F.lds + F.wave * 16384);
    const int gw = F.blk * 8 + F.wave, NGW = F.G * 8, lane = F.lane;
    GAS unsigned char* ws = F.ws;
    constexpr int I_IN = 32 * 384, I_PAB = 8 * 64, I_PCC = 16 * 64, I_O = 32 * 64, I_1 = 32 * 256, I_2 = 128 * 64;
    constexpr int PER_L = I_IN + 2 * I_PAB + I_PCC + I_O + I_1 + I_2;
    for (int it = gw; it < DEPTH * PER_L; it += NGW) {
        const int l = it / PER_L; int r = it % PER_L;
        if (r < I_IN) { transpose_item(((const GAS float*)a->in[I_WIN]) + (size_t)l * D * DIN, DIN, (GAS bf16_t*)(ws + WS_WIN) + (size_t)l * DIN * D, D, 0, scr, r, lane); continue; } r -= I_IN;
        if (r < I_PAB) { transpose_item(((const GAS float*)a->in[I_PA]) + (size_t)l * 512 * D, D, (GAS bf16_t*)(ws + WS_PT) + (size_t)l * D * D, D, 0, scr, r, lane); continue; } r -= I_PAB;
        if (r < I_PAB) { transpose_item(((const GAS float*)a->in[I_PB]) + (size_t)l * 512 * D, D, (GAS bf16_t*)(ws + WS_PT) + (size_t)l * D * D, D, 512, scr, r, lane); continue; } r -= I_PAB;
        if (r < I_PCC) { transpose_item(((const GAS float*)a->in[I_PC]) + (size_t)l * 1024 * D, D, (GAS bf16_t*)(ws + WS_PT) + (size_t)l * D * D, D, 1024, scr, r, lane); continue; } r -= I_PCC;
        if (r < I_O) { transpose_item(((const GAS float*)a->in[I_WO]) + (size_t)l * D * D, D, (GAS bf16_t*)(ws + WS_WO) + (size_t)l * D * D, D, 0, scr, r, lane); continue; } r -= I_O;
        if (r < I_1) { transpose_item(((const GAS float*)a->in[I_W1]) + (size_t)l * D * DFF, DFF, (GAS bf16_t*)(ws + WS_W1) + (size_t)l * DFF * D, D, 0, scr, r, lane); continue; } r -= I_1;
        transpose_item(((const GAS float*)a->in[I_W2]) + (size_t)l * DFF * D, D, (GAS bf16_t*)(ws + WS_W2) + (size_t)l * D * DFF, DFF, 0, scr, r, lane);
    }
    {
        GAS float* modp = (GAS float*)(ws + WS_MODP);
        for (int it = gw; it < DEPTH * 192 * 16; it += NGW) {
            const int ks = it & 15, cb = (it >> 4) % 192, l = it / (16 * 192);
            const int col = cb * 64 + lane, k0 = ks * 128;
            float sv0[5], sv1[5];
#pragma unroll
            for (int b = 0; b < 5; ++b) { const GAS float* cp = b < 4 ? ((const GAS float*)a->in[I_C]) + b * D : ((const GAS float*)a->in[I_CCTX]); sv0[b] = silu_f(cp[k0 + lane]); sv1[b] = silu_f(cp[k0 + 64 + lane]); }
            float acc[5] = {0.f, 0.f, 0.f, 0.f, 0.f};
            const GAS float* wp = ((const GAS float*)a->in[I_WADA]) + ((size_t)l * D + k0) * 12288 + col;
            for (int kk = 0; kk < 64; ++kk) { const float w = wp[(size_t)kk * 12288];
#pragma unroll
                for (int b = 0; b < 5; ++b) acc[b] += __shfl(sv0[b], kk) * w; }
            for (int kk = 0; kk < 64; ++kk) { const float w = wp[(size_t)(64 + kk) * 12288];
#pragma unroll
                for (int b = 0; b < 5; ++b) acc[b] += __shfl(sv1[b], kk) * w; }
#pragma unroll
            for (int b = 0; b < 5; ++b) modp[(((size_t)ks * DEPTH + l) * 5 + b) * 12288 + col] = acc[b];
        }
    }
    {
        LAS float* H3 = (LAS float*)F.lds;
        GAS bf16_t* krg = (GAS bf16_t*)(ws + WS_KRG); GAS bf16_t* krc = (GAS bf16_t*)(ws + WS_KRC);
        for (int it = F.blk; it < DEPTH * 36; it += F.G) {
            const int l = it / 36, grp = it % 36; const bool isc = grp >= 32; const int L = isc ? CTXL : SEQ, p0 = (isc ? grp - 32 : grp) * 64;
            __syncthreads();
            for (int pp = 0; pp < 8; ++pp) {
                const int pos = p0 + F.wave * 8 + pp;
                const float t = (float)pos / (float)(L - 1);
                const float w = 6.2831853071795862f * (float)pos / (float)L;
                float zf = 0.f;
                if (lane == 0) zf = t;
                else if (lane < 33) { const int bi = (lane - 1) & 15; const float f = 1e-4f + (float)bi * ((15.0f - 1e-4f) / 15.0f); const float ang = f * w; zf = lane <= 16 ? cosf(ang) : -sinf(ang); }
                float h = ((const GAS float*)a->in[I_FB1])[l * 64 + lane];
                for (int i = 0; i < 33; ++i) h += __shfl(zf, i) * ((const GAS float*)a->in[I_FW1])[((size_t)l * 33 + i) * 64 + lane];
                h = sinf(((const GAS float*)a->in[I_FF1])[l * 64 + lane] * h);
                float h2 = ((const GAS float*)a->in[I_FB2])[l * 64 + lane];
                for (int i = 0; i < 64; ++i) h2 += __shfl(h, i) * ((const GAS float*)a->in[I_FW2])[((size_t)l * 64 + i) * 64 + lane];
                h2 = sinf(((const GAS float*)a->in[I_FF2])[l * 64 + lane] * h2);
                float h3 = ((const GAS float*)a->in[I_FB3])[l * 64 + lane];
                for (int i = 0; i < 64; ++i) h3 += __shfl(h2, i) * ((const GAS float*)a->in[I_FW3])[((size_t)l * 64 + i) * 64 + lane];
                h3 = sinf(((const GAS float*)a->in[I_FF3])[l * 64 + lane] * h3);
                H3[(F.wave * 8 + pp) * 64 + lane] = h3;
            }
            __syncthreads();
            const int c = F.tid;
            const float min_decay = -3.0701134573253945f, max_decay = -15.350567286626973f;
            const float adelta = fabsf(min_decay + (float)c * ((max_decay - min_decay) / 511.0f));
            GAS bf16_t* dst = isc ? krc + ((size_t)l * 512 + c) * 512 : krg + ((size_t)l * 512 + c) * 4096;
            const int center = isc ? CTXL : SEQ;
            if (p0 == 0) dst[0] = (bf16_t)0;
#pragma unroll 1
            for (int dir = 0; dir < 2; ++dir) {
                float wc[64];
#pragma unroll
                for (int i = 0; i < 64; ++i) wc[i] = ((const GAS float*)a->in[I_FW4])[((size_t)l * 64 + i) * 1024 + dir * 512 + c];
#pragma unroll 2
                for (int pp = 0; pp < 64; ++pp) {
                    float acc = 0.f;
#pragma unroll
                    for (int i4 = 0; i4 < 16; ++i4) { const f32x4 hv = *(const LAS f32x4*)(H3 + pp * 64 + 4 * i4);
                        acc += hv[0] * wc[4 * i4] + hv[1] * wc[4 * i4 + 1] + hv[2] * wc[4 * i4 + 2] + hv[3] * wc[4 * i4 + 3]; }
                    const int pos = p0 + pp; const float t = (float)pos / (float)(L - 1);
                    const bf16_t v = (bf16_t)f2bf(acc * expf(-t * adelta));
                    if (dir == 0) dst[center - pos] = v; else if (pos > 0) dst[center + pos] = v;
                }
            }
        }
        __syncthreads();
    }
    for (int t = gw; t < SEQ; t += NGW) {
        const float inv = exp2f(-(float)lane * (13.287712379549449f / 64.0f));
        const float ar = (float)(t >> 6) * inv, ac = (float)(t & 63) * inv;
        GAS float* rp = (GAS float*)(ws + WS_ROPE) + (size_t)t * 256;
        rp[lane] = cosf(ar); rp[64 + lane] = sinf(ar); rp[128 + lane] = cosf(ac); rp[192 + lane] = sinf(ac);
    }
    {
        GAS bf16_t* wpt = (GAS bf16_t*)(ws + WS_WPT);
        for (int e = F.blk * 512 + F.tid; e < DEPTH * 512 * 512; e += F.G * 512) {
            const int l = e >> 18, n = (e >> 9) & 511, k = e & 511; float v = 0.f;
            if ((n >> 7) == (k >> 7)) v = ((const GAS float*)a->in[I_POOLW])[(((size_t)l * 4 + (n >> 7)) * 128 + (k & 127)) * 128 + (n & 127)] * ((const GAS float*)a->in[I_POOLS])[l * 512 + n];
            wpt[e] = (bf16_t)f2bf(v);
        }
    }
    {
        GAS f32x4* X = (GAS f32x4*)(ws + WS_X);
        const size_t nc = (size_t)MC * D / 4, nx = (size_t)ML * D / 4;
        for (size_t e = (size_t)F.blk * 512 + F.tid; e < nc + nx; e += (size_t)F.G * 512)
            X[e] = e < nc ? ((const GAS f32x4*)((const GAS float*)a->in[I_CTX]))[e] : ((const GAS f32x4*)((const GAS float*)a->in[I_X]))[e - nc];
    }
}
__device__ __forceinline__ void pro_b(Frame& F, CArgs a) {
    const GAS float* modp = (const GAS float*)(F.ws + WS_MODP); GAS float* mod = (GAS float*)(F.ws + WS_MOD);
    for (int e = F.blk * 512 + F.tid; e < DEPTH * 5 * 12288; e += F.G * 512) {
        const int j = e % 12288, l = e / (5 * 12288);
        float s = ((const GAS float*)a->in[I_BADA])[l * 12288 + j];
#pragma unroll
        for (int ks = 0; ks < 16; ++ks) s += modp[(size_t)ks * DEPTH * 5 * 12288 + e];
        mod[e] = s;
    }
}
__device__ __forceinline__ void pro_c(Frame& F) {
    const int gw = F.blk * 8 + F.wave, NGW = F.G * 8, lane = F.lane;
    const GAS float* mod = (const GAS float*)(F.ws + WS_MOD);
    for (int row = gw; row < M; row += NGW) {
        const int bmod = row < MC ? 4 : ((row - MC) >> 11);
        const GAS float* sh = mod + (size_t)bmod * 12288; const GAS float* sc = sh + D;
        const GAS f32x4* xr = (const GAS f32x4*)((const GAS float*)(F.ws + WS_X) + (size_t)row * D);
        GAS u32x2* o = (GAS u32x2*)((GAS bf16_t*)(F.ws + WS_XM) + (size_t)row * D);
#pragma unroll
        for (int j = 0; j < 8; ++j) { const int i4 = lane + 64 * j; const f32x4 v = xr[i4], s4 = ((const GAS f32x4*)sc)[i4], h4 = ((const GAS f32x4*)sh)[i4];
            const f32x4 r = v * (s4 + 1.0f) + h4; u32x2 w; w.x = pk2(r[0], r[1]); w.y = pk2(r[2], r[3]); o[i4] = w; }
    }
}

__device__ __forceinline__ void prep_phase(Frame& F, CArgs a, int l) {
    GAS unsigned char* ws = F.ws;
    const GAS bf16_t* Z = (const GAS bf16_t*)(ws + WS_Z);
    {
        GAS bf16_t* P = (GAS bf16_t*)(ws + WS_POOL);
        for (int e = F.blk * 512 + F.tid; e < M * 64; e += F.G * 512) {
            const int row = e >> 6, cg = e & 63, g = cg >> 4, w = 2 << g;
            int t, L; if (row < MC) { t = row & 255; L = CTXL; } else { t = (row - MC) & 2047; L = SEQ; }
            const int lo = max(t - (w >> 1), 0), hi = min(t + w - (w >> 1), L);
            float s[8] = {0.f, 0.f, 0.f, 0.f, 0.f, 0.f, 0.f, 0.f};
            for (int tt = lo; tt < hi; ++tt) { const u32x4 v = *(const GAS u32x4*)(Z + (size_t)(row - t + tt) * DIN + cg * 8);
                s[0] += bflo(v.x); s[1] += bfhi(v.x); s[2] += bflo(v.y); s[3] += bfhi(v.y); s[4] += bflo(v.z); s[5] += bfhi(v.z); s[6] += bflo(v.w); s[7] += bfhi(v.w); }
            const u32x4 sv = *(const GAS u32x4*)(Z + (size_t)row * DIN + cg * 8);
            const float inv = 1.0f / (float)(hi - lo);
            u32x4 o; o.x = pk2(s[0] * inv - bflo(sv.x), s[1] * inv - bfhi(sv.x)); o.y = pk2(s[2] * inv - bflo(sv.y), s[3] * inv - bfhi(sv.y));
            o.z = pk2(s[4] * inv - bflo(sv.z), s[5] * inv - bfhi(sv.z)); o.w = pk2(s[6] * inv - bflo(sv.w), s[7] * inv - bfhi(sv.w));
            *(GAS u32x4*)(P + (size_t)row * 512 + cg * 8) = o;
        }
    }
    {
        const GAS float* cw = ((const GAS float*)a->in[I_CONVW]) + (size_t)l * 3 * 1536; const GAS float* cb = ((const GAS float*)a->in[I_CONVB]) + (size_t)l * 1536;
        LAS bf16_t* LU = (LAS bf16_t*)F.lds; LAS bf16_t* LX = LU + 128 * 72;
        for (int it = F.blk; it < 144 * 4; it += F.G) {
            const int tile = it >> 2, c0 = (it & 3) * 128, row0 = tile * 64;
            int t0, L; GAS bf16_t *ud, *xd;
            if (row0 < MC) { const int sq = row0 >> 8; t0 = row0 & 255; L = CTXL; ud = (GAS bf16_t*)(ws + WS_UTBC) + (size_t)sq * 512 * CTXL; xd = (GAS bf16_t*)(ws + WS_X0TC) + (size_t)sq * 512 * CTXL; }
            else { const int r = row0 - MC, sq = r >> 11; t0 = r & 2047; L = SEQ; ud = (GAS bf16_t*)(ws + WS_UTBL) + (size_t)sq * 512 * SEQ; xd = (GAS bf16_t*)(ws + WS_X0TL) + (size_t)sq * 512 * SEQ; }
            __syncthreads();
#pragma unroll 1
            for (int k = 0; k < 4; ++k) {
                const int tl = (F.tid >> 5) + 16 * k, c4 = (F.tid & 31) * 4, row = row0 + tl, t = t0 + tl;
                f32x4 r3[3];
#pragma unroll
                for (int sgm = 0; sgm < 3; ++sgm) {
                    const int ch = sgm * 512 + c0 + c4; f32x4 acc = *(const GAS f32x4*)(cb + ch);
#pragma unroll
                    for (int d = 0; d < 3; ++d) { const int tt = t + d - 1;
                        if (tt >= 0 && tt < L) { const u32x2 zv = *(const GAS u32x2*)(Z + (size_t)(row + d - 1) * DIN + O_HY + ch); const f32x4 wv = *(const GAS f32x4*)(cw + d * 1536 + ch);
                            acc[0] += wv[0] * bflo(zv.x); acc[1] += wv[1] * bfhi(zv.x); acc[2] += wv[2] * bflo(zv.y); acc[3] += wv[3] * bfhi(zv.y); } }
                    r3[sgm] = acc; }
                const f32x4 uu = r3[0] * r3[2];
#pragma unroll
                for (int e = 0; e < 4; ++e) { LU[(c4 + e) * 72 + tl] = (bf16_t)f2bf(uu[e]); LX[(c4 + e) * 72 + tl] = (bf16_t)f2bf(r3[1][e]); }
            }
            __syncthreads();
            {
                const int c = F.tid >> 2, seg = F.tid & 3;
                const u32x4 u0 = *(const LAS u32x4*)(LU + c * 72 + 16 * seg), u1 = *(const LAS u32x4*)(LU + c * 72 + 16 * seg + 8);
                const u32x4 x0 = *(const LAS u32x4*)(LX + c * 72 + 16 * seg), x1 = *(const LAS u32x4*)(LX + c * 72 + 16 * seg + 8);
                GAS bf16_t* up = ud + (size_t)(c0 + c) * L + t0 + 16 * seg; GAS bf16_t* xp = xd + (size_t)(c0 + c) * L + t0 + 16 * seg;
                *(GAS u32x4*)up = u0; *(GAS u32x4*)(up + 8) = u1; *(GAS u32x4*)xp = x0; *(GAS u32x4*)(xp + 8) = x1;
            }
        }
        __syncthreads();
    }
    {
        GAS bf16_t* Zw = (GAS bf16_t*)(ws + WS_Z); GAS bf16_t* AB = (GAS bf16_t*)(ws + WS_ABUF); GAS bf16_t* BB = (GAS bf16_t*)(ws + WS_BBUF); GAS bf16_t* KT = (GAS bf16_t*)(ws + WS_KT);
        const GAS float* rope = (const GAS float*)(ws + WS_ROPE);
        LAS float* LK = (LAS float*)F.lds;
        for (int it = F.blk; it < NU * 4; it += F.G) {
            const int u = it >> 2, pg = it & 3, bh = u / 9, ci = u % 9, b = bh >> 2, h = bh & 3;
            const int row0 = chunk_row0(b, ci); const bool isctx = ci == 0;
            const float lf = ret_lg2(((const GAS float*)a->in[I_RDEC]), l, h), lb = ret_lg2(((const GAS float*)a->in[I_RDEC]), l, 4 + h);
            const int dbase = (pg & 1) * 32 + (pg >> 1) * 128, rbase = (pg >> 1) * 128;
            const int tok = F.tid >> 1, sub = F.tid & 1, dl0 = sub * 16, d1 = dbase + dl0, d2 = d1 + 64;
            const size_t zrow = (size_t)(row0 + tok) * DIN;
            float cs[16], sn[16];
            if (!isctx) { const GAS float* rp = rope + (size_t)((ci - 1) * 256 + tok) * 256 + rbase + (d1 - rbase);
#pragma unroll
                for (int e = 0; e < 16; ++e) { cs[e] = rp[e]; sn[e] = rp[64 + e]; } }
            else {
#pragma unroll
                for (int e = 0; e < 16; ++e) { cs[e] = 1.f; sn[e] = 0.f; } }
            {
                GAS bf16_t* qp = Zw + zrow + O_Q + h * 256;
                u32x4 a0 = *(const GAS u32x4*)(qp + d1), a1 = *(const GAS u32x4*)(qp + d1 + 8), b0 = *(const GAS u32x4*)(qp + d2), b1 = *(const GAS u32x4*)(qp + d2 + 8);
                const unsigned aw[8] = {a0.x, a0.y, a0.z, a0.w, a1.x, a1.y, a1.z, a1.w}, bw[8] = {b0.x, b0.y, b0.z, b0.w, b1.x, b1.y, b1.z, b1.w};
                float o1[16], o2[16];
#pragma unroll
                for (int e = 0; e < 16; ++e) { const float x1 = (e & 1) ? bfhi(aw[e >> 1]) : bflo(aw[e >> 1]), x2 = (e & 1) ? bfhi(bw[e >> 1]) : bflo(bw[e >> 1]);
                    o1[e] = x1 * cs[e] - x2 * sn[e]; o2[e] = x2 * cs[e] + x1 * sn[e]; }
                const float df = exp2f((float)(tok + 1) * lf), db = exp2f((float)(256 - tok) * lb);
                unsigned w1[8], w2[8], f1[8], f2[8], g1[8], g2[8];
#pragma unroll
                for (int e = 0; e < 8; ++e) { w1[e] = pk2(o1[2 * e], o1[2 * e + 1]); w2[e] = pk2(o2[2 * e], o2[2 * e + 1]);
                    f1[e] = pk2(o1[2 * e] * df, o1[2 * e + 1] * df); f2[e] = pk2(o2[2 * e] * df, o2[2 * e + 1] * df);
                    g1[e] = pk2(o1[2 * e] * db, o1[2 * e + 1] * db); g2[e] = pk2(o2[2 * e] * db, o2[2 * e + 1] * db); }
                *(GAS u32x4*)(qp + d1) = (u32x4){w1[0], w1[1], w1[2], w1[3]}; *(GAS u32x4*)(qp + d1 + 8) = (u32x4){w1[4], w1[5], w1[6], w1[7]};
                *(GAS u32x4*)(qp + d2) = (u32x4){w2[0], w2[1], w2[2], w2[3]}; *(GAS u32x4*)(qp + d2 + 8) = (u32x4){w2[4], w2[5], w2[6], w2[7]};
                GAS bf16_t* ap = AB + ((size_t)u * 256 + tok) * 768;
                *(GAS u32x4*)(ap + 256 + d1) = (u32x4){f1[0], f1[1], f1[2], f1[3]}; *(GAS u32x4*)(ap + 256 + d1 + 8) = (u32x4){f1[4], f1[5], f1[6], f1[7]};
                *(GAS u32x4*)(ap + 256 + d2) = (u32x4){f2[0], f2[1], f2[2], f2[3]}; *(GAS u32x4*)(ap + 256 + d2 + 8) = (u32x4){f2[4], f2[5], f2[6], f2[7]};
                *(GAS u32x4*)(ap + 512 + d1) = (u32x4){g1[0], g1[1], g1[2], g1[3]}; *(GAS u32x4*)(ap + 512 + d1 + 8) = (u32x4){g1[4], g1[5], g1[6], g1[7]};
                *(GAS u32x4*)(ap + 512 + d2) = (u32x4){g2[0], g2[1], g2[2], g2[3]}; *(GAS u32x4*)(ap + 512 + d2 + 8) = (u32x4){g2[4], g2[5], g2[6], g2[7]};
            }
            {
                GAS bf16_t* kp = Zw + zrow + O_K + h * 256;
                u32x4 a0 = *(const GAS u32x4*)(kp + d1), a1 = *(const GAS u32x4*)(kp + d1 + 8), b0 = *(const GAS u32x4*)(kp + d2), b1 = *(const GAS u32x4*)(kp + d2 + 8);
                const unsigned aw[8] = {a0.x, a0.y, a0.z, a0.w, a1.x, a1.y, a1.z, a1.w}, bw[8] = {b0.x, b0.y, b0.z, b0.w, b1.x, b1.y, b1.z, b1.w};
                float o1[16], o2[16];
#pragma unroll
                for (int e = 0; e < 16; ++e) { const float x1 = (e & 1) ? bfhi(aw[e >> 1]) : bflo(aw[e >> 1]), x2 = (e & 1) ? bfhi(bw[e >> 1]) : bflo(bw[e >> 1]);
                    o1[e] = (x1 * cs[e] - x2 * sn[e]) * 0.0625f; o2[e] = (x2 * cs[e] + x1 * sn[e]) * 0.0625f; }
                unsigned w1[8], w2[8];
#pragma unroll
                for (int e = 0; e < 8; ++e) { w1[e] = pk2(o1[2 * e], o1[2 * e + 1]); w2[e] = pk2(o2[2 * e], o2[2 * e + 1]); }
                *(GAS u32x4*)(kp + d1) = (u32x4){w1[0], w1[1], w1[2], w1[3]}; *(GAS u32x4*)(kp + d1 + 8) = (u32x4){w1[4], w1[5], w1[6], w1[7]};
                *(GAS u32x4*)(kp + d2) = (u32x4){w2[0], w2[1], w2[2], w2[3]}; *(GAS u32x4*)(kp + d2 + 8) = (u32x4){w2[4], w2[5], w2[6], w2[7]};
#pragma unroll
                for (int e = 0; e < 16; ++e) { LK[(dl0 + e) * 257 + tok] = o1[e]; LK[(32 + dl0 + e) * 257 + tok] = o2[e]; }
            }
            __syncthreads();
            {
                const int dl = F.tid & 63, seg = F.tid >> 6, dg = dl < 32 ? dbase + dl : dbase + 64 + (dl - 32);
                GAS bf16_t* kf = KT + ((size_t)u * 512 + dg) * 256 + seg * 32; GAS bf16_t* kb = KT + ((size_t)u * 512 + 256 + dg) * 256 + seg * 32;
                unsigned wf[16], wb[16];
#pragma unroll
                for (int j = 0; j < 16; ++j) { const int t0 = seg * 32 + 2 * j; const float v0 = LK[dl * 257 + t0], v1 = LK[dl * 257 + t0 + 1];
                    wf[j] = pk2(v0 * exp2f((float)(255 - t0) * lf), v1 * exp2f((float)(254 - t0) * lf));
                    wb[j] = pk2(v0 * exp2f((float)t0 * lb), v1 * exp2f((float)(t0 + 1) * lb)); }
#pragma unroll
                for (int j = 0; j < 4; ++j) { *(GAS u32x4*)(kf + 8 * j) = (u32x4){wf[4 * j], wf[4 * j + 1], wf[4 * j + 2], wf[4 * j + 3]}; *(GAS u32x4*)(kb + 8 * j) = (u32x4){wb[4 * j], wb[4 * j + 1], wb[4 * j + 2], wb[4 * j + 3]}; }
            }
            __syncthreads();
            {
                const GAS bf16_t* vp = Z + zrow + O_V + h * 256;
                u32x4 a0 = *(const GAS u32x4*)(vp + d1), a1 = *(const GAS u32x4*)(vp + d1 + 8), b0 = *(const GAS u32x4*)(vp + d2), b1 = *(const GAS u32x4*)(vp + d2 + 8);
                const unsigned aw[8] = {a0.x, a0.y, a0.z, a0.w, a1.x, a1.y, a1.z, a1.w}, bw[8] = {b0.x, b0.y, b0.z, b0.w, b1.x, b1.y, b1.z, b1.w};
#pragma unroll
                for (int e = 0; e < 16; ++e) { LK[(dl0 + e) * 257 + tok] = (e & 1) ? bfhi(aw[e >> 1]) : bflo(aw[e >> 1]); LK[(32 + dl0 + e) * 257 + tok] = (e & 1) ? bfhi(bw[e >> 1]) : bflo(bw[e >> 1]); }
            }
            __syncthreads();
            {
                const int dl = F.tid & 63, seg = F.tid >> 6, dg = dl < 32 ? dbase + dl : dbase + 64 + (dl - 32);
                GAS bf16_t* vt = BB + ((size_t)u * 256 + dg) * 768 + seg * 32;
                unsigned wv[16];
#pragma unroll
                for (int j = 0; j < 16; ++j) { const int t0 = seg * 32 + 2 * j; wv[j] = pk2(LK[dl * 257 + t0], LK[dl * 257 + t0 + 1]); }
#pragma unroll
                for (int j = 0; j < 4; ++j) *(GAS u32x4*)(vt + 8 * j) = (u32x4){wv[4 * j], wv[4 * j + 1], wv[4 * j + 2], wv[4 * j + 3]};
            }
            __syncthreads();
        }
    }
}

__device__ __forceinline__ void scan_phase(Frame& F, CArgs a, int l) {
    const GAS float* UT = (const GAS float*)(F.ws + WS_UT); GAS bf16_t* BB = (GAS bf16_t*)(F.ws + WS_BBUF);
    for (int e = F.blk * 512 + F.tid; e < 16 * 2 * 16384; e += F.G * 512) {
        const int q = e & 16383, dir = (e >> 14) & 1, bh = e >> 15, dv = q >> 6, dk4 = (q & 63) * 4, h = bh & 3;
        const float cdec = exp2f(256.0f * ret_lg2(((const GAS float*)a->in[I_RDEC]), l, dir * 4 + h));
        f32x4 S = (f32x4){0.f, 0.f, 0.f, 0.f};
#pragma unroll 1
        for (int s = 0; s < 9; ++s) {
            const int ci = dir == 0 ? s : (s == 0 ? 0 : 9 - s);
            const int u = bh * 9 + ci;
            u32x2 w; w.x = pk2(S[0], S[1]); w.y = pk2(S[2], S[3]);
            *(GAS u32x2*)(BB + ((size_t)u * 256 + dv) * 768 + 256 + dir * 256 + dk4) = w;
            const f32x4 uv = *(const GAS f32x4*)(UT + ((size_t)u * 256 + dv) * 512 + dir * 256 + dk4);
            S = S * cdec + uv;
        }
    }
}

typedef float f32x16 __attribute__((ext_vector_type(16)));
template <bool CTX>
__device__ __forceinline__ void conv_mfma(Frame& F, CArgs a, int l) {
    constexpr int NA = CTX ? 8 : 64, L = NA * 32, FLEN = 2 * L, CST = FLEN + 8, PB = CTX ? 7 : 31, UB = (2 * PB + NA) * 40, RST = CTX ? 33 : 257;
    constexpr int F8_BYTES = 8 * CST * 2, U_OFF = (F8_BYTES + 255) & ~255, U_BYTES = 4 * UB * 2, RB_OFF = CTX ? ((U_OFF + U_BYTES + 255) & ~255) : 0, RB_BYTES = CTX ? 8 * 32 * RST * 4 : 32 * RST * 4;
    static_assert(U_OFF + U_BYTES <= RING_BYTES && RB_OFF + RB_BYTES <= RING_BYTES && (CTX || RB_BYTES <= F8_BYTES), "conv LDS map");
    LAS unsigned char* lds = F.lds;
    const int tid = F.tid, lane = F.lane, wave = F.wave, r = lane & 31, h = lane >> 5;
    const GAS bf16_t* KR = CTX ? (const GAS bf16_t*)(F.ws + WS_KRC) + (size_t)l * 512 * FLEN : (const GAS bf16_t*)(F.ws + WS_KRG) + (size_t)l * 512 * FLEN;
    const GAS bf16_t* UT = (const GAS bf16_t*)(F.ws + (CTX ? WS_UTBC : WS_UTBL)); const GAS bf16_t* XT = (const GAS bf16_t*)(F.ws + (CTX ? WS_X0TC : WS_X0TL));
    GAS bf16_t* YT = (GAS bf16_t*)(F.ws + (CTX ? WS_YBTC : WS_YBTL));
    __syncthreads();
    for (int e = tid; e < U_BYTES / 16; e += 512) *(LAS u32x4*)(lds + U_OFF + e * 16) = (u32x4){0u, 0u, 0u, 0u};
    const int sA = (-r) & 7;
    const int abase = (sA * CST + L - r + 8 * h - sA) * 2;
    const int bl = CTX ? (r >> 3) : (wave & 3), al = CTX ? (r & 7) : r;
    const int bbase = U_OFF + (bl * UB + (PB + al) * 40 + 8 * h) * 2;
    LAS float* R = (LAS float*)(lds + RB_OFF);
    for (int ch = F.blk; ch < 512; ch += F.G) {
        __syncthreads();
        for (int x8 = tid; x8 < FLEN / 8; x8 += 512) {
            const GAS bf16_t* kp = KR + (size_t)ch * FLEN + x8 * 8;
            const u32x4 lo = *(const GAS u32x4*)kp; u32x4 hi = (u32x4){0u, 0u, 0u, 0u}; if (x8 + 1 < FLEN / 8) hi = *(const GAS u32x4*)(kp + 8);
            unsigned w[8] = {lo.x, lo.y, lo.z, lo.w, hi.x, hi.y, hi.z, hi.w};
            if (x8 == 0) w[0] &= 0xffff0000u;
#pragma unroll
            for (int sft = 0; sft < 8; ++sft) { u32x4 o;
                if ((sft & 1) == 0) { o.x = w[sft / 2]; o.y = w[sft / 2 + 1]; o.z = w[sft / 2 + 2]; o.w = w[sft / 2 + 3]; }
                else { const int q = sft / 2; o.x = (w[q] >> 16) | (w[q + 1] << 16); o.y = (w[q + 1] >> 16) | (w[q + 2] << 16); o.z = (w[q + 2] >> 16) | (w[q + 3] << 16); o.w = (w[q + 3] >> 16) | (w[q + 4] << 16); }
                *(LAS u32x4*)(lds + (sft * CST + x8 * 8) * 2) = o; }
        }
        if (tid < 8) *(LAS u32x4*)(lds + (tid * CST + FLEN) * 2) = (u32x4){0u, 0u, 0u, 0u};
        for (int q = tid; q < 4 * L / 8; q += 512) { const int b = q / (L / 8), qq = q % (L / 8);
            const u32x4 v = *(const GAS u32x4*)(UT + ((size_t)b * 512 + ch) * L + qq * 8);
            *(LAS u32x4*)(lds + U_OFF + (b * UB + (PB + (qq >> 2)) * 40 + (qq & 3) * 8) * 2) = v; }
        __syncthreads();
        if constexpr (CTX) {
            f32x16 acc;
#pragma unroll
            for (int e = 0; e < 16; ++e) acc[e] = 0.f;
#pragma unroll 1
            for (int q = wave; q < 2 * (2 * NA - 1); q += 8) {
                const int delta = (q >> 1) - (NA - 1), j0 = (q & 1) * 16;
                const bf16x8 af = *(const LAS bf16x8*)(lds + abase + (j0 - 32 * delta) * 2);
                const bf16x8 bf = *(const LAS bf16x8*)(lds + bbase + (j0 - 40 * delta) * 2);
                acc = __builtin_amdgcn_mfma_f32_32x32x16_bf16(af, bf, acc, 0, 0, 0);
            }
#pragma unroll
            for (int e = 0; e < 16; ++e) R[wave * 32 * RST + ((e & 3) + 8 * (e >> 2) + 4 * h) * RST + r] = acc[e];
            __syncthreads();
        } else {
            f32x16 acc0, acc1;
#pragma unroll
            for (int e = 0; e < 16; ++e) { acc0[e] = 0.f; acc1[e] = 0.f; }
            const int j0 = (wave >> 2) * 16;
            const LAS unsigned char* ap0 = lds + abase + j0 * 2; const LAS unsigned char* bp0 = lds + bbase + j0 * 2;
            {
                bf16x8 af = *(const LAS bf16x8*)(ap0 + 64 * 63), b0 = *(const LAS bf16x8*)(bp0 + 80 * 63);
#pragma unroll 1
                for (int delta = -63; delta < -31; ++delta) {
                    const int dn = delta < -32 ? delta + 1 : delta;
                    const bf16x8 naf = *(const LAS bf16x8*)(ap0 - 64 * dn), nb0 = *(const LAS bf16x8*)(bp0 - 80 * dn);
                    acc0 = __builtin_amdgcn_mfma_f32_32x32x16_bf16(af, b0, acc0, 0, 0, 0);
                    af = naf; b0 = nb0;
                }
            }
            {
                bf16x8 af = *(const LAS bf16x8*)(ap0 + 64 * 31), b0 = *(const LAS bf16x8*)(bp0 + 80 * 31), b1 = *(const LAS bf16x8*)(bp0 + 80 * 31 + 32 * 40 * 2);
#pragma unroll 1
                for (int delta = -31; delta < 32; ++delta) {
                    const int dn = delta < 31 ? delta + 1 : delta;
                    const bf16x8 naf = *(const LAS bf16x8*)(ap0 - 64 * dn), nb0 = *(const LAS bf16x8*)(bp0 - 80 * dn), nb1 = *(const LAS bf16x8*)(bp0 - 80 * dn + 32 * 40 * 2);
                    acc0 = __builtin_amdgcn_mfma_f32_32x32x16_bf16(af, b0, acc0, 0, 0, 0);
                    acc1 = __builtin_amdgcn_mfma_f32_32x32x16_bf16(af, b1, acc1, 0, 0, 0);
                    af = naf; b0 = nb0; b1 = nb1;
                }
            }
            {
                bf16x8 af = *(const LAS bf16x8*)(ap0 - 64 * 32), b1 = *(const LAS bf16x8*)(bp0 - 80 * 32 + 32 * 40 * 2);
#pragma unroll 1
                for (int delta = 32; delta < 64; ++delta) {
                    const int dn = delta < 63 ? delta + 1 : delta;
                    const bf16x8 naf = *(const LAS bf16x8*)(ap0 - 64 * dn), nb1 = *(const LAS bf16x8*)(bp0 - 80 * dn + 32 * 40 * 2);
                    acc1 = __builtin_amdgcn_mfma_f32_32x32x16_bf16(af, b1, acc1, 0, 0, 0);
                    af = naf; b1 = nb1;
                }
            }
            __syncthreads();
            const int cbase = (wave & 3) * 64 + r;
            if (wave >= 4) {
#pragma unroll
                for (int e = 0; e < 16; ++e) { const int row = (e & 3) + 8 * (e >> 2) + 4 * h; R[row * RST + cbase] = acc0[e]; R[row * RST + cbase + 32] = acc1[e]; }
            }
            __syncthreads();
            if (wave < 4) {
#pragma unroll
                for (int e = 0; e < 16; ++e) { const int row = (e & 3) + 8 * (e >> 2) + 4 * h; R[row * RST + cbase] += acc0[e]; R[row * RST + cbase + 32] += acc1[e]; }
            }
            __syncthreads();
        }
        const float hd = ((const GAS float*)a->in[I_HYD])[l * 512 + ch];
#pragma unroll 2
        for (int ck = tid; ck < 4 * L / 8; ck += 512) {
            const int b = ck / (L / 8), t0 = (ck % (L / 8)) * 8;
            const size_t off = ((size_t)b * 512 + ch) * L + t0;
            const u32x4 uw = *(const GAS u32x4*)(UT + off), xw = *(const GAS u32x4*)(XT + off);
            const unsigned uu[4] = {uw.x, uw.y, uw.z, uw.w}, xx[4] = {xw.x, xw.y, xw.z, xw.w};
            const int col = CTX ? b * 8 + (t0 >> 5) : b * 64 + (t0 >> 5), i0 = t0 & 31;
            unsigned o[4];
#pragma unroll
            for (int e = 0; e < 4; ++e) {
                float c0v = R[(i0 + 2 * e) * RST + col], c1v = R[(i0 + 2 * e + 1) * RST + col];
                if constexpr (CTX) {
#pragma unroll
                    for (int w8 = 1; w8 < 8; ++w8) { c0v += R[w8 * 32 * RST + (i0 + 2 * e) * RST + col]; c1v += R[w8 * 32 * RST + (i0 + 2 * e + 1) * RST + col]; } }
                o[e] = pk2((c0v + bflo(uu[e]) * hd) * bflo(xx[e]), (c1v + bfhi(uu[e]) * hd) * bfhi(xx[e])); }
            *(GAS u32x4*)(YT + off) = (u32x4){o[0], o[1], o[2], o[3]};
        }
    }
    __syncthreads();
}
__device__ __forceinline__ void conv_phase(Frame& F, CArgs a, int l) {
    conv_mfma<false>(F, a, l);
    if (l < DEPTH - 1) conv_mfma<true>(F, a, l);
}

__device__ __forceinline__ void gn_phase(Frame& F) {
    {
        LAS bf16_t* LT = (LAS bf16_t*)F.lds;
        GAS bf16_t* Yw = (GAS bf16_t*)(F.ws + WS_Y);
        for (int it = F.blk; it < 144 * 4; it += F.G) {
            const int tile = it >> 2, c0 = (it & 3) * 128, row0 = tile * 64;
            int t0, L; const GAS bf16_t* src;
            if (row0 < MC) { const int sq = row0 >> 8; t0 = row0 & 255; L = CTXL; src = (const GAS bf16_t*)(F.ws + WS_YBTC) + (size_t)sq * 512 * CTXL; }
            else { const int r = row0 - MC, sq = r >> 11; t0 = r & 2047; L = SEQ; src = (const GAS bf16_t*)(F.ws + WS_YBTL) + (size_t)sq * 512 * SEQ; }
            __syncthreads();
            { const int c = F.tid >> 2, seg = F.tid & 3; const GAS bf16_t* sp = src + (size_t)(c0 + c) * L + t0 + 16 * seg;
              *(LAS u32x4*)(LT + c * 72 + 16 * seg) = *(const GAS u32x4*)sp; *(LAS u32x4*)(LT + c * 72 + 16 * seg + 8) = *(const GAS u32x4*)(sp + 8); }
            __syncthreads();
#pragma unroll
            for (int k = 0; k < 4; ++k) { const int tl = (F.tid >> 5) + 16 * k, c4 = (F.tid & 31) * 4;
                const unsigned v0 = LT[(c4 + 0) * 72 + tl], v1 = LT[(c4 + 1) * 72 + tl], v2 = LT[(c4 + 2) * 72 + tl], v3 = LT[(c4 + 3) * 72 + tl];
                u32x2 w; w.x = v0 | (v1 << 16); w.y = v2 | (v3 << 16);
                *(GAS u32x2*)(Yw + (size_t)(row0 + tl) * D + 512 + c0 + c4) = w; }
        }
        __syncthreads();
    }

    const int gw = F.blk * 8 + F.wave, NGW = F.G * 8, lane = F.lane;
    const GAS float* OB = (const GAS float*)(F.ws + WS_OBUF); const GAS bf16_t* Z = (const GAS bf16_t*)(F.ws + WS_Z); GAS bf16_t* Y = (GAS bf16_t*)(F.ws + WS_Y);
    for (int it = gw; it < NU * 256; it += NGW) {
        const int u = it >> 8, tok = it & 255, bh = u / 9, ci = u % 9, b = bh >> 2, h = bh & 3;
        const size_t row = (size_t)(chunk_row0(b, ci) + tok);
        const f32x4 v = *(const GAS f32x4*)(OB + (size_t)it * 256 + lane * 4);
        const float mean = wave_sum((v[0] + v[1]) + (v[2] + v[3])) * (1.0f / 256.0f);
        const f32x4 dv = v - mean;
        const float var = wave_sum((dv[0] * dv[0] + dv[1] * dv[1]) + (dv[2] * dv[2] + dv[3] * dv[3])) * (1.0f / 256.0f);
        const float rstd = 1.0f / sqrtf(var + GN_EPS);
        const u32x2 gz = *(const GAS u32x2*)(Z + row * DIN + O_G + h * 256 + lane * 4);
        const float g0 = silu_f(bflo(gz.x)), g1 = silu_f(bfhi(gz.x)), g2 = silu_f(bflo(gz.y)), g3 = silu_f(bfhi(gz.y));
        u32x2 w; w.x = pk2(dv[0] * rstd * g0, dv[1] * rstd * g1); w.y = pk2(dv[2] * rstd * g2, dv[3] * rstd * g3);
        *(GAS u32x2*)(Y + row * D + 1024 + h * 256 + lane * 4) = w;
    }
}

__device__ __forceinline__ void ln_phase(Frame& F, CArgs a, int l, int which) {
    const int gw = F.blk * 8 + F.wave, NGW = F.G * 8, lane = F.lane;
    const GAS float* S = (const GAS float*)(F.ws + WS_S); GAS float* X = (GAS float*)(F.ws + WS_X); GAS bf16_t* XM = (GAS bf16_t*)(F.ws + WS_XM);
    const GAS float* g = (which == 0 ? ((const GAS float*)a->in[I_LN1G]) : ((const GAS float*)a->in[I_LN2G])) + (size_t)l * D; const GAS float* bb = (which == 0 ? ((const GAS float*)a->in[I_LN1B]) : ((const GAS float*)a->in[I_LN2B])) + (size_t)l * D;
    const bool last = (which == 1 && l == DEPTH - 1);
    const GAS float* mod = (const GAS float*)(F.ws + WS_MOD) + (size_t)(which == 0 ? l : (last ? l : l + 1)) * 5 * 12288 + (which == 0 ? 3 * D : 0);
    for (int row = gw; row < M; row += NGW) {
        if (last && row < MC) continue;
        const int bmod = row < MC ? 4 : ((row - MC) >> 11);
        const GAS f32x4* sr = (const GAS f32x4*)(S + (size_t)row * D);
        f32x4 v[8]; float s = 0.f;
#pragma unroll
        for (int j = 0; j < 8; ++j) v[j] = sr[lane + 64 * j];
        if (row >= 8192) {
#pragma unroll 1
            for (int p = 0; p < 7; ++p) { const GAS f32x4* pr = (const GAS f32x4*)((const GAS float*)(F.ws + WS_PB) + ((size_t)p * 1024 + (row - 8192)) * D);
#pragma unroll
                for (int j = 0; j < 8; ++j) v[j] = v[j] + pr[lane + 64 * j]; } }
#pragma unroll
        for (int j = 0; j < 8; ++j) s += (v[j][0] + v[j][1]) + (v[j][2] + v[j][3]);
        const float mean = wave_sum(s) * (1.0f / D); float q = 0.f;
#pragma unroll
        for (int j = 0; j < 8; ++j) { v[j] = v[j] - mean; q += (v[j][0] * v[j][0] + v[j][1] * v[j][1]) + (v[j][2] * v[j][2] + v[j][3] * v[j][3]); }
        const float rstd = 1.0f / sqrtf(wave_sum(q) * (1.0f / D) + LN_EPS);
        const GAS float* sh = mod + (size_t)bmod * 12288; const GAS float* sc = sh + D;
        GAS f32x4* xo = last ? (GAS f32x4*)(((GAS float*)a->out) + (size_t)(row - MC) * D) : (GAS f32x4*)(X + (size_t)row * D);
        GAS u32x2* xm = (GAS u32x2*)(XM + (size_t)row * D);
#pragma unroll
        for (int j = 0; j < 8; ++j) { const int i4 = lane + 64 * j; const f32x4 y = v[j] * rstd * ((const GAS f32x4*)g)[i4] + ((const GAS f32x4*)bb)[i4];
            xo[i4] = y;
            if (!last) { const f32x4 r = y * (((const GAS f32x4*)sc)[i4] + 1.0f) + ((const GAS f32x4*)sh)[i4]; u32x2 w; w.x = pk2(r[0], r[1]); w.y = pk2(r[2], r[3]); xm[i4] = w; } }
    }
}

struct ScoresOrder {
    const GAS char* Z; int G, c;
    __device__ __forceinline__ int nt(const pg8::Unit&, int d) const { return d; }
    __device__ __forceinline__ bool next(int i, pg8::Unit& u) const { const int L = i * G + c; if (L >= NU) return false; u.z = L; u.pm = 0; u.pn = 0; return true; }
    __device__ __forceinline__ size_t rowoff(const pg8::Unit& u) const { const int bh = u.z / 9, ci = u.z % 9; return (size_t)chunk_row0(bh >> 2, ci) * DIN + (bh & 3) * 256; }
    __device__ __forceinline__ const GAS char* aptr(const pg8::Unit& u) const { return Z + (rowoff(u) + O_Q) * 2; }
    __device__ __forceinline__ const GAS char* bptr(const pg8::Unit& u) const { return Z + (rowoff(u) + O_K) * 2; }
};
struct UtOrder {
    const GAS char* BB; const GAS char* KT; int G, c;
    __device__ __forceinline__ int nt(const pg8::Unit&, int d) const { return d; }
    __device__ __forceinline__ bool next(int i, pg8::Unit& u) const { const int L = i * G + c; if (L >= NU * 2) return false; u.z = L >> 1; u.pm = 0; u.pn = L & 1; return true; }
    __device__ __forceinline__ const GAS char* aptr(const pg8::Unit& u) const { return BB + (size_t)u.z * 256 * 768 * 2; }
    __device__ __forceinline__ const GAS char* bptr(const pg8::Unit& u) const { return KT + ((size_t)u.z * 512 + u.pn * 256) * 256 * 2; }
};
struct OutOrder {
    const GAS char* AB; const GAS char* BB; int G, c;
    __device__ __forceinline__ int nt(const pg8::Unit&, int d) const { return d; }
    __device__ __forceinline__ bool next(int i, pg8::Unit& u) const { const int L = i * G + c; if (L >= NU) return false; u.z = L; u.pm = 0; u.pn = 0; return true; }
    __device__ __forceinline__ const GAS char* aptr(const pg8::Unit& u) const { return AB + (size_t)u.z * 256 * 768 * 2; }
    __device__ __forceinline__ const GAS char* bptr(const pg8::Unit& u) const { return BB + (size_t)u.z * 256 * 768 * 2; }
};

struct MergedOrder {
    pg8::BigOrder base;
    __device__ __forceinline__ int nt(const pg8::Unit& u, int) const { return u.z == 2 ? 16 : 8; }
    __device__ __forceinline__ bool next(int i, pg8::Unit& u) const { const int z = i % 3; if (!base.next(i / 3, u)) return false; u.z = z; return true; }
    __device__ __forceinline__ const GAS char* aptr(const pg8::Unit& u) const { return base.aptr(u) + u.z * 1024; }
    __device__ __forceinline__ const GAS char* bptr(const pg8::Unit& u) const { return base.bptr(u) + u.z * 1024; }
};

constexpr int PH_PER_LAYER = 12, N_PHASES = 3 + DEPTH * PH_PER_LAYER;

__global__ void __launch_bounds__(512, 2) mk_fwd(Args args_unused) {
    extern __shared__ __attribute__((aligned(16))) unsigned char lds_raw[];
    (void)args_unused;
    CArgs ap = (CArgs)__builtin_amdgcn_kernarg_segment_ptr();
    Frame F;
    F.lds = (LAS unsigned char*)lds_raw;
    F.tid = threadIdx.x; F.lane = F.tid & 63; F.wave = __builtin_amdgcn_readfirstlane(F.tid >> 6);
    F.blk = blockIdx.x; F.G = gridDim.x; F.ws = (GAS unsigned char*)ap->ws;
    volatile LAS unsigned* MISC = (volatile LAS unsigned*)(F.lds + MISC_OFF);
    if (F.tid < 64) MISC[F.tid] = 0u;
    __syncthreads();
#if MK_PER_PHASE
#define GRID_BAR() do { } while (0)
#else
    XcdBarrier bar = xcd_barrier_post((unsigned*)(ap->ws + WS_CTL) + 4096, MISC + 8);
#define GRID_BAR() xcd_barrier(bar)
#endif
    const int lo = ap->ph_lo, hi = ap->ph_hi;
#ifndef DUPMASK
#define DUPMASK 0u
#endif
#define REP(k) _Pragma("unroll 1") for (int _r = 0; _r < (((DUPMASK >> (k)) & 1u) ? 2 : 1); ++_r)
#define IN(k) (lo <= (k) && (k) < hi)
#define SEAM(k) do { if (IN(k) && IN((k) + 1)) GRID_BAR(); } while (0)
#define LAUNDER() do { int _t = F.tid; asm volatile("" : "+v"(_t)); F.tid = _t; F.lane = _t & 63; F.wave = __builtin_amdgcn_readfirstlane(_t >> 6); \
        asm volatile("" : "+s"(ap)); GAS unsigned char* _w = (GAS unsigned char*)ap->ws; asm volatile("" : "+s"(_w)); F.ws = _w; ws = _w; } while (0)
    GAS unsigned char* ws = F.ws;

    if (IN(0)) REP(12) { LAUNDER(); pro_a(F, ap); } SEAM(0);
    if (IN(1)) REP(13) { LAUNDER(); pro_b(F, ap); } SEAM(1);
    if (IN(2)) REP(14) { LAUNDER(); pro_c(F); } SEAM(2);

#pragma unroll 1
    for (int l = 0; l < DEPTH; ++l) {
        const int p0 = 3 + l * PH_PER_LAYER;
        if (IN(p0 + 0)) REP(0) {
            LAUNDER();
            pg8::BigOrder S; S.init(ws + WS_XM, (const GAS bf16_t*)(ws + WS_WIN) + (size_t)l * DIN * D, D, D, M, DIN, F.G, F.blk);
            pg8::EpiBf16<0> E{(GAS bf16_t*)(ws + WS_Z), DIN, ((const GAS float*)ap->in[I_BIN]) + (size_t)l * DIN};
            pg8::gemm_phase<pg8::EpiBf16<0>, pg8::BigOrder, true, true>(F.lds, F.tid, pg8::Gemm{D, D, D}, S, E);
        }
        SEAM(p0 + 0);
        if (IN(p0 + 1)) { LAUNDER(); prep_phase(F, ap, l); }
        SEAM(p0 + 1);
        if (IN(p0 + 2)) REP(2) {
            {
                LAUNDER();
                pg8::BigOrder S; S.init(ws + WS_POOL, (const GAS bf16_t*)(ws + WS_WPT) + (size_t)l * 512 * 512, 512, 512, M, 512, F.G, F.blk);
                pg8::EpiBf16<0> E{(GAS bf16_t*)(ws + WS_Y), D, nullptr};
                pg8::gemm_phase<pg8::EpiBf16<0>, pg8::BigOrder, true, true>(F.lds, F.tid, pg8::Gemm{512, 512, 512}, S, E);
            }
            {
                LAUNDER();
                ScoresOrder S{(const GAS char*)(ws + WS_Z), F.G, (F.blk + 72) % F.G};
                pg8::EpiScores E{(GAS bf16_t*)(ws + WS_ABUF), ((const GAS float*)ap->in[I_RDEC]) + l * 8};
                pg8::gemm_phase<pg8::EpiScores, ScoresOrder, true, true>(F.lds, F.tid, pg8::Gemm{DIN, DIN, 256}, S, E);
            }
            {
                LAUNDER();
                UtOrder S{(const GAS char*)(ws + WS_BBUF), (const GAS char*)(ws + WS_KT), F.G, (F.blk + 216) % F.G};
                pg8::EpiF32 E{(GAS float*)(ws + WS_UT), 512, (size_t)256 * 512};
                pg8::gemm_phase<pg8::EpiF32, UtOrder, true, true>(F.lds, F.tid, pg8::Gemm{768, 256, 256}, S, E);
            }
        }
        SEAM(p0 + 2);
        if (IN(p0 + 3)) { REP(3) { LAUNDER(); scan_phase(F, ap, l); } REP(15) { LAUNDER(); conv_phase(F, ap, l); } }
        SEAM(p0 + 3);
        if (IN(p0 + 4)) REP(4) {
            LAUNDER();
            OutOrder S{(const GAS char*)(ws + WS_ABUF), (const GAS char*)(ws + WS_BBUF), F.G, F.blk};
            pg8::EpiF32 E{(GAS float*)(ws + WS_OBUF), 256, (size_t)256 * 256};
            pg8::gemm_phase<pg8::EpiF32, OutOrder, true, true>(F.lds, F.tid, pg8::Gemm{768, 768, 768}, S, E);
        }
        SEAM(p0 + 4);
        if (IN(p0 + 5)) REP(5) { LAUNDER(); gn_phase(F); }
        SEAM(p0 + 5);
        if (IN(p0 + 6)) REP(6) {
            LAUNDER();
            MergedOrder S; S.base.init(ws + WS_Y, (const GAS bf16_t*)(ws + WS_PT) + (size_t)l * D * D, D, D, M, D, F.G, F.blk);
            pg8::EpiMerged E{(const GAS bf16_t*)(ws + WS_Z), (GAS bf16_t*)(ws + WS_MG)};
            pg8::gemm_phase<pg8::EpiMerged, MergedOrder, true, true>(F.lds, F.tid, pg8::Gemm{D, D, D}, S, E);
        }
        SEAM(p0 + 6);
        if (IN(p0 + 7)) REP(7) {
            LAUNDER();
            pg8::EpiResid E{(const GAS float*)(ws + WS_X), (GAS float*)(ws + WS_S), ((const GAS float*)ap->in[I_BO]) + (size_t)l * D, (const GAS float*)(ws + WS_MOD) + (size_t)l * 5 * 12288 + 2 * D, (GAS float*)(ws + WS_PB)};
            if (F.G == 256) { pg8::SplitOrder S; S.init(ws + WS_MG, (const GAS bf16_t*)(ws + WS_WO) + (size_t)l * D * D, D, D, D, F.blk);
                pg8::gemm_phase<pg8::EpiResid, pg8::SplitOrder, true, true>(F.lds, F.tid, pg8::Gemm{D, D, D}, S, E); }
        }
        SEAM(p0 + 7);
        if (IN(p0 + 8)) REP(8) { LAUNDER(); ln_phase(F, ap, l, 0); }
        SEAM(p0 + 8);
        if (IN(p0 + 9)) REP(9) {
            LAUNDER();
            pg8::BigOrder S; S.init(ws + WS_XM, (const GAS bf16_t*)(ws + WS_W1) + (size_t)l * DFF * D, D, D, M, DFF, F.G, F.blk);
            pg8::EpiBf16<1> E{(GAS bf16_t*)(ws + WS_H), DFF, ((const GAS float*)ap->in[I_B1]) + (size_t)l * DFF};
            pg8::gemm_phase<pg8::EpiBf16<1>, pg8::BigOrder, true, true>(F.lds, F.tid, pg8::Gemm{D, D, D}, S, E);
        }
        SEAM(p0 + 9);
        if (IN(p0 + 10)) REP(10) {
            LAUNDER();
            pg8::EpiResid E{(const GAS float*)(ws + WS_X), (GAS float*)(ws + WS_S), ((const GAS float*)ap->in[I_B2]) + (size_t)l * D, (const GAS float*)(ws + WS_MOD) + (size_t)l * 5 * 12288 + 5 * D, (GAS float*)(ws + WS_PB)};
            if (F.G == 256) { pg8::SplitOrder S; S.init(ws + WS_H, (const GAS bf16_t*)(ws + WS_W2) + (size_t)l * D * DFF, DFF, DFF, DFF, F.blk);
                pg8::gemm_phase<pg8::EpiResid, pg8::SplitOrder, true, true>(F.lds, F.tid, pg8::Gemm{DFF, DFF, DFF}, S, E); }
        }
        SEAM(p0 + 10);
        if (IN(p0 + 11)) REP(11) { LAUNDER(); ln_phase(F, ap, l, 1); }
        SEAM(p0 + 11);
    }
#undef IN
#undef SEAM
#undef LAUNDER
}

extern "C" void kernel_launch(void* const* d_in, const int* in_sizes, int n_in, void* d_out, int out_size, void* d_ws, size_t ws_size, hipStream_t stream) {
    static int grid = 0;
    if (grid == 0) {
        if (n_in != 37 || out_size != ML * D || ws_size < WS_END) { fprintf(stderr, "kernel_launch: unexpected shapes (n_in %d, out %d, ws %zu)\n", n_in, out_size, ws_size); grid = -1; return; }
        int dev = 0, cus = 0, per_cu = 0;
        if (hipGetDevice(&dev) != hipSuccess || hipDeviceGetAttribute(&cus, hipDeviceAttributeMultiprocessorCount, dev) != hipSuccess) { grid = -1; return; }
        if (hipFuncSetAttribute((const void*)mk_fwd, hipFuncAttributeMaxDynamicSharedMemorySize, LDS_BYTES) != hipSuccess) { fprintf(stderr, "kernel_launch: hipFuncSetAttribute failed\n"); grid = -1; return; }
        if (hipOccupancyMaxActiveBlocksPerMultiprocessor(&per_cu, (const void*)mk_fwd, 512, LDS_BYTES) != hipSuccess || per_cu < 1) { fprintf(stderr, "kernel_launch: occupancy query says %d\n", per_cu); }
        (void)hipGetLastError();
        grid = cus;
    }
    if (grid < 0) return;
    (void)hipMemsetAsync((char*)d_ws + WS_CTL, 0, 1 * MiB, stream);
    Args a{};
    for (int i = 0; i < 37; ++i) a.in[i] = (const float*)d_in[i];
    a.out = (float*)d_out; a.ws = (unsigned char*)d_ws;
#if MK_PER_PHASE
    for (int p = 0; p < N_PHASES; ++p) { a.ph_lo = p; a.ph_hi = p + 1; hipLaunchKernelGGL(mk_fwd, dim3(grid), dim3(512), LDS_BYTES, stream, a); }
#else
    a.ph_lo = 0; a.ph_hi = N_PHASES;
    hipLaunchKernelGGL(mk_fwd, dim3(grid), dim3(512), LDS_BYTES, stream, a);
#endif
}
```

```cpp
#include <hip/hip_runtime.h>
#include <cstdio>
#include <cstdint>
#include <type_traits>

#ifndef MK_PER_PHASE
#define MK_PER_PHASE 0
#endif

#ifndef TIMEMASK
#define TIMEMASK 0u
#endif
#define TM_BEGIN(k) do { if ((TIMEMASK >> (k)) & 1u) tm_t0 = __builtin_amdgcn_s_memrealtime(); } while (0)
#define TM_END(k) do { if ((TIMEMASK >> (k)) & 1u) tm_acc += __builtin_amdgcn_s_memrealtime() - tm_t0; } while (0)
#define LAS __attribute__((address_space(3)))
#define GAS __attribute__((address_space(1)))
typedef unsigned short bf16_t;
typedef short bf16x8 __attribute__((ext_vector_type(8)));
typedef float f32x4 __attribute__((ext_vector_type(4)));
typedef float f32x2 __attribute__((ext_vector_type(2)));
typedef unsigned u32x4 __attribute__((ext_vector_type(4)));
typedef unsigned u32x2 __attribute__((ext_vector_type(2)));

constexpr int D = 2048, NB = 4, SEQ = 2048, DEPTH = 4, CTXL = 256;
constexpr int MC = NB * CTXL, ML = NB * SEQ, M = MC + ML;
constexpr int DIN = 12288, DFF = 8192;
constexpr int O_HY = 512, O_Q = 2048, O_K = 3072, O_V = 4096, O_G = 5120, O_GATE = 6144;
constexpr int NU = 144;
constexpr float LN_EPS = 1e-5f, GN_EPS = 1e-6f;
constexpr float ALPHA = 1.6817928305074290f;

constexpr size_t MiB = 1u << 20;
constexpr size_t WS_CTL = 0;
constexpr size_t WS_MOD = 1 * MiB;
constexpr size_t WS_ROPE = 2 * MiB;
constexpr size_t WS_MODP = 678 * MiB;
constexpr size_t WS_KRG = 20 * MiB;
constexpr size_t WS_KRC = 36 * MiB;
constexpr size_t WS_WPT = 56 * MiB;
constexpr size_t WS_WIN = 58 * MiB;
constexpr size_t WS_PT = 250 * MiB;
constexpr size_t WS_WO = 282 * MiB;
constexpr size_t WS_W1 = 314 * MiB;
constexpr size_t WS_W2 = 442 * MiB;
constexpr size_t WS_X = 570 * MiB;
constexpr size_t WS_XM = 642 * MiB;
constexpr size_t WS_Z = 678 * MiB;
constexpr size_t WS_H = WS_Z;
constexpr size_t WS_Y = 894 * MiB;
constexpr size_t WS_UTBL = 930 * MiB;
constexpr size_t WS_UTBC = 938 * MiB;
constexpr size_t WS_X0TL = 939 * MiB;
constexpr size_t WS_X0TC = 947 * MiB;
constexpr size_t WS_YBTL = 948 * MiB;
constexpr size_t WS_YBTC = 956 * MiB;
constexpr size_t WS_POOL = 966 * MiB;
constexpr size_t WS_ABUF = 976 * MiB;
constexpr size_t WS_BBUF = 1030 * MiB;
constexpr size_t WS_KT = 1084 * MiB;
constexpr size_t WS_UT = 1120 * MiB;
constexpr size_t WS_PB = WS_UT;
constexpr size_t WS_OBUF = 1192 * MiB;
constexpr size_t WS_MGF = 1228 * MiB;
constexpr size_t WS_S = WS_MGF;
constexpr size_t WS_MG = 1300 * MiB;
constexpr size_t WS_QR = 1336 * MiB;
constexpr size_t WS_KRB = 1354 * MiB;
constexpr size_t WS_END = 1372 * MiB;

constexpr int RING_BYTES = 131072;
constexpr int MISC_OFF = 147200;
constexpr int LDS_BYTES = 147456;

#define RLX_AGENT __ATOMIC_RELAXED, __HIP_MEMORY_SCOPE_AGENT
#define LDS_WAIT() asm volatile("s_waitcnt lgkmcnt(0)" ::: "memory")
#define VM_WAIT() asm volatile("s_waitcnt vmcnt(0)" ::: "memory")

__device__ __forceinline__ unsigned f2bf(float f) { unsigned u = __builtin_bit_cast(unsigned, f); return (u + 0x7fffu + ((u >> 16) & 1u)) >> 16; }
__device__ __forceinline__ unsigned pk2(float lo, float hi) { return f2bf(lo) | (f2bf(hi) << 16); }
__device__ __forceinline__ float bflo(unsigned w) { return __builtin_bit_cast(float, w << 16); }
__device__ __forceinline__ float bfhi(unsigned w) { return __builtin_bit_cast(float, w & 0xffff0000u); }
typedef short v4i16_t __attribute__((ext_vector_type(4)));
__device__ __forceinline__ u32x2 ds_tr16(const LAS unsigned char* p) { return __builtin_bit_cast(u32x2, __builtin_amdgcn_ds_read_tr16_b64_v4i16((LAS v4i16_t*)p)); }
__device__ __forceinline__ float bf1(bf16_t h) { return __builtin_bit_cast(float, ((unsigned)h) << 16); }

namespace pg8 {
constexpr int BM = 256, BK = 64, HALF = 128, HTB = HALF * BK * 2, STAGE_BYTES = 8 * HTB, NXCD = 8, WGM = 8;
__host__ __device__ __forceinline__ int lds_byte(int r, int c) { const int st = (r >> 4) * 2 + (c >> 5), rr = r & 15, cc = c & 31, ob = rr * 64 + cc * 2; return st * 1024 + (ob ^ (((ob >> 9) & 1) << 5)); }
__host__ __device__ __forceinline__ void stage_rc(int b, int& R, int& C) { const int st = b / 1024, sb = b % 1024, swz = sb ^ (((sb >> 9) & 1) << 5); R = (st >> 1) * 16 + swz / 64; C = (st & 1) * 32 + (swz % 64) / 2; }
__host__ __device__ __forceinline__ int perm32(int rho) { const int n = rho >> 4, i = rho & 15; return 8 * (i >> 2) + 4 * n + (i & 3); }

struct Unit { int pm, pn, z; };
struct Gemm { int lda, ldb, K; };

__device__ __forceinline__ unsigned cvt_pk_bf16(float lo, float hi) { unsigned r; asm volatile("v_cvt_pk_bf16_f32 %0, %1, %2" : "=v"(r) : "v"(lo), "v"(hi)); return r; }

struct BigOrder {
    const GAS char* A; const GAS char* B; size_t astep, bstep; int nM, nN, nwg, G, c;
    __device__ __forceinline__ void init(const GAS void* A_, const GAS void* B_, int lda, int ldb, int M_, int N_, int G_, int c_) {
        A = (const GAS char*)A_; B = (const GAS char*)B_; astep = (size_t)BM * lda * 2; bstep = (size_t)BM * ldb * 2; nM = M_ / BM; nN = N_ / BM; nwg = nM * nN; G = G_; c = c_; }
    __device__ __forceinline__ bool next(int i, Unit& u) const {
        const long L = (long)i * G + c; if (L >= nwg) return false;
        int wgid = (int)L; { const int q = nwg / NXCD, r = nwg % NXCD, xcd = wgid % NXCD, off = wgid / NXCD; wgid = (xcd < r ? xcd * (q + 1) : r * (q + 1) + (xcd - r) * q) + off; }
        const int nig = WGM * nN, gid = wgid / nig, fm = gid * WGM, gsz = (nM - fm) < WGM ? (nM - fm) : WGM;
        u.pm = fm + ((wgid % nig) % gsz); u.pn = (wgid % nig) / gsz; u.z = 0; return true;
    }
    __device__ __forceinline__ int nt(const Unit&, int d) const { return d; }
    __device__ __forceinline__ const GAS char* aptr(const Unit& u) const { return A + (size_t)u.pm * astep; }
    __device__ __forceinline__ const GAS char* bptr(const Unit& u) const { return B + (size_t)u.pn * bstep; }
};

template <class Epi, class Sched, bool ALIGN_EPI, bool SP2>
__device__ __forceinline__ void gemm_phase(LAS unsigned char* lds, const int tid, const Gemm g, const Sched& S, const Epi& E) {
    const int wid = __builtin_amdgcn_readfirstlane(tid >> 6), lane = tid & 63, wr = wid >> 2, wc = wid & 3, fr = lane & 15, fq = lane >> 4;
    const int nt0 = g.K / BK;
    unsigned voffA[2], voffB[2];
#pragma unroll
    for (int i = 0; i < 2; ++i) { int R, C; stage_rc(tid * 16 + i * 8192, R, C); const int Rb = Epi::PERM ? ((R & ~31) + perm32(R & 31)) : R;
        voffA[i] = (unsigned)(R * g.lda + C) * 2u; voffB[i] = (unsigned)(Rb * g.ldb + C) * 2u; }
    const size_t kstep = (size_t)(BK * 2);
    const size_t hstepA = (size_t)HALF * g.lda * 2, hstepB = (size_t)HALF * g.ldb * 2;
    const unsigned ldsw = (unsigned)wid * 1024u;
    const int aoff = lds_byte(wr * 64 + fr, fq * 8), boff = lds_byte(wc * 32 + fr, fq * 8);
#define PG8_SA(b, h) (((b) * 2 + (h)) * HTB)
#define PG8_SB(b, h) ((4 + (b) * 2 + (h)) * HTB)
#define PG8_STAGE(bufoff, gbase, voff) do { _Pragma("unroll") for (int _i = 0; _i < 2; ++_i) \
        __builtin_amdgcn_global_load_lds((const GAS unsigned*)((const GAS char*)(gbase) + (voff)[_i]), (LAS unsigned*)(lds + (bufoff) + ldsw + _i * 8192), 16, 0, 0); } while (0)
#define PG8_LDA(dst, b, h) do { _Pragma("unroll") for (int m = 0; m < 4; ++m) _Pragma("unroll") for (int k = 0; k < 2; ++k) dst[m][k] = *(const LAS bf16x8*)(lds + PG8_SA(b, h) + aoff + m * 2048 + k * 1024); } while (0)
#define PG8_LDB(dst, b, h) do { _Pragma("unroll") for (int n = 0; n < 2; ++n) _Pragma("unroll") for (int k = 0; k < 2; ++k) dst[n][k] = *(const LAS bf16x8*)(lds + PG8_SB(b, h) + boff + n * 2048 + k * 1024); } while (0)
#define PG8_MMA(ai, bj, At, Bt) do { __builtin_amdgcn_s_setprio(1); _Pragma("unroll") for (int m = 0; m < 4; ++m) _Pragma("unroll") for (int n = 0; n < 2; ++n) _Pragma("unroll") for (int k = 0; k < 2; ++k) \
        acc[ai][bj][m][n] = __builtin_amdgcn_mfma_f32_16x16x32_bf16(Bt[n][k], At[m][k], acc[ai][bj][m][n], 0, 0, 0); __builtin_amdgcn_s_setprio(0); } while (0)
#define PG8_WAIT_V(n) asm volatile("s_waitcnt vmcnt(" #n ")" ::: "memory")
#define PG8_WAIT_L(n) asm volatile("s_waitcnt lgkmcnt(" #n ")" ::: "memory")
#define PG8_BAR __builtin_amdgcn_s_barrier()
#define PG8_SCHED __builtin_amdgcn_sched_barrier(0)
    Unit cur, nxt; int ui = 0;
    if (!S.next(0, cur)) return;
    f32x4 acc[2][2][4][2];
#pragma unroll
    for (int a = 0; a < 2; ++a)
#pragma unroll
        for (int b = 0; b < 2; ++b)
#pragma unroll
            for (int m = 0; m < 4; ++m)
#pragma unroll
                for (int n = 0; n < 2; ++n) acc[a][b][m][n] = (f32x4){0.f, 0.f, 0.f, 0.f};
    bf16x8 At[4][2], B0[2][2], B1[2][2];
    const GAS char* cA = S.aptr(cur); const GAS char* cB = S.bptr(cur);
    if constexpr (SP2) {
        PG8_STAGE(PG8_SB(0, 0), cB, voffB); PG8_STAGE(PG8_SB(0, 1), cB + hstepB, voffB); PG8_STAGE(PG8_SA(0, 0), cA, voffA); PG8_STAGE(PG8_SA(0, 1), cA + hstepA, voffA);
        if (wr == 1) PG8_BAR;
        PG8_WAIT_V(2); PG8_BAR;
        PG8_STAGE(PG8_SB(1, 0), cB + kstep, voffB); PG8_STAGE(PG8_SA(1, 0), cA + kstep, voffA); PG8_STAGE(PG8_SB(1, 1), cB + hstepB + kstep, voffB);
        PG8_WAIT_V(6); PG8_BAR;
    } else {
        PG8_STAGE(PG8_SB(0, 0), cB, voffB); PG8_STAGE(PG8_SA(0, 0), cA, voffA); PG8_STAGE(PG8_SB(0, 1), cB + hstepB, voffB); PG8_STAGE(PG8_SA(0, 1), cA + hstepA, voffA);
        if (wr == 1) PG8_BAR;
        PG8_WAIT_V(4); PG8_BAR;
        PG8_STAGE(PG8_SB(1, 0), cB + kstep, voffB); PG8_STAGE(PG8_SA(1, 0), cA + kstep, voffA); PG8_STAGE(PG8_SB(1, 1), cB + hstepB + kstep, voffB);
        PG8_WAIT_V(6); PG8_BAR;
    }
    for (;;) {
        const bool has_next = S.next(ui + 1, nxt);
        const int nt = S.nt(cur, nt0);
        const GAS char* nA = has_next ? S.aptr(nxt) : cA; const GAS char* nB = has_next ? S.bptr(nxt) : cB;
#pragma unroll 1
        for (int t = 0; t < nt; t += 2) {
            const bool last = (t == nt - 2);
            const GAS char* a1 = cA + (size_t)(t + 1) * kstep;
            const GAS char* a2 = last ? nA : cA + (size_t)(t + 2) * kstep; const GAS char* b2 = last ? nB : cB + (size_t)(t + 2) * kstep;
            const GAS char* a3 = a2 + kstep; const GAS char* b3 = b2 + kstep;
            if constexpr (SP2) {
            PG8_LDB(B0, 0, 0); PG8_LDB(B1, 0, 1); PG8_SCHED; PG8_LDA(At, 0, 0); PG8_STAGE(PG8_SA(1, 1), a1 + hstepA, voffA);
            PG8_WAIT_V(8); PG8_WAIT_L(0); PG8_BAR; PG8_MMA(0, 0, At, B0); PG8_MMA(0, 1, At, B1); PG8_BAR; PG8_SCHED;
            PG8_LDA(At, 0, 1); PG8_STAGE(PG8_SB(0, 0), b2, voffB); PG8_STAGE(PG8_SB(0, 1), b2 + hstepB, voffB); PG8_STAGE(PG8_SA(0, 0), a2, voffA);
            PG8_WAIT_V(8); PG8_WAIT_L(0); PG8_BAR; PG8_MMA(1, 0, At, B0); PG8_MMA(1, 1, At, B1); PG8_BAR; PG8_SCHED;
            PG8_LDB(B0, 1, 0); PG8_LDB(B1, 1, 1); PG8_SCHED; PG8_LDA(At, 1, 0); PG8_STAGE(PG8_SA(0, 1), a2 + hstepA, voffA);
            PG8_WAIT_V(8); PG8_WAIT_L(0); PG8_BAR; PG8_MMA(0, 0, At, B0); PG8_MMA(0, 1, At, B1); PG8_BAR; PG8_SCHED;
            PG8_LDA(At, 1, 1); PG8_STAGE(PG8_SB(1, 0), b3, voffB); PG8_STAGE(PG8_SB(1, 1), b3 + hstepB, voffB); PG8_STAGE(PG8_SA(1, 0), a3, voffA);
            PG8_WAIT_V(8); PG8_WAIT_L(0); PG8_BAR; PG8_MMA(1, 0, At, B0); PG8_MMA(1, 1, At, B1); PG8_BAR; PG8_SCHED;
            } else {
            PG8_LDB(B0, 0, 0); PG8_SCHED; PG8_LDA(At, 0, 0); PG8_STAGE(PG8_SA(1, 1), a1 + hstepA, voffA);
            PG8_WAIT_L(8); PG8_BAR; PG8_WAIT_L(0); PG8_MMA(0, 0, At, B0); PG8_BAR; PG8_SCHED;
            PG8_LDB(B1, 0, 1); PG8_STAGE(PG8_SB(0, 0), b2, voffB);
            PG8_BAR; PG8_WAIT_L(0); PG8_MMA(0, 1, At, B1); PG8_BAR;
            PG8_LDA(At, 0, 1); PG8_STAGE(PG8_SA(0, 0), a2, voffA);
            PG8_BAR; PG8_WAIT_L(0); PG8_MMA(1, 0, At, B0); PG8_BAR; PG8_SCHED;
            PG8_STAGE(PG8_SB(0, 1), b2 + hstepB, voffB);
            PG8_WAIT_V(6); PG8_BAR; PG8_MMA(1, 1, At, B1); PG8_BAR;
            PG8_LDB(B0, 1, 0); PG8_SCHED; PG8_LDA(At, 1, 0); PG8_STAGE(PG8_SA(0, 1), a2 + hstepA, voffA);
            PG8_WAIT_L(8); PG8_BAR; PG8_WAIT_L(0); PG8_MMA(0, 0, At, B0); PG8_BAR; PG8_SCHED;
            PG8_LDB(B1, 1, 1); PG8_STAGE(PG8_SB(1, 0), b3, voffB);
            PG8_BAR; PG8_WAIT_L(0); PG8_MMA(0, 1, At, B1); PG8_BAR;
            PG8_LDA(At, 1, 1); PG8_STAGE(PG8_SA(1, 0), a3, voffA);
            PG8_BAR; PG8_WAIT_L(0); PG8_MMA(1, 0, At, B0); PG8_BAR; PG8_SCHED;
            PG8_STAGE(PG8_SB(1, 1), b3 + hstepB, voffB);
            PG8_WAIT_V(6); PG8_BAR; PG8_MMA(1, 1, At, B1); PG8_BAR;
            }
        }
        if constexpr (ALIGN_EPI) { if (wr == 0) PG8_BAR; }
        E(acc, cur, wr, wc, fr, fq);
        if (!has_next) break;
        bool rst = true; if constexpr (Epi::KEEPS) rst = E.reset(cur);
        if (rst) {
#pragma unroll
        for (int a = 0; a < 2; ++a)
#pragma unroll
            for (int b = 0; b < 2; ++b)
#pragma unroll
                for (int m = 0; m < 4; ++m)
#pragma unroll
                    for (int n = 0; n < 2; ++n) acc[a][b][m][n] = (f32x4){0.f, 0.f, 0.f, 0.f};
        }
        cur = nxt; cA = nA; cB = nB; ++ui;
        if constexpr (ALIGN_EPI) { if (wr == 1) PG8_BAR; }
    }
    PG8_WAIT_V(0);
    if constexpr (!ALIGN_EPI) { if (wr == 0) PG8_BAR; }
    PG8_BAR;
#undef PG8_SA
#undef PG8_SB
#undef PG8_STAGE
#undef PG8_LDA
#undef PG8_LDB
#undef PG8_MMA
#undef PG8_WAIT_V
#undef PG8_WAIT_L
#undef PG8_BAR
#undef PG8_SCHED
}


template <int ACT> struct EpiBf16 {
    static constexpr bool PERM = true; static constexpr bool KEEPS = false;
    GAS bf16_t* O; int ldc; const GAS float* bias;
    __device__ __forceinline__ void operator()(const f32x4 (&acc)[2][2][4][2], const Unit& u, int wr, int wc, int fr, int fq) const {
        const int row0 = u.pm * BM + wr * 64 + fr, col0 = u.pn * BM + wc * 32 + 8 * fq;
        f32x4 bv[2][2];
#pragma unroll
        for (int bj = 0; bj < 2; ++bj)
#pragma unroll
            for (int n = 0; n < 2; ++n) bv[bj][n] = bias ? *(const GAS f32x4*)(bias + col0 + bj * HALF + 4 * n) : (f32x4){0.f, 0.f, 0.f, 0.f};
#pragma unroll
        for (int ai = 0; ai < 2; ++ai)
#pragma unroll
            for (int m = 0; m < 4; ++m) { GAS bf16_t* rowp = O + (size_t)(row0 + ai * HALF + m * 16) * ldc + col0;
#pragma unroll
                for (int bj = 0; bj < 2; ++bj) { f32x4 v0 = acc[ai][bj][m][0] + bv[bj][0], v1 = acc[ai][bj][m][1] + bv[bj][1];
                    if (ACT == 1) {
#pragma unroll
                        for (int j = 0; j < 4; ++j) { const float a = fmaxf(v0[j], 0.f), b = fmaxf(v1[j], 0.f); v0[j] = a * a; v1[j] = b * b; } }
                    u32x4 w; w.x = cvt_pk_bf16(v0[0], v0[1]); w.y = cvt_pk_bf16(v0[2], v0[3]); w.z = cvt_pk_bf16(v1[0], v1[1]); w.w = cvt_pk_bf16(v1[2], v1[3]);
                    *(GAS u32x4*)(rowp + bj * HALF) = w; } }
    }
};
struct EpiScores {
    static constexpr bool PERM = true; static constexpr bool KEEPS = false;
    GAS bf16_t* O; const GAS float* rdec;
    __device__ __forceinline__ void operator()(const f32x4 (&acc)[2][2][4][2], const Unit& u, int wr, int wc, int fr, int fq) const {
        const int h = (u.z / 9) & 3; const float lf = log1pf(-expf(rdec[h])) * 1.4426950408889634f, lb = log1pf(-expf(rdec[4 + h])) * 1.4426950408889634f;
        GAS bf16_t* base = O + (size_t)u.z * 256 * 768 + (size_t)(wr * 64 + fr) * 768 + wc * 32 + 8 * fq;
        float d00 = (float)(wr * 64 + fr - wc * 32 - 8 * fq);
        asm volatile("" : "+v"(d00));
#pragma unroll
        for (int ai = 0; ai < 2; ++ai)
#pragma unroll
            for (int m = 0; m < 4; ++m) {
#pragma unroll
                for (int bj = 0; bj < 2; ++bj) { float v[8];
#pragma unroll
                    for (int n = 0; n < 2; ++n)
#pragma unroll
                        for (int e = 0; e < 4; ++e) { const float d = d00 + (float)(ai * HALF + m * 16 - bj * HALF - 4 * n - e);
                            const float dp = fmaxf(d, 0.f), dn = fmaxf(-d, 0.f);
                            const float mk = __builtin_amdgcn_exp2f(dp * lf + dn * lb) + (1.0f - fminf(dp + dn, 1.0f));
                            v[4 * n + e] = acc[ai][bj][m][n][e] * mk; }
                    u32x4 w; w.x = cvt_pk_bf16(v[0], v[1]); w.y = cvt_pk_bf16(v[2], v[3]); w.z = cvt_pk_bf16(v[4], v[5]); w.w = cvt_pk_bf16(v[6], v[7]);
                    *(GAS u32x4*)(base + (size_t)(ai * HALF + m * 16) * 768 + bj * HALF) = w; }
                asm volatile("" ::: "memory"); }
    }
};
struct EpiF32 {
    static constexpr bool PERM = false; static constexpr bool KEEPS = false;
    GAS float* C; int ldc; size_t zstride;
    __device__ __forceinline__ void operator()(const f32x4 (&acc)[2][2][4][2], const Unit& u, int wr, int wc, int fr, int fq) const {
        const int row0 = u.pm * BM + wr * 64 + fr, col0 = u.pn * BM + wc * 32 + 4 * fq; GAS float* Cz = C + (size_t)u.z * zstride;
#pragma unroll
        for (int ai = 0; ai < 2; ++ai)
#pragma unroll
            for (int m = 0; m < 4; ++m) { GAS float* rowp = Cz + (size_t)(row0 + ai * HALF + m * 16) * ldc + col0;
#pragma unroll
                for (int bj = 0; bj < 2; ++bj)
#pragma unroll
                    for (int n = 0; n < 2; ++n) *(GAS f32x4*)(rowp + bj * HALF + n * 16) = acc[ai][bj][m][n]; }
    }
};
struct EpiMerged {
    static constexpr bool PERM = true; static constexpr bool KEEPS = true;
    const GAS bf16_t* Z; GAS bf16_t* MG;
    __device__ __forceinline__ bool reset(const Unit& u) const { return u.z == 2; }
    __device__ __forceinline__ void operator()(f32x4 (&acc)[2][2][4][2], const Unit& u, int wr, int wc, int fr, int fq) const {
        int row0 = u.pm * BM + wr * 64 + fr, col0 = u.pn * BM + wc * 32 + 8 * fq;
        const bool fin = u.z == 2;
        const int offn = O_GATE + u.z * D, offd = O_GATE + (fin ? 2 : u.z + 1) * D;
#pragma unroll
        for (int ai = 0; ai < 2; ++ai)
#pragma unroll
            for (int m = 0; m < 4; ++m) { int rowi = row0 + ai * HALF + m * 16; asm volatile("" : "+v"(rowi)); const size_t row = (size_t)rowi;
#pragma unroll
                for (int bj = 0; bj < 2; ++bj) { const int col = col0 + bj * HALF;
                    const GAS bf16_t* zp = Z + row * DIN + col;
                    const u32x4 zn = *(const GAS u32x4*)(zp + offn), zd = *(const GAS u32x4*)(zp + offd);
                    const unsigned nn[4] = {zn.x, zn.y, zn.z, zn.w}, dd[4] = {zd.x, zd.y, zd.z, zd.w};
                    float f[8];
#pragma unroll
                    for (int e = 0; e < 4; ++e) {
                        const float n0 = __builtin_amdgcn_rcpf(1.0f + __expf(-bflo(nn[e]))), n1 = __builtin_amdgcn_rcpf(1.0f + __expf(-bfhi(nn[e])));
                        const float d0 = fin ? 1.0f : 1.0f + __expf(-bflo(dd[e])), d1 = fin ? 1.0f : 1.0f + __expf(-bfhi(dd[e]));
                        f[2 * e] = n0 * d0; f[2 * e + 1] = n1 * d1; }
#pragma unroll
                    for (int n = 0; n < 2; ++n)
#pragma unroll
                        for (int e = 0; e < 4; ++e) acc[ai][bj][m][n][e] *= f[4 * n + e];
                    if (fin) { u32x4 w; w.x = cvt_pk_bf16(acc[ai][bj][m][0][0], acc[ai][bj][m][0][1]); w.y = cvt_pk_bf16(acc[ai][bj][m][0][2], acc[ai][bj][m][0][3]);
                        w.z = cvt_pk_bf16(acc[ai][bj][m][1][0], acc[ai][bj][m][1][1]); w.w = cvt_pk_bf16(acc[ai][bj][m][1][2], acc[ai][bj][m][1][3]);
                        *(GAS u32x4*)(MG + row * D + col) = w; } }
                asm volatile("" ::: "memory"); }
    }
};
struct EpiResid {
    static constexpr bool PERM = false; static constexpr bool KEEPS = false;
    const GAS float* X; GAS float* S; const GAS float* bias; const GAS float* gate; GAS float* PB;
    __device__ __forceinline__ void operator()(const f32x4 (&acc)[2][2][4][2], const Unit& u, int wr, int wc, int fr, int fq) const {
        const int row0 = u.pm * BM + wr * 64 + fr, col0 = u.pn * BM + wc * 32 + 4 * fq;
        const int bmod = u.pm < 4 ? 4 : ((u.pm - 4) >> 3);
        const GAS float* gp = gate + (size_t)bmod * 12288;
        f32x4 bv[2][2], gv[2][2];
#pragma unroll
        for (int bj = 0; bj < 2; ++bj)
#pragma unroll
            for (int n = 0; n < 2; ++n) { bv[bj][n] = *(const GAS f32x4*)(bias + col0 + bj * HALF + n * 16); gv[bj][n] = *(const GAS f32x4*)(gp + col0 + bj * HALF + n * 16); }
        if (u.z == 0) {
#pragma unroll
            for (int ai = 0; ai < 2; ++ai)
#pragma unroll
                for (int m = 0; m < 4; ++m) { const size_t off = (size_t)(row0 + ai * HALF + m * 16) * D + col0;
#pragma unroll
                    for (int bj = 0; bj < 2; ++bj)
#pragma unroll
                        for (int n = 0; n < 2; ++n) { const f32x4 xv = *(const GAS f32x4*)(X + off + bj * HALF + n * 16);
                            *(GAS f32x4*)(S + off + bj * HALF + n * 16) = xv * ALPHA + gv[bj][n] * (acc[ai][bj][m][n] + bv[bj][n]); } }
        } else {
            GAS float* pb = PB + (size_t)(u.z - 1) * 1024 * D;
#pragma unroll
            for (int ai = 0; ai < 2; ++ai)
#pragma unroll
                for (int m = 0; m < 4; ++m) { const size_t off = (size_t)(row0 - 8192 + ai * HALF + m * 16) * D + col0;
#pragma unroll
                    for (int bj = 0; bj < 2; ++bj)
#pragma unroll
                        for (int n = 0; n < 2; ++n) *(GAS f32x4*)(pb + off + bj * HALF + n * 16) = gv[bj][n] * acc[ai][bj][m][n]; }
        }
    }
};
struct SplitOrder {
    const GAS char* A; const GAS char* B; size_t astep, bstep; int c, nt_full;
    __device__ __forceinline__ void init(const GAS void* A_, const GAS void* B_, int lda, int ldb, int K, int c_) {
        A = (const GAS char*)A_; B = (const GAS char*)B_; astep = (size_t)BM * lda * 2; bstep = (size_t)BM * ldb * 2; c = c_; nt_full = K / BK; }
    __device__ __forceinline__ bool next(int i, Unit& u) const {
        const int x = c & 7, j = c >> 3;
        if (i == 0) { u.pm = x * 4 + (j >> 3); u.pn = j & 7; u.z = 0; return true; }
        if (i == 1) { u.pm = 32 + (j >> 3); u.pn = j & 7; u.z = x; return true; }
        return false;
    }
    __device__ __forceinline__ int nt(const Unit& u, int) const { return u.pm < 32 ? nt_full : nt_full / 8; }
    __device__ __forceinline__ size_t koff(const Unit& u) const { return u.pm < 32 ? 0 : (size_t)u.z * (nt_full / 8) * BK * 2; }
    __device__ __forceinline__ const GAS char* aptr(const Unit& u) const { return A + (size_t)u.pm * astep + koff(u); }
    __device__ __forceinline__ const GAS char* bptr(const Unit& u) const { return B + (size_t)u.pn * bstep + koff(u); }
};
}

#define XB_TMO      128
#define XB_XCNT(j)  (256  + 64 * (j))
#define XB_XSUB(j)  (1280 + 64 * (j))
#define XB_XGEN(j)  (2304 + 64 * (j))
#define XB_TOP      3328
#define XB_TOPGEN   3392
#define XCD_BAR_WORDS 3456
#define XB_SPIN_CAP (1u << 22)

__device__ __forceinline__ unsigned xb_ld(unsigned* p)              { return __hip_atomic_load(p, __ATOMIC_RELAXED, __HIP_MEMORY_SCOPE_AGENT); }
__device__ __forceinline__ unsigned xb_add(unsigned* p, unsigned v) { return __hip_atomic_fetch_add(p, v, __ATOMIC_RELAXED, __HIP_MEMORY_SCOPE_AGENT); }
__device__ __forceinline__ unsigned xb_xcc_id() { return (unsigned)__builtin_amdgcn_s_getreg((3 << 11) | 20) & 0xFu; }
#define XB_SPIN(cond, bar) do { unsigned _sp = 0; while (cond) { __builtin_amdgcn_s_sleep(1); \
    if ((++_sp & 255u) == 0u) { if (xb_ld(&(bar)[XB_TMO])) break; if (_sp > XB_SPIN_CAP) { atomicAdd(&(bar)[XB_TMO], 1u); break; } } } } while (0)

struct XcdBarrier { unsigned* bar; unsigned x; volatile LAS unsigned* st; };

__device__ __forceinline__ XcdBarrier xcd_barrier_post(unsigned* bar, volatile LAS unsigned* st) {
    XcdBarrier b; b.bar = bar; b.x = xb_xcc_id(); b.st = st;
    if (threadIdx.x == 0) (void)xb_add(&bar[XB_XCNT(b.x)], 1u);
    return b;
}
__device__ __forceinline__ void xcd_barrier_complete(unsigned* bar, unsigned x, unsigned& nloc, unsigned& nx) {
    const unsigned G = gridDim.x * gridDim.y * gridDim.z;
    unsigned sum, cnt, mine, sp = 0u;
    for (;;) {
        sum = 0u; cnt = 0u; mine = 0u;
#pragma unroll
        for (unsigned j = 0; j < 16; ++j) { const unsigned c = xb_ld(&bar[XB_XCNT(j)]); sum += c; cnt += (c > 0u) ? 1u : 0u; mine = (j == x) ? c : mine; }
        if (sum == G) break;
        __builtin_amdgcn_s_sleep(1);
        if ((++sp & 255u) == 0u) { if (xb_ld(&bar[XB_TMO])) break; if (sp > XB_SPIN_CAP) { atomicAdd(&bar[XB_TMO], 1u); break; } }
    }
    nloc = mine > 0u ? mine : 1u; nx = cnt > 0u ? cnt : 1u;
}
__device__ __forceinline__ void xcd_barrier(const XcdBarrier& b) {
    asm volatile("s_waitcnt vmcnt(0)" ::: "memory");
    __syncthreads();
    if (threadIdx.x == 0) {
        unsigned* bar = b.bar;
        __builtin_amdgcn_s_waitcnt(0);
        unsigned nloc = b.st[0], nx = b.st[1];
        if (nloc == 0u) { xcd_barrier_complete(bar, b.x, nloc, nx); b.st[0] = nloc; b.st[1] = nx; }
        const unsigned old = xb_add(&bar[XB_XSUB(b.x)], 1u);
        const unsigned gen = old / nloc;
        if (old + 1u == (gen + 1u) * nloc) {
            __builtin_amdgcn_fence(__ATOMIC_RELEASE, "agent");
            asm volatile("s_waitcnt vmcnt(0)" ::: "memory");
            const unsigned og = xb_add(&bar[XB_TOP], 1u);
            const unsigned tg = og / nx;
            if (og + 1u == (tg + 1u) * nx) xb_add(&bar[XB_TOPGEN], 1u);
            else XB_SPIN(xb_ld(&bar[XB_TOPGEN]) == tg, bar);
            __builtin_amdgcn_fence(__ATOMIC_ACQUIRE, "agent");
            xb_add(&bar[XB_XGEN(b.x)], 1u);
            asm volatile("s_waitcnt vmcnt(0)" ::: "memory");
        } else {
            XB_SPIN(xb_ld(&bar[XB_XGEN(b.x)]) == gen, bar);
            __builtin_amdgcn_fence(__ATOMIC_ACQUIRE, "agent");
            asm volatile("s_waitcnt vmcnt(0)" ::: "memory");
        }
    }
    __syncthreads();
}

struct Args { const float* in[37]; float* out; unsigned char* ws; int ph_lo, ph_hi; };
typedef const __attribute__((address_space(4))) Args* CArgs;
enum { I_X = 0, I_C, I_CTX, I_CCTX, I_WADA, I_BADA, I_WIN, I_BIN, I_CONVW, I_CONVB, I_POOLW, I_POOLS, I_FW1, I_FB1, I_FF1, I_FW2, I_FB2, I_FF2, I_FW3, I_FB3, I_FF3, I_FW4,
       I_HYD, I_RDEC, I_PA, I_PB, I_PC, I_WO, I_BO, I_LN1G, I_LN1B, I_W1, I_B1, I_W2, I_B2, I_LN2G, I_LN2B };

struct Frame {
    LAS unsigned char* lds;
    int tid, lane, wave, blk, G;
    GAS unsigned char* ws;
};

__device__ __forceinline__ float wave_sum(float v) {
#pragma unroll
    for (int o = 1; o < 64; o <<= 1) v += __shfl_xor(v, o);
    return v;
}
__device__ __forceinline__ float silu_f(float v) { return v / (1.0f + __expf(-v)); }
__device__ __forceinline__ int chunk_row0(int b, int ci) { return ci == 0 ? b * CTXL : MC + b * SEQ + (ci - 1) * 256; }
__device__ __forceinline__ float ret_lg2(const GAS float* rdec, int l, int dirh) { const float p = rdec[l * 8 + dirh]; return log1pf(-expf(p)) * 1.4426950408889634f; }

__device__ __forceinline__ void transpose_item(const GAS float* W, int N, GAS bf16_t* WT, int ldw, int koff, LAS float* scr, int item, int lane) {
    const int nblk = N / 64, kb = item / nblk, nb = item % nblk, k0 = 64 * kb, n0 = 64 * nb;
    const int lr = lane >> 4, lc = (lane & 15) * 4;
    f32x4 v[16];
#pragma unroll
    for (int i = 0; i < 16; ++i) v[i] = *(const GAS f32x4*)(W + (size_t)(k0 + 4 * i + lr) * N + n0 + lc);
#pragma unroll
    for (int i = 0; i < 16; ++i) { LAS float* p = scr + (4 * i + lr) * 65 + lc; p[0] = v[i][0]; p[1] = v[i][1]; p[2] = v[i][2]; p[3] = v[i][3]; }
    LDS_WAIT(); asm volatile("" ::: "memory");
    const int c = lane & 7;
#pragma unroll
    for (int j = 0; j < 8; ++j) { const int n = (lane >> 3) + 8 * j; const LAS float* sp = scr + (8 * c) * 65 + n;
        u32x4 o; o.x = pk2(sp[0 * 65], sp[1 * 65]); o.y = pk2(sp[2 * 65], sp[3 * 65]); o.z = pk2(sp[4 * 65], sp[5 * 65]); o.w = pk2(sp[6 * 65], sp[7 * 65]);
        *(GAS u32x4*)(WT + (size_t)(n0 + n) * ldw + koff + k0 + 8 * c) = o; }
    LDS_WAIT(); asm volatile("" ::: "memory");
}

__device__ __forceinline__ void pro_a(Frame& F, CArgs a) {
    LAS float* scr = (LAS float*)(F.lds + F.wave * 16640);
    const int gw = F.blk * 8 + F.wave, NGW = F.G * 8, lane = F.lane;
    GAS unsigned char* ws = F.ws;
    constexpr int I_IN = 32 * 192, I_PAB = 8 * 32, I_PCC = 16 * 32, I_O = 32 * 32, I_1 = 32 * 128, I_2 = 128 * 32;
    constexpr int PER_L = I_IN + 2 * I_PAB + I_PCC + I_O + I_1 + I_2;
    for (int it = gw; it < DEPTH * PER_L; it += NGW) {
        const int l = it / PER_L; int r = it % PER_L;
        if (r < I_IN) { transpose_item(((const GAS float*)a->in[I_WIN]) + (size_t)l * D * DIN, DIN, (GAS bf16_t*)(ws + WS_WIN) + (size_t)l * DIN * D, D, 0, scr, r, lane); continue; } r -= I_IN;
        if (r < I_PAB) { transpose_item(((const GAS float*)a->in[I_PA]) + (size_t)l * 512 * D, D, (GAS bf16_t*)(ws + WS_PT) + (size_t)l * D * D, D, 0, scr, r, lane); continue; } r -= I_PAB;
        if (r < I_PAB) { transpose_item(((const GAS float*)a->in[I_PB]) + (size_t)l * 512 * D, D, (GAS bf16_t*)(ws + WS_PT) + (size_t)l * D * D, D, 512, scr, r, lane); continue; } r -= I_PAB;
        if (r < I_PCC) { transpose_item(((const GAS float*)a->in[I_PC]) + (size_t)l * 1024 * D, D, (GAS bf16_t*)(ws + WS_PT) + (size_t)l * D * D, D, 1024, scr, r, lane); continue; } r -= I_PCC;
        if (r < I_O) { transpose_item(((const GAS float*)a->in[I_WO]) + (size_t)l * D * D, D, (GAS bf16_t*)(ws + WS_WO) + (size_t)l * D * D, D, 0, scr, r, lane); continue; } r -= I_O;
        if (r < I_1) { transpose_item(((const GAS float*)a->in[I_W1]) + (size_t)l * D * DFF, DFF, (GAS bf16_t*)(ws + WS_W1) + (size_t)l * DFF * D, D, 0, scr, r, lane); continue; } r -= I_1;
        transpose_item(((const GAS float*)a->in[I_W2]) + (size_t)l * DFF * D, D, (GAS bf16_t*)(ws + WS_W2) + (size_t)l * D * DFF, DFF, 0, scr, r, lane);
    }
    {
        GAS float* modp = (GAS float*)(ws + WS_MODP);
        for (int it = gw; it < DEPTH * 48 * 32; it += NGW) {
            const int ks = it & 31, cb = (it >> 5) % 48, l = it / (32 * 48);
            const int col = cb * 256 + lane * 4, k0 = ks * 64;
            float sv[5];
#pragma unroll
            for (int b = 0; b < 5; ++b) { const GAS float* cp = b < 4 ? ((const GAS float*)a->in[I_C]) + b * D : ((const GAS float*)a->in[I_CCTX]); sv[b] = silu_f(cp[k0 + lane]); }
            f32x4 acc[5];
#pragma unroll
            for (int b = 0; b < 5; ++b) acc[b] = (f32x4){0.f, 0.f, 0.f, 0.f};
            const GAS float* wp = ((const GAS float*)a->in[I_WADA]) + ((size_t)l * D + k0) * 12288 + col;
#pragma unroll 8
            for (int kk = 0; kk < 64; ++kk) { const f32x4 w = *(const GAS f32x4*)(wp + (size_t)kk * 12288);
#pragma unroll
                for (int b = 0; b < 5; ++b) acc[b] = acc[b] + w * __shfl(sv[b], kk); }
#pragma unroll
            for (int b = 0; b < 5; ++b) *(GAS f32x4*)(modp + (((size_t)ks * DEPTH + l) * 5 + b) * 12288 + col) = acc[b];
        }
    }
    {
        LAS float* H3 = (LAS float*)F.lds;
        GAS bf16_t* krg = (GAS bf16_t*)(ws + WS_KRG); GAS bf16_t* krc = (GAS bf16_t*)(ws + WS_KRC);
        for (int it = F.blk; it < DEPTH * 36; it += F.G) {
            const int l = it / 36, grp = it % 36; const bool isc = grp >= 32; const int L = isc ? CTXL : SEQ, p0 = (isc ? grp - 32 : grp) * 64;
            __syncthreads();
            for (int pp = 0; pp < 8; ++pp) {
                const int pos = p0 + F.wave * 8 + pp;
                const float t = (float)pos / (float)(L - 1);
                const float w = 6.2831853071795862f * (float)pos / (float)L;
                float zf = 0.f;
                if (lane == 0) zf = t;
                else if (lane < 33) { const int bi = (lane - 1) & 15; const float f = 1e-4f + (float)bi * ((15.0f - 1e-4f) / 15.0f); const float ang = f * w; zf = lane <= 16 ? cosf(ang) : -sinf(ang); }
                float h = ((const GAS float*)a->in[I_FB1])[l * 64 + lane];
                for (int i = 0; i < 33; ++i) h += __shfl(zf, i) * ((const GAS float*)a->in[I_FW1])[((size_t)l * 33 + i) * 64 + lane];
                h = sinf(((const GAS float*)a->in[I_FF1])[l * 64 + lane] * h);
                float h2 = ((const GAS float*)a->in[I_FB2])[l * 64 + lane];
                for (int i = 0; i < 64; ++i) h2 += __shfl(h, i) * ((const GAS float*)a->in[I_FW2])[((size_t)l * 64 + i) * 64 + lane];
                h2 = sinf(((const GAS float*)a->in[I_FF2])[l * 64 + lane] * h2);
                float h3 = ((const GAS float*)a->in[I_FB3])[l * 64 + lane];
                for (int i = 0; i < 64; ++i) h3 += __shfl(h2, i) * ((const GAS float*)a->in[I_FW3])[((size_t)l * 64 + i) * 64 + lane];
                h3 = sinf(((const GAS float*)a->in[I_FF3])[l * 64 + lane] * h3);
                H3[(F.wave * 8 + pp) * 64 + lane] = h3;
            }
            __syncthreads();
            const int c = F.tid;
            const float min_decay = -3.0701134573253945f, max_decay = -15.350567286626973f;
            const float adelta = fabsf(min_decay + (float)c * ((max_decay - min_decay) / 511.0f));
            GAS bf16_t* dst = isc ? krc + ((size_t)l * 512 + c) * 512 : krg + ((size_t)l * 512 + c) * 4096;
            const int center = isc ? CTXL : SEQ;
            if (p0 == 0) dst[0] = (bf16_t)0;
#pragma unroll 1
            for (int dir = 0; dir < 2; ++dir) {
                float wc[64];
#pragma unroll
                for (int i = 0; i < 64; ++i) wc[i] = ((const GAS float*)a->in[I_FW4])[((size_t)l * 64 + i) * 1024 + dir * 512 + c];
#pragma unroll 2
                for (int pp = 0; pp < 64; ++pp) {
                    float acc = 0.f;
#pragma unroll
                    for (int i4 = 0; i4 < 16; ++i4) { const f32x4 hv = *(const LAS f32x4*)(H3 + pp * 64 + 4 * i4);
                        acc += hv[0] * wc[4 * i4] + hv[1] * wc[4 * i4 + 1] + hv[2] * wc[4 * i4 + 2] + hv[3] * wc[4 * i4 + 3]; }
                    const int pos = p0 + pp; const float t = (float)pos / (float)(L - 1);
                    const bf16_t v = (bf16_t)f2bf(acc * expf(-t * adelta));
                    if (dir == 0) dst[center - pos] = v; else if (pos > 0) dst[center + pos] = v;
                }
            }
        }
        __syncthreads();
    }
    for (int t = gw; t < SEQ; t += NGW) {
        const float inv = exp2f(-(float)lane * (13.287712379549449f / 64.0f));
        const float ar = (float)(t >> 6) * inv, ac = (float)(t & 63) * inv;
        GAS float* rp = (GAS float*)(ws + WS_ROPE) + (size_t)t * 256;
        rp[lane] = cosf(ar); rp[64 + lane] = sinf(ar); rp[128 + lane] = cosf(ac); rp[192 + lane] = sinf(ac);
    }
    {
        GAS bf16_t* wpt = (GAS bf16_t*)(ws + WS_WPT);
        for (int e = F.blk * 512 + F.tid; e < DEPTH * 512 * 512; e += F.G * 512) {
            const int l = e >> 18, n = (e >> 9) & 511, k = e & 511; float v = 0.f;
            if ((n >> 7) == (k >> 7)) v = ((const GAS float*)a->in[I_POOLW])[(((size_t)l * 4 + (n >> 7)) * 128 + (k & 127)) * 128 + (n & 127)] * ((const GAS float*)a->in[I_POOLS])[l * 512 + n];
            wpt[e] = (bf16_t)f2bf(v);
        }
    }
    {
        GAS f32x4* X = (GAS f32x4*)(ws + WS_X);
        const size_t nc = (size_t)MC * D / 4, nx = (size_t)ML * D / 4;
        for (size_t e = (size_t)F.blk * 512 + F.tid; e < nc + nx; e += (size_t)F.G * 512)
            X[e] = e < nc ? ((const GAS f32x4*)((const GAS float*)a->in[I_CTX]))[e] : ((const GAS f32x4*)((const GAS float*)a->in[I_X]))[e - nc];
    }
}
__device__ __forceinline__ void pro_b(Frame& F, CArgs a) {
    const GAS float* modp = (const GAS float*)(F.ws + WS_MODP); GAS float* mod = (GAS float*)(F.ws + WS_MOD);
    for (int e = F.blk * 512 + F.tid; e < DEPTH * 5 * 12288; e += F.G * 512) {
        const int j = e % 12288, l = e / (5 * 12288);
        float s = ((const GAS float*)a->in[I_BADA])[l * 12288 + j];
#pragma unroll 8
        for (int ks = 0; ks < 32; ++ks) s += modp[(size_t)ks * DEPTH * 5 * 12288 + e];
        mod[e] = s;
    }
}
__device__ __forceinline__ void pro_c(Frame& F) {
    const int gw = F.blk * 8 + F.wave, NGW = F.G * 8, lane = F.lane;
    const GAS float* mod = (const GAS float*)(F.ws + WS_MOD);
    for (int row = gw; row < M; row += NGW) {
        const int bmod = row < MC ? 4 : ((row - MC) >> 11);
        const GAS float* sh = mod + (size_t)bmod * 12288; const GAS float* sc = sh + D;
        const GAS f32x4* xr = (const GAS f32x4*)((const GAS float*)(F.ws + WS_X) + (size_t)row * D);
        GAS u32x2* o = (GAS u32x2*)((GAS bf16_t*)(F.ws + WS_XM) + (size_t)row * D);
#pragma unroll
        for (int j = 0; j < 8; ++j) { const int i4 = lane + 64 * j; const f32x4 v = xr[i4], s4 = ((const GAS f32x4*)sc)[i4], h4 = ((const GAS f32x4*)sh)[i4];
            const f32x4 r = v * (s4 + 1.0f) + h4; u32x2 w; w.x = pk2(r[0], r[1]); w.y = pk2(r[2], r[3]); o[i4] = w; }
    }
}

__device__ __forceinline__ void prep_phase(Frame& F, CArgs a, int l, unsigned long long& tm_acc) {
    unsigned long long tm_t0 = 0ull; (void)tm_t0;
    GAS unsigned char* ws = F.ws;
    const GAS bf16_t* Z = (const GAS bf16_t*)(ws + WS_Z);
    TM_BEGIN(16);
    {
        GAS bf16_t* P = (GAS bf16_t*)(ws + WS_POOL);
        const int gw = F.blk * 8 + F.wave, NGW = F.G * 8;
        for (int wi = gw; wi < M; wi += NGW) {
            const int g = wi & 3, row = (wi >> 2) * 4 + (F.lane >> 4), cg = g * 16 + (F.lane & 15);
            int t, L; if (row < MC) { t = row & 255; L = CTXL; } else { t = (row - MC) & 2047; L = SEQ; }
            const GAS bf16_t* zc = Z + (size_t)(row - t) * DIN + cg * 8;
            float s[8] = {0.f, 0.f, 0.f, 0.f, 0.f, 0.f, 0.f, 0.f}; int cnt = 0;
            auto body = [&](auto WC) { constexpr int W = decltype(WC)::value;
                u32x4 v[W]; float mk[W];
#pragma unroll
                for (int j = 0; j < W; ++j) { const int tt = t - W / 2 + j; const bool ok = tt >= 0 && tt < L; mk[j] = ok ? 1.f : 0.f; cnt += ok ? 1 : 0; v[j] = *(const GAS u32x4*)(zc + (size_t)(ok ? tt : t) * DIN); }
#pragma unroll
                for (int j = 0; j < W; ++j) { s[0] += mk[j] * bflo(v[j].x); s[1] += mk[j] * bfhi(v[j].x); s[2] += mk[j] * bflo(v[j].y); s[3] += mk[j] * bfhi(v[j].y);
                    s[4] += mk[j] * bflo(v[j].z); s[5] += mk[j] * bfhi(v[j].z); s[6] += mk[j] * bflo(v[j].w); s[7] += mk[j] * bfhi(v[j].w); } };
            if (g == 0) body(std::integral_constant<int, 2>{}); else if (g == 1) body(std::integral_constant<int, 4>{}); else if (g == 2) body(std::integral_constant<int, 8>{}); else body(std::integral_constant<int, 16>{});
            const u32x4 sv = *(const GAS u32x4*)(zc + (size_t)t * DIN);
            const float inv = 1.0f / (float)cnt;
            u32x4 o; o.x = pk2(s[0] * inv - bflo(sv.x), s[1] * inv - bfhi(sv.x)); o.y = pk2(s[2] * inv - bflo(sv.y), s[3] * inv - bfhi(sv.y));
            o.z = pk2(s[4] * inv - bflo(sv.z), s[5] * inv - bfhi(sv.z)); o.w = pk2(s[6] * inv - bflo(sv.w), s[7] * inv - bfhi(sv.w));
            *(GAS u32x4*)(P + (size_t)row * 512 + cg * 8) = o;
        }
    }
    __syncthreads(); TM_END(16); TM_BEGIN(17);
    {
        const GAS float* cw = ((const GAS float*)a->in[I_CONVW]) + (size_t)l * 3 * 1536; const GAS float* cb = ((const GAS float*)a->in[I_CONVB]) + (size_t)l * 1536;
        LAS unsigned char* T = F.lds + F.wave * 9216;
        const int lane = F.lane, c8 = (lane & 7) * 8, rb = lane >> 3, gl = lane & 15, gg = lane >> 4;
        const int gw = F.blk * 8 + F.wave, NGW = F.G * 8;
        for (int wi = gw; wi < 144 * 8; wi += NGW) {
            const int tile = wi >> 3, c0 = (wi & 7) * 64, row0 = tile * 64;
            if (l == DEPTH - 1 && row0 < MC) continue;
            int t0, L; GAS bf16_t *ud, *xd;
            if (row0 < MC) { const int sq = row0 >> 8; t0 = row0 & 255; L = CTXL; ud = (GAS bf16_t*)(ws + WS_UTBC) + (size_t)sq * 512 * CTXL; xd = (GAS bf16_t*)(ws + WS_X0TC) + (size_t)sq * 512 * CTXL; }
            else { const int r = row0 - MC, sq = r >> 11; t0 = r & 2047; L = SEQ; ud = (GAS bf16_t*)(ws + WS_UTBL) + (size_t)sq * 512 * SEQ; xd = (GAS bf16_t*)(ws + WS_X0TL) + (size_t)sq * 512 * SEQ; }
#pragma unroll 1
            for (int ps = 0; ps < 2; ++ps) {
                const int rbase = row0 + ps * 32 + rb * 4, tbase = t0 + ps * 32 + rb * 4;
                auto slab = [&](int sgm, float (&o)[4][8]) {
                    const int ch = sgm * 512 + c0 + c8;
                    u32x4 zr[6]; float mk[6];
#pragma unroll
                    for (int ri = 0; ri < 6; ++ri) { const int tt = tbase - 1 + ri; const bool ok = tt >= 0 && tt < L; mk[ri] = ok ? 1.f : 0.f;
                        zr[ri] = *(const GAS u32x4*)(Z + (size_t)(ok ? rbase - 1 + ri : rbase) * DIN + O_HY + ch); }
                    const f32x4 b0 = *(const GAS f32x4*)(cb + ch), b1 = *(const GAS f32x4*)(cb + ch + 4);
#pragma unroll
                    for (int j = 0; j < 4; ++j) { o[j][0] = b0[0]; o[j][1] = b0[1]; o[j][2] = b0[2]; o[j][3] = b0[3]; o[j][4] = b1[0]; o[j][5] = b1[1]; o[j][6] = b1[2]; o[j][7] = b1[3]; }
#pragma unroll
                    for (int d = 0; d < 3; ++d) { const f32x4 w0 = *(const GAS f32x4*)(cw + d * 1536 + ch), w1 = *(const GAS f32x4*)(cw + d * 1536 + ch + 4);
#pragma unroll
                        for (int j = 0; j < 4; ++j) { const u32x4 z = zr[j + d]; const float m = mk[j + d];
                            o[j][0] += m * w0[0] * bflo(z.x); o[j][1] += m * w0[1] * bfhi(z.x); o[j][2] += m * w0[2] * bflo(z.y); o[j][3] += m * w0[3] * bfhi(z.y);
                            o[j][4] += m * w1[0] * bflo(z.z); o[j][5] += m * w1[1] * bfhi(z.z); o[j][6] += m * w1[2] * bflo(z.w); o[j][7] += m * w1[3] * bfhi(z.w); } }
                };
                float vv[4][8], xx[4][8];
                slab(0, vv); slab(2, xx);
#pragma unroll
                for (int j = 0; j < 4; ++j) { u32x4 w; w.x = pk2(vv[j][0] * xx[j][0], vv[j][1] * xx[j][1]); w.y = pk2(vv[j][2] * xx[j][2], vv[j][3] * xx[j][3]);
                    w.z = pk2(vv[j][4] * xx[j][4], vv[j][5] * xx[j][5]); w.w = pk2(vv[j][6] * xx[j][6], vv[j][7] * xx[j][7]);
                    *(LAS u32x4*)(T + (rb * 4 + j) * 144 + (lane & 7) * 16) = w; }
                slab(1, xx);
#pragma unroll
                for (int j = 0; j < 4; ++j) { u32x4 w; w.x = pk2(xx[j][0], xx[j][1]); w.y = pk2(xx[j][2], xx[j][3]); w.z = pk2(xx[j][4], xx[j][5]); w.w = pk2(xx[j][6], xx[j][7]);
                    *(LAS u32x4*)(T + 4608 + (rb * 4 + j) * 144 + (lane & 7) * 16) = w; }
                LDS_WAIT();
#pragma unroll
                for (int it = 0; it < 4; ++it) {
                    const LAS unsigned char* rp = T + (8 * gg + (gl >> 2)) * 144 + (16 * it + 4 * (gl & 3)) * 2;
                    const u32x2 u0 = ds_tr16(rp), u1 = ds_tr16(rp + 4 * 144), x0 = ds_tr16(rp + 4608), x1 = ds_tr16(rp + 4608 + 4 * 144);
                    const size_t off = (size_t)(c0 + 16 * it + gl) * L + t0 + ps * 32 + 8 * gg;
                    *(GAS u32x4*)(ud + off) = (u32x4){u0.x, u0.y, u1.x, u1.y}; *(GAS u32x4*)(xd + off) = (u32x4){x0.x, x0.y, x1.x, x1.y};
                }
                LDS_WAIT();
            }
        }
    }
    __syncthreads();
    TM_END(17); TM_BEGIN(18);
    {
        GAS bf16_t* AB = (GAS bf16_t*)(ws + WS_ABUF); GAS bf16_t* BB = (GAS bf16_t*)(ws + WS_BBUF); GAS bf16_t* KT = (GAS bf16_t*)(ws + WS_KT);
        GAS bf16_t* QRp = (GAS bf16_t*)(ws + WS_QR); GAS bf16_t* KRp = (GAS bf16_t*)(ws + WS_KRB);
        const GAS float* rope = (const GAS float*)(ws + WS_ROPE);
        LAS unsigned char* T = F.lds + F.wave * 8704;
        const int lane = F.lane, ts = lane >> 3, c = lane & 7, gl = lane & 15, gg = lane >> 4;
        const int gw = F.blk * 8 + F.wave, NGW = F.G * 8;
        for (int wi = gw; wi < NU * 8; wi += NGW) {
            const int u = wi >> 3, tb = (wi >> 1) & 3, half = wi & 1, bh = u / 9, ci = u % 9, b = bh >> 2, h = bh & 3;
            const int row0 = chunk_row0(b, ci); const bool isctx = ci == 0;
            const float lf = ret_lg2((const GAS float*)a->in[I_RDEC], l, h), lb = ret_lg2((const GAS float*)a->in[I_RDEC], l, 4 + h);
            const int dA = half * 128 + 8 * c, dB = dA + 64;
#pragma unroll 1
            for (int sb = 0; sb < 2; ++sb) {
                float kf[4][16]; u32x4 va[4], vb[4];
#pragma unroll
                for (int st = 0; st < 4; ++st) {
                    const int tok = tb * 64 + sb * 32 + st * 8 + ts; const size_t zrow = (size_t)(row0 + tok) * DIN;
                    float cs[8], sn[8];
                    if (!isctx) { const GAS float* rp = rope + (size_t)((ci - 1) * 256 + tok) * 256 + half * 128 + 8 * c;
                        const f32x4 c0v = *(const GAS f32x4*)rp, c1v = *(const GAS f32x4*)(rp + 4), s0v = *(const GAS f32x4*)(rp + 64), s1v = *(const GAS f32x4*)(rp + 68);
#pragma unroll
                        for (int e = 0; e < 4; ++e) { cs[e] = c0v[e]; cs[4 + e] = c1v[e]; sn[e] = s0v[e]; sn[4 + e] = s1v[e]; } }
                    else {
#pragma unroll
                        for (int e = 0; e < 8; ++e) { cs[e] = 1.f; sn[e] = 0.f; } }
                    const GAS bf16_t* qp = Z + zrow + O_Q + h * 256; const GAS bf16_t* kp = Z + zrow + O_K + h * 256; const GAS bf16_t* vp = Z + zrow + O_V + h * 256;
                    const u32x4 qa = *(const GAS u32x4*)(qp + dA), qb = *(const GAS u32x4*)(qp + dB), ka = *(const GAS u32x4*)(kp + dA), kb = *(const GAS u32x4*)(kp + dB);
                    va[st] = *(const GAS u32x4*)(vp + dA); vb[st] = *(const GAS u32x4*)(vp + dB);
                    const unsigned qaw[4] = {qa.x, qa.y, qa.z, qa.w}, qbw[4] = {qb.x, qb.y, qb.z, qb.w}, kaw[4] = {ka.x, ka.y, ka.z, ka.w}, kbw[4] = {kb.x, kb.y, kb.z, kb.w};
                    float q1[8], q2[8];
#pragma unroll
                    for (int e = 0; e < 8; ++e) { const float x1 = (e & 1) ? bfhi(qaw[e >> 1]) : bflo(qaw[e >> 1]), x2 = (e & 1) ? bfhi(qbw[e >> 1]) : bflo(qbw[e >> 1]);
                        q1[e] = x1 * cs[e] - x2 * sn[e]; q2[e] = x2 * cs[e] + x1 * sn[e];
                        const float y1 = (e & 1) ? bfhi(kaw[e >> 1]) : bflo(kaw[e >> 1]), y2 = (e & 1) ? bfhi(kbw[e >> 1]) : bflo(kbw[e >> 1]);
                        kf[st][e] = (y1 * cs[e] - y2 * sn[e]) * 0.0625f; kf[st][8 + e] = (y2 * cs[e] + y1 * sn[e]) * 0.0625f; }
                    const float df = exp2f((float)(tok + 1) * lf), db = exp2f((float)(256 - tok) * lb);
                    GAS bf16_t* qw = QRp + (size_t)(row0 + tok) * 1024 + h * 256; GAS bf16_t* kw = KRp + (size_t)(row0 + tok) * 1024 + h * 256; GAS bf16_t* apq = AB + ((size_t)u * 256 + tok) * 768;
                    *(GAS u32x4*)(qw + dA) = (u32x4){pk2(q1[0], q1[1]), pk2(q1[2], q1[3]), pk2(q1[4], q1[5]), pk2(q1[6], q1[7])};
                    *(GAS u32x4*)(qw + dB) = (u32x4){pk2(q2[0], q2[1]), pk2(q2[2], q2[3]), pk2(q2[4], q2[5]), pk2(q2[6], q2[7])};
                    *(GAS u32x4*)(apq + 256 + dA) = (u32x4){pk2(q1[0] * df, q1[1] * df), pk2(q1[2] * df, q1[3] * df), pk2(q1[4] * df, q1[5] * df), pk2(q1[6] * df, q1[7] * df)};
                    *(GAS u32x4*)(apq + 256 + dB) = (u32x4){pk2(q2[0] * df, q2[1] * df), pk2(q2[2] * df, q2[3] * df), pk2(q2[4] * df, q2[5] * df), pk2(q2[6] * df, q2[7] * df)};
                    *(GAS u32x4*)(apq + 512 + dA) = (u32x4){pk2(q1[0] * db, q1[1] * db), pk2(q1[2] * db, q1[3] * db), pk2(q1[4] * db, q1[5] * db), pk2(q1[6] * db, q1[7] * db)};
                    *(GAS u32x4*)(apq + 512 + dB) = (u32x4){pk2(q2[0] * db, q2[1] * db), pk2(q2[2] * db, q2[3] * db), pk2(q2[4] * db, q2[5] * db), pk2(q2[6] * db, q2[7] * db)};
                    *(GAS u32x4*)(kw + dA) = (u32x4){pk2(kf[st][0], kf[st][1]), pk2(kf[st][2], kf[st][3]), pk2(kf[st][4], kf[st][5]), pk2(kf[st][6], kf[st][7])};
                    *(GAS u32x4*)(kw + dB) = (u32x4){pk2(kf[st][8], kf[st][9]), pk2(kf[st][10], kf[st][11]), pk2(kf[st][12], kf[st][13]), pk2(kf[st][14], kf[st][15])};
                }
                const int tok0 = tb * 64 + sb * 32;
#pragma unroll
                for (int pass = 0; pass < 3; ++pass) {
#pragma unroll
                    for (int st = 0; st < 4; ++st) { const int tl = st * 8 + ts, tok = tok0 + tl; u32x4 w0, w1;
                        if (pass < 2) { const float sc = pass == 0 ? exp2f((float)(255 - tok) * lf) : exp2f((float)tok * lb);
                            w0 = (u32x4){pk2(kf[st][0] * sc, kf[st][1] * sc), pk2(kf[st][2] * sc, kf[st][3] * sc), pk2(kf[st][4] * sc, kf[st][5] * sc), pk2(kf[st][6] * sc, kf[st][7] * sc)};
                            w1 = (u32x4){pk2(kf[st][8] * sc, kf[st][9] * sc), pk2(kf[st][10] * sc, kf[st][11] * sc), pk2(kf[st][12] * sc, kf[st][13] * sc), pk2(kf[st][14] * sc, kf[st][15] * sc)}; }
                        else { w0 = va[st]; w1 = vb[st]; }
                        *(LAS u32x4*)(T + tl * 272 + c * 16) = w0; *(LAS u32x4*)(T + tl * 272 + (c + 8) * 16) = w1; }
                    LDS_WAIT();
                    GAS bf16_t* dst = pass < 2 ? KT + ((size_t)u * 512 + pass * 256 + half * 128) * 256 + tok0 + 8 * gg : BB + ((size_t)u * 256 + half * 128) * 768 + tok0 + 8 * gg;
                    const int pitch = pass < 2 ? 256 : 768;
#pragma unroll
                    for (int it = 0; it < 8; ++it) {
                        const LAS unsigned char* rp = T + (8 * gg + (gl >> 2)) * 272 + (16 * it + 4 * (gl & 3)) * 2;
                        const u32x2 r0 = ds_tr16(rp), r1 = ds_tr16(rp + 4 * 272);
                        *(GAS u32x4*)(dst + (size_t)(16 * it + gl) * pitch) = (u32x4){r0.x, r0.y, r1.x, r1.y};
                    }
                    LDS_WAIT();
                }
            }
        }
    }
    TM_END(18);
}

__device__ __forceinline__ void scan_phase(Frame& F, CArgs a, int l) {
    const GAS float* UT = (const GAS float*)(F.ws + WS_UT); GAS bf16_t* BB = (GAS bf16_t*)(F.ws + WS_BBUF);
    for (int e = F.blk * 512 + F.tid; e < 16 * 2 * 16384; e += F.G * 512) {
        const int q = e & 16383, dir = (e >> 14) & 1, bh = e >> 15, dv = q >> 6, dk4 = (q & 63) * 4, h = bh & 3;
        const float cdec = exp2f(256.0f * ret_lg2(((const GAS float*)a->in[I_RDEC]), l, dir * 4 + h));
        f32x4 S = (f32x4){0.f, 0.f, 0.f, 0.f};
#pragma unroll 1
        for (int s = 0; s < 9; ++s) {
            const int ci = dir == 0 ? s : (s == 0 ? 0 : 9 - s);
            const int u = bh * 9 + ci;
            u32x2 w; w.x = pk2(S[0], S[1]); w.y = pk2(S[2], S[3]);
            *(GAS u32x2*)(BB + ((size_t)u * 256 + dv) * 768 + 256 + dir * 256 + dk4) = w;
            const f32x4 uv = *(const GAS f32x4*)(UT + ((size_t)u * 256 + dv) * 512 + dir * 256 + dk4);
            S = S * cdec + uv;
        }
    }
}

typedef float f32x16 __attribute__((ext_vector_type(16)));
template <bool CTX>
__device__ __forceinline__ void conv_mfma(Frame& F, CArgs a, int l) {
    constexpr int NA = CTX ? 8 : 64, L = NA * 32, FLEN = 2 * L, CST = FLEN + 8, PB = CTX ? 7 : 31, UB = (2 * PB + NA) * 40, RST = CTX ? 33 : 257;
    constexpr int F8_BYTES = 8 * CST * 2, U_OFF = (F8_BYTES + 255) & ~255, U_BYTES = 4 * UB * 2, RB_OFF = CTX ? ((U_OFF + U_BYTES + 255) & ~255) : 0, RB_BYTES = CTX ? 8 * 32 * RST * 4 : 32 * RST * 4;
    static_assert(U_OFF + U_BYTES <= RING_BYTES && RB_OFF + RB_BYTES <= RING_BYTES && (CTX || RB_BYTES <= F8_BYTES), "conv LDS map");
    LAS unsigned char* lds = F.lds;
    const int tid = F.tid, lane = F.lane, wave = F.wave, r = lane & 31, h = lane >> 5;
    const GAS bf16_t* KR = CTX ? (const GAS bf16_t*)(F.ws + WS_KRC) + (size_t)l * 512 * FLEN : (const GAS bf16_t*)(F.ws + WS_KRG) + (size_t)l * 512 * FLEN;
    const GAS bf16_t* UT = (const GAS bf16_t*)(F.ws + (CTX ? WS_UTBC : WS_UTBL)); const GAS bf16_t* XT = (const GAS bf16_t*)(F.ws + (CTX ? WS_X0TC : WS_X0TL));
    GAS bf16_t* YT = (GAS bf16_t*)(F.ws + (CTX ? WS_YBTC : WS_YBTL));
    __syncthreads();
    for (int e = tid; e < U_BYTES / 16; e += 512) *(LAS u32x4*)(lds + U_OFF + e * 16) = (u32x4){0u, 0u, 0u, 0u};
    const int sA = (-r) & 7;
    const int abase = (sA * CST + L - r + 8 * h - sA) * 2;
    const int bl = CTX ? (r >> 3) : (wave & 3), al = CTX ? (r & 7) : r;
    const int bbase = U_OFF + (bl * UB + (PB + al) * 40 + 8 * h) * 2;
    LAS float* R = (LAS float*)(lds + RB_OFF);
    for (int ch = F.blk; ch < 512; ch += F.G) {
        __syncthreads();
        for (int x8 = tid; x8 < FLEN / 8; x8 += 512) {
            const GAS bf16_t* kp = KR + (size_t)ch * FLEN + x8 * 8;
            const u32x4 lo = *(const GAS u32x4*)kp; u32x4 hi = (u32x4){0u, 0u, 0u, 0u}; if (x8 + 1 < FLEN / 8) hi = *(const GAS u32x4*)(kp + 8);
            unsigned w[8] = {lo.x, lo.y, lo.z, lo.w, hi.x, hi.y, hi.z, hi.w};
            if (x8 == 0) w[0] &= 0xffff0000u;
#pragma unroll
            for (int sft = 0; sft < 8; ++sft) { u32x4 o;
                if ((sft & 1) == 0) { o.x = w[sft / 2]; o.y = w[sft / 2 + 1]; o.z = w[sft / 2 + 2]; o.w = w[sft / 2 + 3]; }
                else { const int q = sft / 2; o.x = (w[q] >> 16) | (w[q + 1] << 16); o.y = (w[q + 1] >> 16) | (w[q + 2] << 16); o.z = (w[q + 2] >> 16) | (w[q + 3] << 16); o.w = (w[q + 3] >> 16) | (w[q + 4] << 16); }
                *(LAS u32x4*)(lds + (sft * CST + x8 * 8) * 2) = o; }
        }
        if (tid < 8) *(LAS u32x4*)(lds + (tid * CST + FLEN) * 2) = (u32x4){0u, 0u, 0u, 0u};
        for (int q = tid; q < 4 * L / 8; q += 512) { const int b = q / (L / 8), qq = q % (L / 8);
            const u32x4 v = *(const GAS u32x4*)(UT + ((size_t)b * 512 + ch) * L + qq * 8);
            *(LAS u32x4*)(lds + U_OFF + (b * UB + (PB + (qq >> 2)) * 40 + (qq & 3) * 8) * 2) = v; }
        __syncthreads();
        if constexpr (CTX) {
            f32x16 acc;
#pragma unroll
            for (int e = 0; e < 16; ++e) acc[e] = 0.f;
#pragma unroll 1
            for (int q = wave; q < 2 * (2 * NA - 1); q += 8) {
                const int delta = (q >> 1) - (NA - 1), j0 = (q & 1) * 16;
                const bf16x8 af = *(const LAS bf16x8*)(lds + abase + (j0 - 32 * delta) * 2);
                const bf16x8 bf = *(const LAS bf16x8*)(lds + bbase + (j0 - 40 * delta) * 2);
                acc = __builtin_amdgcn_mfma_f32_32x32x16_bf16(af, bf, acc, 0, 0, 0);
            }
#pragma unroll
            for (int e = 0; e < 16; ++e) R[wave * 32 * RST + ((e & 3) + 8 * (e >> 2) + 4 * h) * RST + r] = acc[e];
            __syncthreads();
        } else {
            f32x16 acc0, acc1;
#pragma unroll
            for (int e = 0; e < 16; ++e) { acc0[e] = 0.f; acc1[e] = 0.f; }
            const int j0 = (wave >> 2) * 16;
            const LAS unsigned char* ap0 = lds + abase + j0 * 2; const LAS unsigned char* bp0 = lds + bbase + j0 * 2;
            {
                bf16x8 af = *(const LAS bf16x8*)(ap0 + 64 * 63), b0 = *(const LAS bf16x8*)(bp0 + 80 * 63);
#pragma unroll 1
                for (int delta = -63; delta < -31; ++delta) {
                    const int dn = delta < -32 ? delta + 1 : delta;
                    const bf16x8 naf = *(const LAS bf16x8*)(ap0 - 64 * dn), nb0 = *(const LAS bf16x8*)(bp0 - 80 * dn);
                    acc0 = __builtin_amdgcn_mfma_f32_32x32x16_bf16(af, b0, acc0, 0, 0, 0);
                    af = naf; b0 = nb0;
                }
            }
            {
                bf16x8 af = *(const LAS bf16x8*)(ap0 + 64 * 31), b0 = *(const LAS bf16x8*)(bp0 + 80 * 31), b1 = *(const LAS bf16x8*)(bp0 + 80 * 31 + 32 * 40 * 2);
#pragma unroll 1
                for (int delta = -31; delta < 32; ++delta) {
                    const int dn = delta < 31 ? delta + 1 : delta;
                    const bf16x8 naf = *(const LAS bf16x8*)(ap0 - 64 * dn), nb0 = *(const LAS bf16x8*)(bp0 - 80 * dn), nb1 = *(const LAS bf16x8*)(bp0 - 80 * dn + 32 * 40 * 2);
                    acc0 = __builtin_amdgcn_mfma_f32_32x32x16_bf16(af, b0, acc0, 0, 0, 0);
                    acc1 = __builtin_amdgcn_mfma_f32_32x32x16_bf16(af, b1, acc1, 0, 0, 0);
                    af = naf; b0 = nb0; b1 = nb1;
                }
            }
            {
                bf16x8 af = *(const LAS bf16x8*)(ap0 - 64 * 32), b1 = *(const LAS bf16x8*)(bp0 - 80 * 32 + 32 * 40 * 2);
#pragma unroll 1
                for (int delta = 32; delta < 64; ++delta) {
                    const int dn = delta < 63 ? delta + 1 : delta;
                    const bf16x8 naf = *(const LAS bf16x8*)(ap0 - 64 * dn), nb1 = *(const LAS bf16x8*)(bp0 - 80 * dn + 32 * 40 * 2);
                    acc1 = __builtin_amdgcn_mfma_f32_32x32x16_bf16(af, b1, acc1, 0, 0, 0);
                    af = naf; b1 = nb1;
                }
            }
            __syncthreads();
            const int cbase = (wave & 3) * 64 + r;
            if (wave >= 4) {
#pragma unroll
                for (int e = 0; e < 16; ++e) { const int row = (e & 3) + 8 * (e >> 2) + 4 * h; R[row * RST + cbase] = acc0[e]; R[row * RST + cbase + 32] = acc1[e]; }
            }
            __syncthreads();
            if (wave < 4) {
#pragma unroll
                for (int e = 0; e < 16; ++e) { const int row = (e & 3) + 8 * (e >> 2) + 4 * h; R[row * RST + cbase] += acc0[e]; R[row * RST + cbase + 32] += acc1[e]; }
            }
            __syncthreads();
        }
        const float hd = ((const GAS float*)a->in[I_HYD])[l * 512 + ch];
#pragma unroll 2
        for (int ck = tid; ck < 4 * L / 8; ck += 512) {
            const int b = ck / (L / 8), t0 = (ck % (L / 8)) * 8;
            const size_t off = ((size_t)b * 512 + ch) * L + t0;
            const u32x4 uw = *(const GAS u32x4*)(UT + off), xw = *(const GAS u32x4*)(XT + off);
            const unsigned uu[4] = {uw.x, uw.y, uw.z, uw.w}, xx[4] = {xw.x, xw.y, xw.z, xw.w};
            const int col = CTX ? b * 8 + (t0 >> 5) : b * 64 + (t0 >> 5), i0 = t0 & 31;
            unsigned o[4];
#pragma unroll
            for (int e = 0; e < 4; ++e) {
                float c0v = R[(i0 + 2 * e) * RST + col], c1v = R[(i0 + 2 * e + 1) * RST + col];
                if constexpr (CTX) {
#pragma unroll
                    for (int w8 = 1; w8 < 8; ++w8) { c0v += R[w8 * 32 * RST + (i0 + 2 * e) * RST + col]; c1v += R[w8 * 32 * RST + (i0 + 2 * e + 1) * RST + col]; } }
                o[e] = pk2((c0v + bflo(uu[e]) * hd) * bflo(xx[e]), (c1v + bfhi(uu[e]) * hd) * bfhi(xx[e])); }
            *(GAS u32x4*)(YT + off) = (u32x4){o[0], o[1], o[2], o[3]};
        }
    }
    __syncthreads();
}
__device__ __forceinline__ void conv_phase(Frame& F, CArgs a, int l) {
    conv_mfma<false>(F, a, l);
    if (l < DEPTH - 1) conv_mfma<true>(F, a, l);
}

__device__ __forceinline__ void gn_phase(Frame& F) {
    {
        LAS bf16_t* LT = (LAS bf16_t*)F.lds;
        GAS bf16_t* Yw = (GAS bf16_t*)(F.ws + WS_Y);
        for (int it = F.blk; it < 144 * 4; it += F.G) {
            const int tile = it >> 2, c0 = (it & 3) * 128, row0 = tile * 64;
            int t0, L; const GAS bf16_t* src;
            if (row0 < MC) { const int sq = row0 >> 8; t0 = row0 & 255; L = CTXL; src = (const GAS bf16_t*)(F.ws + WS_YBTC) + (size_t)sq * 512 * CTXL; }
            else { const int r = row0 - MC, sq = r >> 11; t0 = r & 2047; L = SEQ; src = (const GAS bf16_t*)(F.ws + WS_YBTL) + (size_t)sq * 512 * SEQ; }
            __syncthreads();
            { const int c = F.tid >> 2, seg = F.tid & 3; const GAS bf16_t* sp = src + (size_t)(c0 + c) * L + t0 + 16 * seg;
              *(LAS u32x4*)(LT + c * 72 + 16 * seg) = *(const GAS u32x4*)sp; *(LAS u32x4*)(LT + c * 72 + 16 * seg + 8) = *(const GAS u32x4*)(sp + 8); }
            __syncthreads();
#pragma unroll
            for (int k = 0; k < 4; ++k) { const int tl = (F.tid >> 5) + 16 * k, c4 = (F.tid & 31) * 4;
                const unsigned v0 = LT[(c4 + 0) * 72 + tl], v1 = LT[(c4 + 1) * 72 + tl], v2 = LT[(c4 + 2) * 72 + tl], v3 = LT[(c4 + 3) * 72 + tl];
                u32x2 w; w.x = v0 | (v1 << 16); w.y = v2 | (v3 << 16);
                *(GAS u32x2*)(Yw + (size_t)(row0 + tl) * D + 512 + c0 + c4) = w; }
        }
        __syncthreads();
    }

    const int gw = F.blk * 8 + F.wave, NGW = F.G * 8, lane = F.lane;
    const GAS float* OB = (const GAS float*)(F.ws + WS_OBUF); const GAS bf16_t* Z = (const GAS bf16_t*)(F.ws + WS_Z); GAS bf16_t* Y = (GAS bf16_t*)(F.ws + WS_Y);
    for (int it = gw; it < NU * 256; it += NGW) {
        const int u = it >> 8, tok = it & 255, bh = u / 9, ci = u % 9, b = bh >> 2, h = bh & 3;
        const size_t row = (size_t)(chunk_row0(b, ci) + tok);
        const f32x4 v = *(const GAS f32x4*)(OB + (size_t)it * 256 + lane * 4);
        const float mean = wave_sum((v[0] + v[1]) + (v[2] + v[3])) * (1.0f / 256.0f);
        const f32x4 dv = v - mean;
        const float var = wave_sum((dv[0] * dv[0] + dv[1] * dv[1]) + (dv[2] * dv[2] + dv[3] * dv[3])) * (1.0f / 256.0f);
        const float rstd = 1.0f / sqrtf(var + GN_EPS);
        const u32x2 gz = *(const GAS u32x2*)(Z + row * DIN + O_G + h * 256 + lane * 4);
        const float g0 = silu_f(bflo(gz.x)), g1 = silu_f(bfhi(gz.x)), g2 = silu_f(bflo(gz.y)), g3 = silu_f(bfhi(gz.y));
        u32x2 w; w.x = pk2(dv[0] * rstd * g0, dv[1] * rstd * g1); w.y = pk2(dv[2] * rstd * g2, dv[3] * rstd * g3);
        *(GAS u32x2*)(Y + row * D + 1024 + h * 256 + lane * 4) = w;
    }
}

__device__ __forceinline__ void ln_phase(Frame& F, CArgs a, int l, int which) {
    const int gw = F.blk * 8 + F.wave, NGW = F.G * 8, lane = F.lane;
    const GAS float* S = (const GAS float*)(F.ws + WS_S); GAS float* X = (GAS float*)(F.ws + WS_X); GAS bf16_t* XM = (GAS bf16_t*)(F.ws + WS_XM);
    const GAS float* g = (which == 0 ? ((const GAS float*)a->in[I_LN1G]) : ((const GAS float*)a->in[I_LN2G])) + (size_t)l * D; const GAS float* bb = (which == 0 ? ((const GAS float*)a->in[I_LN1B]) : ((const GAS float*)a->in[I_LN2B])) + (size_t)l * D;
    const bool last = (which == 1 && l == DEPTH - 1);
    const GAS float* mod = (const GAS float*)(F.ws + WS_MOD) + (size_t)(which == 0 ? l : (last ? l : l + 1)) * 5 * 12288 + (which == 0 ? 3 * D : 0);
    for (int row = gw; row < M; row += NGW) {
        if (last && row < MC) continue;
        const int bmod = row < MC ? 4 : ((row - MC) >> 11);
        const GAS f32x4* sr = (const GAS f32x4*)(S + (size_t)row * D);
        f32x4 v[8]; float s = 0.f;
#pragma unroll
        for (int j = 0; j < 8; ++j) v[j] = sr[lane + 64 * j];
        if (row >= 8192) {
#pragma unroll 1
            for (int p = 0; p < 7; ++p) { const GAS f32x4* pr = (const GAS f32x4*)((const GAS float*)(F.ws + WS_PB) + ((size_t)p * 1024 + (row - 8192)) * D);
#pragma unroll
                for (int j = 0; j < 8; ++j) v[j] = v[j] + pr[lane + 64 * j]; } }
#pragma unroll
        for (int j = 0; j < 8; ++j) s += (v[j][0] + v[j][1]) + (v[j][2] + v[j][3]);
        const float mean = wave_sum(s) * (1.0f / D); float q = 0.f;
#pragma unroll
        for (int j = 0; j < 8; ++j) { v[j] = v[j] - mean; q += (v[j][0] * v[j][0] + v[j][1] * v[j][1]) + (v[j][2] * v[j][2] + v[j][3] * v[j][3]); }
        const float rstd = 1.0f / sqrtf(wave_sum(q) * (1.0f / D) + LN_EPS);
        const GAS float* sh = mod + (size_t)bmod * 12288; const GAS float* sc = sh + D;
        GAS f32x4* xo = last ? (GAS f32x4*)(((GAS float*)a->out) + (size_t)(row - MC) * D) : (GAS f32x4*)(X + (size_t)row * D);
        GAS u32x2* xm = (GAS u32x2*)(XM + (size_t)row * D);
#pragma unroll
        for (int j = 0; j < 8; ++j) { const int i4 = lane + 64 * j; const f32x4 y = v[j] * rstd * ((const GAS f32x4*)g)[i4] + ((const GAS f32x4*)bb)[i4];
            xo[i4] = y;
            if (!last) { const f32x4 r = y * (((const GAS f32x4*)sc)[i4] + 1.0f) + ((const GAS f32x4*)sh)[i4]; u32x2 w; w.x = pk2(r[0], r[1]); w.y = pk2(r[2], r[3]); xm[i4] = w; } }
    }
}

struct ScoresOrder {
    const GAS char* Q; const GAS char* K; int G, c;
    __device__ __forceinline__ int nt(const pg8::Unit&, int d) const { return d; }
    __device__ __forceinline__ bool next(int i, pg8::Unit& u) const { const int L = i * G + c; if (L >= NU) return false; u.z = L; u.pm = 0; u.pn = 0; return true; }
    __device__ __forceinline__ size_t rowoff(const pg8::Unit& u) const { const int bh = u.z / 9, ci = u.z % 9; return ((size_t)chunk_row0(bh >> 2, ci) * 1024 + (bh & 3) * 256) * 2; }
    __device__ __forceinline__ const GAS char* aptr(const pg8::Unit& u) const { return Q + rowoff(u); }
    __device__ __forceinline__ const GAS char* bptr(const pg8::Unit& u) const { return K + rowoff(u); }
};
struct UtOrder {
    const GAS char* BB; const GAS char* KT; int G, c;
    __device__ __forceinline__ int nt(const pg8::Unit&, int d) const { return d; }
    __device__ __forceinline__ bool next(int i, pg8::Unit& u) const { const int L = i * G + c; if (L >= NU * 2) return false; u.z = L >> 1; u.pm = 0; u.pn = L & 1; return true; }
    __device__ __forceinline__ const GAS char* aptr(const pg8::Unit& u) const { return BB + (size_t)u.z * 256 * 768 * 2; }
    __device__ __forceinline__ const GAS char* bptr(const pg8::Unit& u) const { return KT + ((size_t)u.z * 512 + u.pn * 256) * 256 * 2; }
};
struct OutOrder {
    const GAS char* AB; const GAS char* BB; int G, c;
    __device__ __forceinline__ int nt(const pg8::Unit&, int d) const { return d; }
    __device__ __forceinline__ bool next(int i, pg8::Unit& u) const { const int L = i * G + c; if (L >= NU) return false; u.z = L; u.pm = 0; u.pn = 0; return true; }
    __device__ __forceinline__ const GAS char* aptr(const pg8::Unit& u) const { return AB + (size_t)u.z * 256 * 768 * 2; }
    __device__ __forceinline__ const GAS char* bptr(const pg8::Unit& u) const { return BB + (size_t)u.z * 256 * 768 * 2; }
};

struct MergedOrder {
    pg8::BigOrder base;
    __device__ __forceinline__ int nt(const pg8::Unit& u, int) const { return u.z == 2 ? 16 : 8; }
    __device__ __forceinline__ bool next(int i, pg8::Unit& u) const { const int z = i % 3; if (!base.next(i / 3, u)) return false; u.z = z; return true; }
    __device__ __forceinline__ const GAS char* aptr(const pg8::Unit& u) const { return base.aptr(u) + u.z * 1024; }
    __device__ __forceinline__ const GAS char* bptr(const pg8::Unit& u) const { return base.bptr(u) + u.z * 1024; }
};

constexpr int PH_PER_LAYER = 12, N_PHASES = 3 + DEPTH * PH_PER_LAYER;

__global__ void __launch_bounds__(512, 2) mk_fwd(Args args_unused) {
    extern __shared__ __attribute__((aligned(16))) unsigned char lds_raw[];
    (void)args_unused;
    CArgs ap = (CArgs)__builtin_amdgcn_kernarg_segment_ptr();
    Frame F;
    F.lds = (LAS unsigned char*)lds_raw;
    F.tid = threadIdx.x; F.lane = F.tid & 63; F.wave = __builtin_amdgcn_readfirstlane(F.tid >> 6);
    F.blk = blockIdx.x; F.G = gridDim.x; F.ws = (GAS unsigned char*)ap->ws;
    volatile LAS unsigned* MISC = (volatile LAS unsigned*)(F.lds + MISC_OFF);
    if (F.tid < 64) MISC[F.tid] = 0u;
    __syncthreads();
#if MK_PER_PHASE
#define GRID_BAR() do { } while (0)
#else
    XcdBarrier bar = xcd_barrier_post((unsigned*)(ap->ws + WS_CTL) + 4096, MISC + 8);
#define GRID_BAR() xcd_barrier(bar)
#endif
    const int lo = ap->ph_lo, hi = ap->ph_hi;
    unsigned long long tm_acc = 0ull, tm_t0 = 0ull; (void)tm_t0;
#ifndef DUPMASK
#define DUPMASK 0u
#endif
#define REP(k) _Pragma("unroll 1") for (int _r = 0; _r < (((DUPMASK >> (k)) & 1u) ? 2 : 1); ++_r)
#define IN(k) (lo <= (k) && (k) < hi)
#define SEAM(k) do { if (IN(k) && IN((k) + 1)) GRID_BAR(); } while (0)
#define LAUNDER() do { int _t = F.tid; asm volatile("" : "+v"(_t)); F.tid = _t; F.lane = _t & 63; F.wave = __builtin_amdgcn_readfirstlane(_t >> 6); \
        asm volatile("" : "+s"(ap)); GAS unsigned char* _w = (GAS unsigned char*)ap->ws; asm volatile("" : "+s"(_w)); F.ws = _w; ws = _w; } while (0)
    GAS unsigned char* ws = F.ws;

    TM_BEGIN(12); if (IN(0)) REP(12) { LAUNDER(); pro_a(F, ap); } SEAM(0); TM_END(12);
    TM_BEGIN(13); if (IN(1)) REP(13) { LAUNDER(); pro_b(F, ap); } SEAM(1); TM_END(13);
    TM_BEGIN(14); if (IN(2)) REP(14) { LAUNDER(); pro_c(F); } SEAM(2); TM_END(14);

#pragma unroll 1
    for (int l = 0; l < DEPTH; ++l) {
        const int p0 = 3 + l * PH_PER_LAYER;
        TM_BEGIN(0);
        if (IN(p0 + 0)) REP(0) {
            LAUNDER();
            pg8::BigOrder S; S.init(ws + WS_XM, (const GAS bf16_t*)(ws + WS_WIN) + (size_t)l * DIN * D, D, D, M, DIN, F.G, F.blk);
            pg8::EpiBf16<0> E{(GAS bf16_t*)(ws + WS_Z), DIN, ((const GAS float*)ap->in[I_BIN]) + (size_t)l * DIN};
            pg8::gemm_phase<pg8::EpiBf16<0>, pg8::BigOrder, true, true>(F.lds, F.tid, pg8::Gemm{D, D, D}, S, E);
        }
        SEAM(p0 + 0); TM_END(0);
        TM_BEGIN(1);
        if (IN(p0 + 1)) REP(1) { LAUNDER(); prep_phase(F, ap, l, tm_acc); }
        SEAM(p0 + 1); TM_END(1);
        TM_BEGIN(2);
        if (IN(p0 + 2)) REP(2) {
            {
                LAUNDER();
                pg8::BigOrder S; S.init(ws + WS_POOL, (const GAS bf16_t*)(ws + WS_WPT) + (size_t)l * 512 * 512, 512, 512, M, 512, F.G, F.blk);
                pg8::EpiBf16<0> E{(GAS bf16_t*)(ws + WS_Y), D, nullptr};
                pg8::gemm_phase<pg8::EpiBf16<0>, pg8::BigOrder, true, true>(F.lds, F.tid, pg8::Gemm{512, 512, 512}, S, E);
            }
            {
                LAUNDER();
                ScoresOrder S{(const GAS char*)(ws + WS_QR), (const GAS char*)(ws + WS_KRB), F.G, (F.blk + 72) % F.G};
                pg8::EpiScores E{(GAS bf16_t*)(ws + WS_ABUF), ((const GAS float*)ap->in[I_RDEC]) + l * 8};
                pg8::gemm_phase<pg8::EpiScores, ScoresOrder, true, true>(F.lds, F.tid, pg8::Gemm{1024, 1024, 256}, S, E);
            }
            {
                LAUNDER();
                UtOrder S{(const GAS char*)(ws + WS_BBUF), (const GAS char*)(ws + WS_KT), F.G, (F.blk + 216) % F.G};
                pg8::EpiF32 E{(GAS float*)(ws + WS_UT), 512, (size_t)256 * 512};
                pg8::gemm_phase<pg8::EpiF32, UtOrder, true, true>(F.lds, F.tid, pg8::Gemm{768, 256, 256}, S, E);
            }
        }
        SEAM(p0 + 2); TM_END(2);
        TM_BEGIN(3);
        if (IN(p0 + 3)) { REP(3) { LAUNDER(); scan_phase(F, ap, l); } REP(15) { LAUNDER(); conv_phase(F, ap, l); } }
        SEAM(p0 + 3); TM_END(3);
        TM_BEGIN(4);
        if (IN(p0 + 4)) REP(4) {
            LAUNDER();
            OutOrder S{(const GAS char*)(ws + WS_ABUF), (const GAS char*)(ws + WS_BBUF), F.G, F.blk};
            pg8::EpiF32 E{(GAS float*)(ws + WS_OBUF), 256, (size_t)256 * 256};
            pg8::gemm_phase<pg8::EpiF32, OutOrder, true, true>(F.lds, F.tid, pg8::Gemm{768, 768, 768}, S, E);
        }
        SEAM(p0 + 4); TM_END(4);
        TM_BEGIN(5);
        if (IN(p0 + 5)) REP(5) { LAUNDER(); gn_phase(F); }
        SEAM(p0 + 5); TM_END(5);
        TM_BEGIN(6);
        if (IN(p0 + 6)) REP(6) {
            LAUNDER();
            MergedOrder S; S.base.init(ws + WS_Y, (const GAS bf16_t*)(ws + WS_PT) + (size_t)l * D * D, D, D, M, D, F.G, F.blk);
            pg8::EpiMerged E{(const GAS bf16_t*)(ws + WS_Z), (GAS bf16_t*)(ws + WS_MG)};
            pg8::gemm_phase<pg8::EpiMerged, MergedOrder, true, true>(F.lds, F.tid, pg8::Gemm{D, D, D}, S, E);
        }
        SEAM(p0 + 6); TM_END(6);
        TM_BEGIN(7);
        if (IN(p0 + 7)) REP(7) {
            LAUNDER();
            pg8::EpiResid E{(const GAS float*)(ws + WS_X), (GAS float*)(ws + WS_S), ((const GAS float*)ap->in[I_BO]) + (size_t)l * D, (const GAS float*)(ws + WS_MOD) + (size_t)l * 5 * 12288 + 2 * D, (GAS float*)(ws + WS_PB)};
            if (F.G == 256) { pg8::SplitOrder S; S.init(ws + WS_MG, (const GAS bf16_t*)(ws + WS_WO) + (size_t)l * D * D, D, D, D, F.blk);
                pg8::gemm_phase<pg8::EpiResid, pg8::SplitOrder, true, true>(F.lds, F.tid, pg8::Gemm{D, D, D}, S, E); }
        }
        SEAM(p0 + 7); TM_END(7);
        TM_BEGIN(8);
        if (IN(p0 + 8)) REP(8) { LAUNDER(); ln_phase(F, ap, l, 0); }
        SEAM(p0 + 8); TM_END(8);
        TM_BEGIN(9);
        if (IN(p0 + 9)) REP(9) {
            LAUNDER();
            pg8::BigOrder S; S.init(ws + WS_XM, (const GAS bf16_t*)(ws + WS_W1) + (size_t)l * DFF * D, D, D, M, DFF, F.G, F.blk);
            pg8::EpiBf16<1> E{(GAS bf16_t*)(ws + WS_H), DFF, ((const GAS float*)ap->in[I_B1]) + (size_t)l * DFF};
            pg8::gemm_phase<pg8::EpiBf16<1>, pg8::BigOrder, true, true>(F.lds, F.tid, pg8::Gemm{D, D, D}, S, E);
        }
        SEAM(p0 + 9); TM_END(9);
        TM_BEGIN(10);
        if (IN(p0 + 10)) REP(10) {
            LAUNDER();
            pg8::EpiResid E{(const GAS float*)(ws + WS_X), (GAS float*)(ws + WS_S), ((const GAS float*)ap->in[I_B2]) + (size_t)l * D, (const GAS float*)(ws + WS_MOD) + (size_t)l * 5 * 12288 + 5 * D, (GAS float*)(ws + WS_PB)};
            if (F.G == 256) { pg8::SplitOrder S; S.init(ws + WS_H, (const GAS bf16_t*)(ws + WS_W2) + (size_t)l * D * DFF, DFF, DFF, DFF, F.blk);
                pg8::gemm_phase<pg8::EpiResid, pg8::SplitOrder, true, true>(F.lds, F.tid, pg8::Gemm{DFF, DFF, DFF}, S, E); }
        }
        SEAM(p0 + 10); TM_END(10);
        TM_BEGIN(11);
        if (IN(p0 + 11)) REP(11) { LAUNDER(); ln_phase(F, ap, l, 1); }
        SEAM(p0 + 11); TM_END(11);
    }
    if (TIMEMASK != 0u && blockIdx.x == 0 && F.tid < 64) { const unsigned long long t1 = __builtin_amdgcn_s_memrealtime(); while (__builtin_amdgcn_s_memrealtime() - t1 < 3ull * tm_acc) __builtin_amdgcn_s_sleep(8); }
#undef IN
#undef SEAM
#undef LAUNDER
}

extern "C" void kernel_launch(void* const* d_in, const int* in_sizes, int n_in, void* d_out, int out_size, void* d_ws, size_t ws_size, hipStream_t stream) {
    static int grid = 0;
    if (grid == 0) {
        if (n_in != 37 || out_size != ML * D || ws_size < WS_END) { fprintf(stderr, "kernel_launch: unexpected shapes (n_in %d, out %d, ws %zu)\n", n_in, out_size, ws_size); grid = -1; return; }
        int dev = 0, cus = 0, per_cu = 0;
        if (hipGetDevice(&dev) != hipSuccess || hipDeviceGetAttribute(&cus, hipDeviceAttributeMultiprocessorCount, dev) != hipSuccess) { grid = -1; return; }
        if (hipFuncSetAttribute((const void*)mk_fwd, hipFuncAttributeMaxDynamicSharedMemorySize, LDS_BYTES) != hipSuccess) { fprintf(stderr, "kernel_launch: hipFuncSetAttribute failed\n"); grid = -1; return; }
        if (hipOccupancyMaxActiveBlocksPerMultiprocessor(&per_cu, (const void*)mk_fwd, 512, LDS_BYTES) != hipSuccess || per_cu < 1) { fprintf(stderr, "kernel_launch: occupancy query says %d\n", per_cu); }
        (void)hipGetLastError();
        grid = cus;
    }
    if (grid < 0) return;
    (void)hipMemsetAsync((char*)d_ws + WS_CTL, 0, 1 * MiB, stream);
    Args a{};
    for (int i = 0; i < 37; ++i) a.in[i] = (const float*)d_in[i];
    a.out = (float*)d_out; a.ws = (unsigned char*)d_ws;
#if MK_PER_PHASE
    for (int p = 0; p < N_PHASES; ++p) { a.ph_lo = p; a.ph_hi = p + 1; hipLaunchKernelGGL(mk_fwd, dim3(grid), dim3(512), LDS_BYTES, stream, a); }
#else
    a.ph_lo = 0; a.ph_hi = N_PHASES;
    hipLaunchKernelGGL(mk_fwd, dim3(grid), dim3(512), LDS_BYTES, stream, a);
#endif
}
```
